# Optimizing an MI355X kernel written in HIP

```python
import jax, jax.numpy as jnp
from jax import lax
import numpy as np

D_MODEL = 1024
BATCH = 16
SEQ = 4096
DEPTH = 4

N_MIXERS = 2
PLE_DIM = 256
ROPE_THETA = 10000.0
NORM_EPS = 1e-6
Q_BLOCK = 128

MLA_HEADS = 8
MLA_Q_RANK = 256
MLA_KV_RANK = 256
MLA_NOPE_DIM = 128
MLA_ROPE_DIM = 64
MLA_V_DIM = 128
MLA_WIDTH = MLA_HEADS * MLA_V_DIM
MLA_SPLITS = [MLA_Q_RANK, MLA_Q_RANK + MLA_KV_RANK, MLA_Q_RANK + MLA_KV_RANK + MLA_ROPE_DIM]
MLA_IN = MLA_Q_RANK + MLA_KV_RANK + MLA_ROPE_DIM + MLA_WIDTH

DSA_HEADS = 8
DSA_KV_HEADS = 2
DSA_HEAD_DIM = 128
DSA_WIDTH = DSA_HEADS * DSA_HEAD_DIM
IDX_HEADS = 8
IDX_DIM = 64
TOPK_MAX = 256
DSA_SIZES = [DSA_WIDTH, DSA_KV_HEADS * DSA_HEAD_DIM, DSA_KV_HEADS * DSA_HEAD_DIM,
             IDX_HEADS * IDX_DIM, IDX_DIM, IDX_HEADS, DSA_WIDTH]
DSA_SPLITS = [int(v) for v in np.cumsum(DSA_SIZES)[:-1]]
DSA_IN = int(sum(DSA_SIZES))

N_MLA_LAYERS = (DEPTH + 1) // 2
N_DSA_LAYERS = DEPTH // 2

kernel_name = "hybrid_mla_dsa_gated_ple"


def rmsnorm(x, g):
    xf = x.astype(jnp.float32)
    y = xf * lax.rsqrt(jnp.mean(xf * xf, axis=-1, keepdims=True) + NORM_EPS)
    return (y * g.astype(jnp.float32)).astype(x.dtype)


def rope(x, pos):
    d = x.shape[-1]
    half = d // 2
    inv = 1.0 / (ROPE_THETA ** (jnp.arange(half, dtype=jnp.float32) / half))
    ang = pos.astype(jnp.float32)[..., None] * inv
    ang = ang.reshape(ang.shape[:2] + (1,) * (x.ndim - 3) + (half,))
    cos, sin = jnp.cos(ang), jnp.sin(ang)
    xf = x.astype(jnp.float32)
    x1, x2 = xf[..., :half], xf[..., half:]
    return jnp.concatenate([x1 * cos - x2 * sin, x2 * cos + x1 * sin], axis=-1).astype(x.dtype)


def sweep_query_blocks(fn, batch, seq):
    out = lax.map(fn, jnp.arange(seq // Q_BLOCK))
    out = jnp.moveaxis(out, 0, 1)
    return out.reshape((batch, seq) + out.shape[3:])


def mla_attention(q_lat, q_pe, c_kv, k_pe):
    B, S = c_kv.shape[:2]
    scale = (MLA_NOPE_DIM + MLA_ROPE_DIM) ** -0.5
    key_pos = jnp.arange(S)

    def block(i):
        start = i * Q_BLOCK
        ql = lax.dynamic_slice_in_dim(q_lat, start, Q_BLOCK, axis=1)
        qp = lax.dynamic_slice_in_dim(q_pe, start, Q_BLOCK, axis=1)
        s = (jnp.einsum('bqhc,bkc->bhqk', ql, c_kv)
             + jnp.einsum('bqhr,bkr->bhqk', qp, k_pe)).astype(jnp.float32) * scale
        qpos = start + jnp.arange(Q_BLOCK)
        causal = key_pos[None, :] <= qpos[:, None]
        s = jnp.where(causal[None, None], s, -jnp.inf)
        pr = jax.nn.softmax(s, axis=-1).astype(c_kv.dtype)
        return jnp.einsum('bhqk,bkc->bqhc', pr, c_kv)

    return sweep_query_blocks(block, B, S)


def mla_branch(h, pos, w_in, q_norm, kv_norm, w_uq, w_uk, w_uv, w_out):
    B, S, _ = h.shape
    c_q, c_kv, k_pe, z = jnp.split(h @ w_in, MLA_SPLITS, axis=-1)
    c_q = rmsnorm(c_q, q_norm)
    c_kv = rmsnorm(c_kv, kv_norm)
    q = (c_q @ w_uq).reshape(B, S, MLA_HEADS, MLA_NOPE_DIM + MLA_ROPE_DIM)
    q_nope, q_pe = q[..., :MLA_NOPE_DIM], q[..., MLA_NOPE_DIM:]
    q_pe = rope(q_pe, pos)
    k_pe = rope(k_pe, pos)
    q_lat = jnp.einsum('bshn,chn->bshc', q_nope, w_uk)
    o_lat = mla_attention(q_lat, q_pe, c_kv, k_pe)
    o = jnp.einsum('bshc,chv->bshv', o_lat, w_uv).reshape(B, S, MLA_WIDTH)
    return (o * jax.nn.silu(z)) @ w_out


def dsa_attention(q, k, v, q_idx, k_idx, w_idx, top_k):
    B, S = k.shape[:2]
    G = DSA_KV_HEADS
    R = DSA_HEADS // DSA_KV_HEADS
    scale = DSA_HEAD_DIM ** -0.5
    key_pos = jnp.arange(S)
    gather = jax.vmap(lambda a, ix: a[ix])

    def block(i):
        start = i * Q_BLOCK
        qpos = start + jnp.arange(Q_BLOCK)
        causal = key_pos[None, :] <= qpos[:, None]
        qi = lax.dynamic_slice_in_dim(q_idx, start, Q_BLOCK, axis=1)
        wi = lax.dynamic_slice_in_dim(w_idx, start, Q_BLOCK, axis=1).astype(jnp.float32)
        logits = jnp.einsum('bqhd,bkd->bqhk', qi, k_idx).astype(jnp.float32) * (IDX_DIM ** -0.5)
        score = jnp.einsum('bqhk,bqh->bqk', jax.nn.relu(logits), wi * (IDX_HEADS ** -0.5))
        score = jnp.where(causal[None], score, -jnp.inf)
        _, idx = lax.top_k(score, top_k)
        valid = idx <= qpos[None, :, None]
        k_sel = gather(k, idx)
        v_sel = gather(v, idx)
        qb = lax.dynamic_slice_in_dim(q, start, Q_BLOCK, axis=1).reshape(B, Q_BLOCK, G, R, DSA_HEAD_DIM)
        s = jnp.einsum('bqgrd,bqkgd->bqgrk', qb, k_sel).astype(jnp.float32) * scale
        s = jnp.where(valid[:, :, None, None, :], s, -jnp.inf)
        pr = jax.nn.softmax(s, axis=-1).astype(v.dtype)
        o = jnp.einsum('bqgrk,bqkgd->bqgrd', pr, v_sel)
        return o.reshape(B, Q_BLOCK, DSA_HEADS, DSA_HEAD_DIM)

    return sweep_query_blocks(block, B, S)


def dsa_branch(h, pos, w_in, w_out):
    B, S, _ = h.shape
    q, k, v, qi, ki, wi, z = jnp.split(h @ w_in, DSA_SPLITS, axis=-1)
    q = rope(q.reshape(B, S, DSA_HEADS, DSA_HEAD_DIM), pos)
    k = rope(k.reshape(B, S, DSA_KV_HEADS, DSA_HEAD_DIM), pos)
    v = v.reshape(B, S, DSA_KV_HEADS, DSA_HEAD_DIM)
    qi = rope(qi.reshape(B, S, IDX_HEADS, IDX_DIM), pos)
    ki = rope(ki, pos)
    top_k = min(TOPK_MAX, S // 4)
    o = dsa_attention(q, k, v, qi, ki, wi, top_k).reshape(B, S, DSA_WIDTH)
    return (o * jax.nn.silu(z)) @ w_out


def setup_inputs(seed: int = 0) -> dict:
    key = jax.random.key(seed)
    ks = jax.random.split(key, 20)

    def w(k, shape, fan_in):
        return jax.random.normal(k, shape, jnp.float32) * (fan_in ** -0.5)

    def gain(k, shape):
        return 1.0 + 0.02 * jax.random.normal(k, shape, jnp.float32)

    x = jax.random.normal(ks[0], (BATCH, SEQ, D_MODEL), jnp.float32)
    p = jax.random.normal(ks[1], (DEPTH, BATCH, SEQ, PLE_DIM), jnp.float32)
    offset = jax.random.randint(ks[2], (BATCH, 1), 0, 1024, dtype=jnp.int32)
    positions = jnp.arange(SEQ, dtype=jnp.int32)[None, :] + offset
    return {
        "x": x,
        "p": p,
        "positions": positions,
        "norm_in": gain(ks[3], (DEPTH, D_MODEL)),
        "mla_w_in": w(ks[4], (N_MLA_LAYERS, D_MODEL, MLA_IN), D_MODEL),
        "mla_q_norm": gain(ks[5], (N_MLA_LAYERS, MLA_Q_RANK)),
        "mla_kv_norm": gain(ks[6], (N_MLA_LAYERS, MLA_KV_RANK)),
        "mla_w_uq": w(ks[7], (N_MLA_LAYERS, MLA_Q_RANK, MLA_HEADS * (MLA_NOPE_DIM + MLA_ROPE_DIM)), MLA_Q_RANK),
        "mla_w_uk": w(ks[8], (N_MLA_LAYERS, MLA_KV_RANK, MLA_HEADS, MLA_NOPE_DIM), MLA_KV_RANK),
        "mla_w_uv": w(ks[9], (N_MLA_LAYERS, MLA_KV_RANK, MLA_HEADS, MLA_V_DIM), MLA_KV_RANK),
        "mla_w_out": w(ks[10], (N_MLA_LAYERS, MLA_WIDTH, D_MODEL), MLA_WIDTH),
        "dsa_w_in": w(ks[11], (N_DSA_LAYERS, D_MODEL, DSA_IN), D_MODEL),
        "dsa_w_out": w(ks[12], (N_DSA_LAYERS, DSA_WIDTH, D_MODEL), DSA_WIDTH),
        "ple_w_proj": w(ks[13], (DEPTH, PLE_DIM, D_MODEL), PLE_DIM),
        "ple_norm": gain(ks[14], (DEPTH, D_MODEL)),
        "ple_w_gate": w(ks[15], (DEPTH, D_MODEL, D_MODEL), D_MODEL),
        "final_norm": gain(ks[16], (D_MODEL,)),
    }


def reference(x, p, positions, norm_in, mla_w_in, mla_q_norm, mla_kv_norm, mla_w_uq,
              mla_w_uk, mla_w_uv, mla_w_out, dsa_w_in, dsa_w_out, ple_w_proj,
              ple_norm, ple_w_gate, final_norm):
    for i in range(DEPTH):
        h = rmsnorm(x, norm_in[i])
        j = i // N_MIXERS
        if i % N_MIXERS == 0:
            y = mla_branch(h, positions, mla_w_in[j], mla_q_norm[j], mla_kv_norm[j],
                           mla_w_uq[j], mla_w_uk[j], mla_w_uv[j], mla_w_out[j])
        else:
            y = dsa_branch(h, positions, dsa_w_in[j], dsa_w_out[j])
        x = x + y
        gate = jax.nn.sigmoid(rmsnorm(x, ple_norm[i]) @ ple_w_gate[i])
        x = x + (p[i] @ ple_w_proj[i]) * gate
    return rmsnorm(x, final_norm)
```

```cpp
#include <hip/hip_runtime.h>
#include <cstdio>
#include <cstdint>
namespace pg8 {
#define PG8_LAS __attribute__((address_space(3)))
typedef unsigned short bf16_t;
typedef short bf16x8 __attribute__((ext_vector_type(8)));
typedef float f32x4 __attribute__((ext_vector_type(4)));
typedef unsigned u32x4 __attribute__((ext_vector_type(4)));
constexpr int BM = 256, BK = 64, HALF = 128, HTB = HALF * BK * 2  , STAGE_BYTES = 8 * HTB, NXCD = 8, WGM = 8;

__host__ __device__ __forceinline__ int lds_byte(int r, int c) { const int st = (r >> 4) * 2 + (c >> 5), rr = r & 15, cc = c & 31, ob = rr * 64 + cc * 2; return st * 1024 + (ob ^ (((ob >> 9) & 1) << 5)); }
__host__ __device__ __forceinline__ void stage_rc(int b, int& R, int& C) { const int st = b / 1024, sb = b % 1024, swz = sb ^ (((sb >> 9) & 1) << 5); R = (st >> 1) * 16 + swz / 64; C = (st & 1) * 32 + (swz % 64) / 2; }
__host__ __device__ __forceinline__ int perm32(int rho) { const int n = rho >> 4, i = rho & 15; return 8 * (i >> 2) + 4 * n + (i & 3); }

struct Unit { int pm, pn; };
struct Gemm { const bf16_t* A; const bf16_t* Bt; int M, N, K; };

struct StaticOrder {
    int nM, nN, nwg, G, c;
    __host__ __device__ void init(int M, int N, int G_, int c_) { nM = M / BM; nN = N / BM; nwg = nM * nN; G = G_; c = c_; }
    __host__ __device__ bool next(int i, Unit& u) const {
        const long L = (long)i * G + c; if (L >= nwg) return false;
        int wgid = (int)L; { const int q = nwg / NXCD, r = nwg % NXCD, xcd = wgid % NXCD, off = wgid / NXCD; wgid = (xcd < r ? xcd * (q + 1) : r * (q + 1) + (xcd - r) * q) + off; }
        const int nig = WGM * nN, gid = wgid / nig, fm = gid * WGM, gsz = (nM - fm) < WGM ? (nM - fm) : WGM;
        u.pm = fm + ((wgid % nig) % gsz); u.pn = (wgid % nig) / gsz; return true;
    }
    __device__ __forceinline__ void a_ready(const Unit&) const {}
    __device__ __forceinline__ void done(const Unit&) const {}
};

__device__ __forceinline__ unsigned cvt_pk_bf16(float lo, float hi) { unsigned r; asm volatile("v_cvt_pk_bf16_f32 %0, %1, %2" : "=v"(r) : "v"(lo), "v"(hi)); return r; }
typedef float f32x2 __attribute__((ext_vector_type(2)));
template <class Epi, class Sched, bool ALIGN_EPI = false, bool SP2 = false>
__device__ __forceinline__ void gemm_phase(PG8_LAS unsigned char* lds, const Gemm g, const Sched& S, const Epi& E) {
    const int tid = threadIdx.x, wid = __builtin_amdgcn_readfirstlane(tid >> 6), lane = tid & 63, wr = wid >> 2, wc = wid & 3, fr = lane & 15, fq = lane >> 4;
    const int K = g.K, nt = K / BK;
    unsigned voffA[2], voffB[2];
#pragma unroll
    for (int i = 0; i < 2; ++i) { int R, C; stage_rc(tid * 16 + i * 8192, R, C); const int Rb = Epi::PERM ? ((R & ~31) + perm32(R & 31)) : R;
        voffA[i] = (unsigned)(R * K + C) * 2u; voffB[i] = (unsigned)(Rb * K + C) * 2u; }
    const size_t kstep = (size_t)(BK * 2);
    const size_t hstep = (size_t)HALF * K * 2;
    const size_t tstep = 2 * hstep;
    const unsigned ldsw = (unsigned)wid * 1024u;
    const int aoff = lds_byte(wr * 64 + fr, fq * 8), boff = lds_byte(wc * 32 + fr, fq * 8);
#define PG8_SA(b, h) (((b) * 2 + (h)) * HTB)
#define PG8_SB(b, h) ((4 + (b) * 2 + (h)) * HTB)
#define PG8_STAGE(bufoff, gbase, voff) do { _Pragma("unroll") for (int _i = 0; _i < 2; ++_i) \
        __builtin_amdgcn_global_load_lds((const unsigned*)((const char*)(gbase) + (voff)[_i]), (PG8_LAS unsigned*)(lds + (bufoff) + ldsw + _i * 8192), 16, 0, 0); } while (0)
#define PG8_LDA(dst, b, h) do { _Pragma("unroll") for (int m = 0; m < 4; ++m) _Pragma("unroll") for (int k = 0; k < 2; ++k) dst[m][k] = *(const PG8_LAS bf16x8*)(lds + PG8_SA(b, h) + aoff + m * 2048 + k * 1024); } while (0)
#define PG8_LDB(dst, b, h) do { _Pragma("unroll") for (int n = 0; n < 2; ++n) _Pragma("unroll") for (int k = 0; k < 2; ++k) dst[n][k] = *(const PG8_LAS bf16x8*)(lds + PG8_SB(b, h) + boff + n * 2048 + k * 1024); } while (0)
#define PG8_MMA(ai, bj, At, Bt) do { __builtin_amdgcn_s_setprio(1); _Pragma("unroll") for (int m = 0; m < 4; ++m) _Pragma("unroll") for (int n = 0; n < 2; ++n) _Pragma("unroll") for (int k = 0; k < 2; ++k) \
        acc[ai][bj][m][n] = __builtin_amdgcn_mfma_f32_16x16x32_bf16(Bt[n][k], At[m][k], acc[ai][bj][m][n], 0, 0, 0); __builtin_amdgcn_s_setprio(0); } while (0)
#define PG8_WAIT_V(n) asm volatile("s_waitcnt vmcnt(" #n ")" ::: "memory")
#define PG8_WAIT_L(n) asm volatile("s_waitcnt lgkmcnt(" #n ")" ::: "memory")
#define PG8_BAR __builtin_amdgcn_s_barrier()
#define PG8_SCHED __builtin_amdgcn_sched_barrier(0)
    Unit cur, nxt; int ui = 0;
    if (!S.next(0, cur)) return;
    f32x4 acc[2][2][4][2];
#pragma unroll
    for (int a = 0; a < 2; ++a)
#pragma unroll
        for (int b = 0; b < 2; ++b)
#pragma unroll
            for (int m = 0; m < 4; ++m)
#pragma unroll
                for (int n = 0; n < 2; ++n) acc[a][b][m][n] = (f32x4){0.f, 0.f, 0.f, 0.f};
    bf16x8 At[4][2], B0[2][2], B1[2][2];
    const char* cA = (const char*)g.A + (size_t)cur.pm * tstep; const char* cB = (const char*)g.Bt + (size_t)cur.pn * tstep;
    S.a_ready(cur);
    if constexpr (SP2) {
        PG8_STAGE(PG8_SB(0, 0), cB, voffB); PG8_STAGE(PG8_SB(0, 1), cB + hstep, voffB); PG8_STAGE(PG8_SA(0, 0), cA, voffA); PG8_STAGE(PG8_SA(0, 1), cA + hstep, voffA);
        if (wr == 1) PG8_BAR;
        PG8_WAIT_V(2); PG8_BAR;
        PG8_STAGE(PG8_SB(1, 0), cB + kstep, voffB); PG8_STAGE(PG8_SA(1, 0), cA + kstep, voffA); PG8_STAGE(PG8_SB(1, 1), cB + hstep + kstep, voffB);
        PG8_WAIT_V(6); PG8_BAR;
    } else {
        PG8_STAGE(PG8_SB(0, 0), cB, voffB); PG8_STAGE(PG8_SA(0, 0), cA, voffA); PG8_STAGE(PG8_SB(0, 1), cB + hstep, voffB); PG8_STAGE(PG8_SA(0, 1), cA + hstep, voffA);
        if (wr == 1) PG8_BAR;
        PG8_WAIT_V(4); PG8_BAR;
        PG8_STAGE(PG8_SB(1, 0), cB + kstep, voffB); PG8_STAGE(PG8_SA(1, 0), cA + kstep, voffA); PG8_STAGE(PG8_SB(1, 1), cB + hstep + kstep, voffB);
        PG8_WAIT_V(6); PG8_BAR;
    }
    for (;;) {
        const bool has_next = S.next(ui + 1, nxt);
        const char* nA = has_next ? (const char*)g.A + (size_t)nxt.pm * tstep : cA; const char* nB = has_next ? (const char*)g.Bt + (size_t)nxt.pn * tstep : cB;
        _Pragma("nounroll") for (int t = 0; t < nt; t += 2) {
            const bool last = (t == nt - 2);
            const char* a1 = cA + (size_t)(t + 1) * kstep;
            const char* a2 = last ? nA : cA + (size_t)(t + 2) * kstep; const char* b2 = last ? nB : cB + (size_t)(t + 2) * kstep;
            const char* a3 = a2 + kstep; const char* b3 = b2 + kstep;
            if (last && has_next) S.a_ready(nxt);
            if constexpr (SP2) {
            PG8_LDB(B0, 0, 0); PG8_LDB(B1, 0, 1); PG8_SCHED; PG8_LDA(At, 0, 0); PG8_STAGE(PG8_SA(1, 1), a1 + hstep, voffA);
            PG8_WAIT_V(8); PG8_WAIT_L(0); PG8_BAR; PG8_MMA(0, 0, At, B0); PG8_MMA(0, 1, At, B1); PG8_BAR; PG8_SCHED;
            PG8_LDA(At, 0, 1); PG8_STAGE(PG8_SB(0, 0), b2, voffB); PG8_STAGE(PG8_SB(0, 1), b2 + hstep, voffB); PG8_STAGE(PG8_SA(0, 0), a2, voffA);
            PG8_WAIT_V(8); PG8_WAIT_L(0); PG8_BAR; PG8_MMA(1, 0, At, B0); PG8_MMA(1, 1, At, B1); PG8_BAR; PG8_SCHED;
            PG8_LDB(B0, 1, 0); PG8_LDB(B1, 1, 1); PG8_SCHED; PG8_LDA(At, 1, 0); PG8_STAGE(PG8_SA(0, 1), a2 + hstep, voffA);
            PG8_WAIT_V(8); PG8_WAIT_L(0); PG8_BAR; PG8_MMA(0, 0, At, B0); PG8_MMA(0, 1, At, B1); PG8_BAR; PG8_SCHED;
            PG8_LDA(At, 1, 1); PG8_STAGE(PG8_SB(1, 0), b3, voffB); PG8_STAGE(PG8_SB(1, 1), b3 + hstep, voffB); PG8_STAGE(PG8_SA(1, 0), a3, voffA);
            PG8_WAIT_V(8); PG8_WAIT_L(0); PG8_BAR; PG8_MMA(1, 0, At, B0); PG8_MMA(1, 1, At, B1); PG8_BAR; PG8_SCHED;
            } else {
            PG8_LDB(B0, 0, 0); PG8_SCHED; PG8_LDA(At, 0, 0); PG8_STAGE(PG8_SA(1, 1), a1 + hstep, voffA);
            PG8_WAIT_L(8); PG8_BAR; PG8_WAIT_L(0); PG8_MMA(0, 0, At, B0); PG8_BAR; PG8_SCHED;
            PG8_LDB(B1, 0, 1); PG8_STAGE(PG8_SB(0, 0), b2, voffB);
            PG8_BAR; PG8_WAIT_L(0); PG8_MMA(0, 1, At, B1); PG8_BAR;
            PG8_LDA(At, 0, 1); PG8_STAGE(PG8_SA(0, 0), a2, voffA);
            PG8_BAR; PG8_WAIT_L(0); PG8_MMA(1, 0, At, B0); PG8_BAR; PG8_SCHED;
            PG8_STAGE(PG8_SB(0, 1), b2 + hstep, voffB);
            PG8_WAIT_V(6); PG8_BAR; PG8_MMA(1, 1, At, B1); PG8_BAR;
            PG8_LDB(B0, 1, 0); PG8_SCHED; PG8_LDA(At, 1, 0); PG8_STAGE(PG8_SA(0, 1), a2 + hstep, voffA);
            PG8_WAIT_L(8); PG8_BAR; PG8_WAIT_L(0); PG8_MMA(0, 0, At, B0); PG8_BAR; PG8_SCHED;
            PG8_LDB(B1, 1, 1); PG8_STAGE(PG8_SB(1, 0), b3, voffB);
            PG8_BAR; PG8_WAIT_L(0); PG8_MMA(0, 1, At, B1); PG8_BAR;
            PG8_LDA(At, 1, 1); PG8_STAGE(PG8_SA(1, 0), a3, voffA);
            PG8_BAR; PG8_WAIT_L(0); PG8_MMA(1, 0, At, B0); PG8_BAR; PG8_SCHED;
            PG8_STAGE(PG8_SB(1, 1), b3 + hstep, voffB);
            PG8_WAIT_V(6); PG8_BAR; PG8_MMA(1, 1, At, B1); PG8_BAR;
            }
        }
        if constexpr (ALIGN_EPI) { if (wr == 0) PG8_BAR; }
        if constexpr (!Epi::AFTER_DRAIN) { E(acc, cur, wr, wc, fr, fq); S.done(cur); }
        if (!has_next) break;
#pragma unroll
        for (int a = 0; a < 2; ++a)
#pragma unroll
            for (int b = 0; b < 2; ++b)
#pragma unroll
                for (int m = 0; m < 4; ++m)
#pragma unroll
                    for (int n = 0; n < 2; ++n) acc[a][b][m][n] = (f32x4){0.f, 0.f, 0.f, 0.f};
        cur = nxt; cA = nA; cB = nB; ++ui;
        if constexpr (ALIGN_EPI) { if (wr == 1) PG8_BAR; }
    }
    PG8_WAIT_V(0);
    if constexpr (!ALIGN_EPI) { if (wr == 0) PG8_BAR; }
    PG8_BAR;
    if constexpr (Epi::AFTER_DRAIN) { E.fused(acc, cur, wr, wc, fr, fq, lds, wid, lane); S.done(cur); }
#undef PG8_SA
#undef PG8_SB
#undef PG8_STAGE
#undef PG8_LDA
#undef PG8_LDB
#undef PG8_MMA
#undef PG8_WAIT_V
#undef PG8_WAIT_L
#undef PG8_BAR
#undef PG8_SCHED
}
}
constexpr int NB = 16, SEQ = 4096, T = NB * SEQ, DM = 1024, DEPTH = 4;
constexpr int MLA_N = 1792;
constexpr int DSA_N = 3328;
constexpr float NORM_EPS = 1e-6f;
constexpr int NPHASE = 22;

constexpr size_t MiB = 1u << 20;
constexpr size_t WS_CTL = 0, CTL_ZERO_BYTES = 1 * MiB;
constexpr size_t WS_W = 2 * MiB;
constexpr size_t W_WINM = 0, W_WUQ = W_WINM + 2ull * MLA_N * 1024, W_WUK = W_WUQ + 2ull * 1536 * 256, W_WUV = W_WUK + 2ull * 1024 * 256,
                 W_WOM = W_WUV + 2ull * 1024 * 256, W_WIND = W_WOM + 2ull * 1024 * 1024, W_WOD = W_WIND + 2ull * DSA_N * 1024,
                 W_WP = W_WOD + 2ull * 1024 * 1024, W_WG = W_WP + 4ull * 1024 * 256, W_END = W_WG + 4ull * 1024 * 1024;
static_assert(WS_W + W_END * 2 <= 46 * MiB, "weights");
constexpr size_t WS_ROPE64 = 48 * MiB, WS_ROPE32 = 80 * MiB;
constexpr size_t WS_RSX = 96 * MiB, WS_RS1 = 100 * MiB, WS_RSQ = 104 * MiB, WS_RSKV = 105 * MiB;
constexpr size_t WS_PB = 112 * MiB;
constexpr size_t WS_XB0 = 144 * MiB;
constexpr size_t WS_SZ = 272 * MiB;
constexpr size_t WS_CQ = 400 * MiB, WS_CKV = 432 * MiB, WS_KPE = 464 * MiB;
constexpr size_t WS_QI = 400 * MiB, WS_KI = 464 * MiB, WS_WI = 472 * MiB;
constexpr size_t WS_Q = 480 * MiB;
constexpr size_t WS_PP = 480 * MiB;
constexpr size_t WS_KN = 672 * MiB, WS_V = 800 * MiB;
constexpr size_t WS_KD = 672 * MiB, WS_VD = 704 * MiB, WS_MASK = 736 * MiB;
constexpr size_t WS_XB1 = 672 * MiB;
constexpr size_t WS_END = 928 * MiB;
constexpr int CW_BAR = 4096;

constexpr int RING_BYTES = 131072;
constexpr int LDS_QIS = 131072;
constexpr int MISC_OFF = 147456;
constexpr int LDS_BYTES = 147456 + 512;
constexpr int NWAVES = 8;

#define GAS __attribute__((address_space(1)))
#define LAS __attribute__((address_space(3)))
typedef unsigned short bf16;
typedef unsigned v4u __attribute__((ext_vector_type(4)));
typedef float f32x4 __attribute__((ext_vector_type(4)));
typedef short bf16x8 __attribute__((ext_vector_type(8)));
typedef GAS unsigned gu32;
#define LDS_WAIT() asm volatile("s_waitcnt lgkmcnt(0)" ::: "memory")
#define VM_WAIT() asm volatile("s_waitcnt vmcnt(0)" ::: "memory")
__device__ __forceinline__ unsigned f2bf(float f) { unsigned u = __builtin_bit_cast(unsigned, f); return (u + 0x7fffu + ((u >> 16) & 1u)) >> 16; }
#define XB_TMO      128
#define XB_XCNT(j)  (256  + 64 * (j))
#define XB_XSUB(j)  (1280 + 64 * (j))
#define XB_XGEN(j)  (2304 + 64 * (j))
#define XB_TOP      3328
#define XB_TOPGEN   3392
#define XCD_BAR_WORDS 3456
#define XB_SPIN_CAP (1u << 18)

__device__ __forceinline__ unsigned xb_ld(unsigned* p)              { return __hip_atomic_load(p, __ATOMIC_RELAXED, __HIP_MEMORY_SCOPE_AGENT); }
__device__ __forceinline__ unsigned xb_add(unsigned* p, unsigned v) { return __hip_atomic_fetch_add(p, v, __ATOMIC_RELAXED, __HIP_MEMORY_SCOPE_AGENT); }
__device__ __forceinline__ unsigned xb_xcc_id() { return (unsigned)__builtin_amdgcn_s_getreg((3 << 11) | 20) & 0xFu; }
#define XB_SPIN(cond, bar) do { unsigned _sp = 0; while (cond) { __builtin_amdgcn_s_sleep(1); \
    if ((++_sp & 255u) == 0u) { if (xb_ld(&(bar)[XB_TMO])) break; if (_sp > XB_SPIN_CAP) { atomicAdd(&(bar)[XB_TMO], 1u); break; } } } } while (0)

struct XcdBarrier {
    unsigned* bar; unsigned x;
    volatile LAS unsigned* st;
};

__device__ __forceinline__ XcdBarrier xcd_barrier_post(unsigned* bar, volatile LAS unsigned* st) {
    XcdBarrier b; b.bar = bar; b.x = xb_xcc_id(); b.st = st;
    if (threadIdx.x == 0) (void)xb_add(&bar[XB_XCNT(b.x)], 1u);
    return b;
}
__device__ __forceinline__ void xcd_barrier_complete(unsigned* bar, unsigned x, unsigned& nloc, unsigned& nx) {
    const unsigned G = gridDim.x * gridDim.y * gridDim.z;
    unsigned sum, cnt, mine, sp = 0u;
    for (;;) {
        sum = 0u; cnt = 0u; mine = 0u;
#pragma unroll
        for (unsigned j = 0; j < 16; ++j) { const unsigned c = xb_ld(&bar[XB_XCNT(j)]); sum += c; cnt += (c > 0u) ? 1u : 0u; mine = (j == x) ? c : mine; }
        if (sum == G) break;
        __builtin_amdgcn_s_sleep(1);
        if ((++sp & 255u) == 0u) { if (xb_ld(&bar[XB_TMO])) break; if (sp > XB_SPIN_CAP) { atomicAdd(&bar[XB_TMO], 1u); break; } }
    }
    nloc = mine > 0u ? mine : 1u; nx = cnt > 0u ? cnt : 1u;
}

__device__ __forceinline__ void xcd_barrier(const XcdBarrier& b) {
    asm volatile("s_waitcnt vmcnt(0)" ::: "memory");
    __syncthreads();
    if (threadIdx.x == 0) {
        unsigned* bar = b.bar;
        __builtin_amdgcn_s_waitcnt(0);
        unsigned nloc = b.st[0], nx = b.st[1];
        if (nloc == 0u) { xcd_barrier_complete(bar, b.x, nloc, nx); b.st[0] = nloc; b.st[1] = nx; }
        const unsigned old = xb_add(&bar[XB_XSUB(b.x)], 1u);
        const unsigned gen = old / nloc;
        if (old + 1u == (gen + 1u) * nloc) {
            __builtin_amdgcn_fence(__ATOMIC_RELEASE, "agent");
            asm volatile("s_waitcnt vmcnt(0)" ::: "memory");
            const unsigned og = xb_add(&bar[XB_TOP], 1u);
            const unsigned tg = og / nx;
            if (og + 1u == (tg + 1u) * nx) xb_add(&bar[XB_TOPGEN], 1u);
            else XB_SPIN(xb_ld(&bar[XB_TOPGEN]) == tg, bar);
            __builtin_amdgcn_fence(__ATOMIC_ACQUIRE, "agent");
            xb_add(&bar[XB_XGEN(b.x)], 1u);
            asm volatile("s_waitcnt vmcnt(0)" ::: "memory");
        } else {
            XB_SPIN(xb_ld(&bar[XB_XGEN(b.x)]) == gen, bar);
            __builtin_amdgcn_fence(__ATOMIC_ACQUIRE, "agent");
            asm volatile("s_waitcnt vmcnt(0)" ::: "memory");
        }
    }
    __syncthreads();
}


typedef unsigned u32x2 __attribute__((ext_vector_type(2)));
__device__ __forceinline__ float bf2f(unsigned h) { return __builtin_bit_cast(float, h << 16); }
__device__ __forceinline__ unsigned cvtpk(float lo, float hi) { unsigned r; asm volatile("v_cvt_pk_bf16_f32 %0, %1, %2" : "=v"(r) : "v"(lo), "v"(hi)); return r; }
__device__ __forceinline__ v4u pack8(f32x4 a, f32x4 b) { v4u w; w.x = cvtpk(a[0], a[1]); w.y = cvtpk(a[2], a[3]); w.z = cvtpk(b[0], b[1]); w.w = cvtpk(b[2], b[3]); return w; }
__device__ __forceinline__ float wave_sum(float v) {
#pragma unroll
    for (int o = 1; o < 64; o <<= 1) v += __shfl_xor(v, o);
    return v;
}
__device__ __forceinline__ float wave_max(float v) {
#pragma unroll
    for (int o = 1; o < 64; o <<= 1) v = fmaxf(v, __shfl_xor(v, o));
    return v;
}
__device__ __forceinline__ int wave_sum_i(int v) {
#pragma unroll
    for (int o = 1; o < 64; o <<= 1) v += __shfl_xor(v, o);
    return v;
}
__device__ __forceinline__ float sum16_rstd(const float* rs, int row, float invn) {
    const f32x4* p = (const f32x4*)(rs + (size_t)row * 16); const f32x4 a = p[0], b = p[1], c = p[2], d = p[3];
    const float s = ((a[0] + a[1]) + (a[2] + a[3])) + ((b[0] + b[1]) + (b[2] + b[3])) + ((c[0] + c[1]) + (c[2] + c[3])) + ((d[0] + d[1]) + (d[2] + d[3]));
    return rsqrtf(s * invn + NORM_EPS);
}
__device__ __forceinline__ float sum4_rstd(const float* rs, int row, float invn) {
    const f32x4 a = *(const f32x4*)(rs + (size_t)row * 4); return rsqrtf(((a[0] + a[1]) + (a[2] + a[3])) * invn + NORM_EPS);
}
__device__ __forceinline__ float silu_f(float v) { return v * __builtin_amdgcn_rcpf(1.f + __expf(-v)); }
__device__ __forceinline__ float sigmoid_f(float v) { return __builtin_amdgcn_rcpf(1.f + __expf(-v)); }
__device__ __forceinline__ float sq4(f32x4 v) { return (v[0] * v[0] + v[1] * v[1]) + (v[2] * v[2] + v[3] * v[3]); }
__device__ __forceinline__ void rope8(f32x4& v0, f32x4& v1, const float* cs) {
    const f32x4 c0 = *(const f32x4*)cs, c1 = *(const f32x4*)(cs + 4);
    f32x4 o0, o1;
    o0[0] = v0[0] * c0[0] - v0[1] * c0[1]; o0[1] = v0[1] * c0[0] + v0[0] * c0[1];
    o0[2] = v0[2] * c0[2] - v0[3] * c0[3]; o0[3] = v0[3] * c0[2] + v0[2] * c0[3];
    o1[0] = v1[0] * c1[0] - v1[1] * c1[1]; o1[1] = v1[1] * c1[0] + v1[0] * c1[1];
    o1[2] = v1[2] * c1[2] - v1[3] * c1[3]; o1[3] = v1[3] * c1[2] + v1[2] * c1[3];
    v0 = o0; v1 = o1;
}

#define EPI_ROWS _Pragma("unroll") for (int ai = 0; ai < 2; ++ai) _Pragma("unroll") for (int m = 0; m < 4; ++m)
#define EPI_ROW (u.pm * 256 + ai * 128 + wr * 64 + m * 16 + fr)
typedef const f32x4 (&AccRef)[2][2][4][2];

struct EpiMlaIn {
    static constexpr bool PERM = true, AFTER_DRAIN = false;
    const float* rsx; bf16* cq; bf16* ckv; bf16* sz; bf16* kpe; float* rsq; float* rskv; const float* rope32;
    __device__ __forceinline__ void operator()(AccRef acc, const pg8::Unit& u, int wr, int wc, int fr, int fq) const {
        const int pn = u.pn;
        EPI_ROWS { const int row = EPI_ROW; const float rstd = sum16_rstd(rsx, row, 1.f / 1024.f);
            if (pn < 2) { bf16* dst = pn == 0 ? cq : ckv; float* rs = pn == 0 ? rsq : rskv; float ss = 0.f;
#pragma unroll
                for (int bj = 0; bj < 2; ++bj) { const f32x4 v0 = acc[ai][bj][m][0] * rstd, v1 = acc[ai][bj][m][1] * rstd; ss += sq4(v0) + sq4(v1);
                    *(v4u*)(dst + (size_t)row * 256 + bj * 128 + wc * 32 + fq * 8) = pack8(v0, v1); }
                ss += __shfl_xor(ss, 16); ss += __shfl_xor(ss, 32);
                if (fq == 0) rs[(size_t)row * 4 + wc] = ss;
            } else if (pn < 6) {
#pragma unroll
                for (int bj = 0; bj < 2; ++bj) { f32x4 v0 = acc[ai][bj][m][0] * rstd, v1 = acc[ai][bj][m][1] * rstd;
#pragma unroll
                    for (int e = 0; e < 4; ++e) { v0[e] = silu_f(v0[e]); v1[e] = silu_f(v1[e]); }
                    *(v4u*)(sz + (size_t)row * 1024 + (pn - 2) * 256 + bj * 128 + wc * 32 + fq * 8) = pack8(v0, v1); }
            } else if (wc < 2) {
                const int c = wc * 32 + fq * 8; f32x4 v0 = acc[ai][0][m][0] * rstd, v1 = acc[ai][0][m][1] * rstd;
                rope8(v0, v1, rope32 + ((size_t)row * 32 + (c >> 1)) * 2);
                *(v4u*)(kpe + (size_t)row * 64 + c) = pack8(v0, v1);
            }
        }
    }
};
struct EpiMlaQ {
    static constexpr bool PERM = true, AFTER_DRAIN = false;
    const float* rsq; bf16* q; const float* rope32;
    __device__ __forceinline__ void operator()(AccRef acc, const pg8::Unit& u, int wr, int wc, int fr, int fq) const {
        EPI_ROWS { const int row = EPI_ROW; const float rstd = sum4_rstd(rsq, row, 1.f / 256.f);
#pragma unroll
            for (int bj = 0; bj < 2; ++bj) { const int col = u.pn * 256 + bj * 128 + wc * 32 + fq * 8; const int h = col / 192, cin = col - h * 192;
                f32x4 v0 = acc[ai][bj][m][0] * rstd, v1 = acc[ai][bj][m][1] * rstd;
                if (cin >= 128) rope8(v0, v1, rope32 + ((size_t)row * 32 + ((cin - 128) >> 1)) * 2);
                *(v4u*)(q + (size_t)row * 1536 + col) = pack8(v0, v1); }
        }
    }
};
struct EpiMlaKV {
    static constexpr bool PERM = true, AFTER_DRAIN = false;
    const float* rskv; bf16* dst;
    __device__ __forceinline__ void operator()(AccRef acc, const pg8::Unit& u, int wr, int wc, int fr, int fq) const {
        EPI_ROWS { const int row = EPI_ROW; const float rstd = sum4_rstd(rskv, row, 1.f / 256.f);
#pragma unroll
            for (int bj = 0; bj < 2; ++bj) { const int col = u.pn * 256 + bj * 128 + wc * 32 + fq * 8;
                *(v4u*)(dst + (size_t)row * 1024 + col) = pack8(acc[ai][bj][m][0] * rstd, acc[ai][bj][m][1] * rstd); }
        }
    }
};
struct EpiPlain {
    static constexpr bool PERM = true, AFTER_DRAIN = false;
    bf16* dst;
    __device__ __forceinline__ void operator()(AccRef acc, const pg8::Unit& u, int wr, int wc, int fr, int fq) const {
        EPI_ROWS { const int row = EPI_ROW;
#pragma unroll
            for (int bj = 0; bj < 2; ++bj) { const int col = u.pn * 256 + bj * 128 + wc * 32 + fq * 8;
                *(v4u*)(dst + (size_t)row * 1024 + col) = pack8(acc[ai][bj][m][0], acc[ai][bj][m][1]); }
        }
    }
};
struct EpiOut {
    static constexpr bool PERM = true, AFTER_DRAIN = false;
    const float* xin; float* xout; bf16* xb; float* rs1;
    __device__ __forceinline__ void operator()(AccRef acc, const pg8::Unit& u, int wr, int wc, int fr, int fq) const {
        EPI_ROWS { const int row = EPI_ROW; float ss = 0.f;
#pragma unroll
            for (int bj = 0; bj < 2; ++bj) { const size_t o = (size_t)row * 1024 + u.pn * 256 + bj * 128 + wc * 32 + fq * 8;
                const f32x4 a0 = *(const f32x4*)(xin + o) + acc[ai][bj][m][0], a1 = *(const f32x4*)(xin + o + 4) + acc[ai][bj][m][1];
                *(f32x4*)(xout + o) = a0; *(f32x4*)(xout + o + 4) = a1; *(v4u*)(xb + o) = pack8(a0, a1); ss += sq4(a0) + sq4(a1); }
            ss += __shfl_xor(ss, 16); ss += __shfl_xor(ss, 32);
            if (fq == 0) rs1[(size_t)row * 16 + u.pn * 4 + wc] = ss;
        }
    }
};
struct EpiGate {
    static constexpr bool PERM = true, AFTER_DRAIN = false;
    const float* rs1; float* x; const bf16* pp; bf16* xb; float* rsx;
    __device__ __forceinline__ void operator()(AccRef acc, const pg8::Unit& u, int wr, int wc, int fr, int fq) const {
        EPI_ROWS { const int row = EPI_ROW; const float rstd = sum16_rstd(rs1, row, 1.f / 1024.f); float ss = 0.f;
#pragma unroll
            for (int bj = 0; bj < 2; ++bj) { const size_t o = (size_t)row * 1024 + u.pn * 256 + bj * 128 + wc * 32 + fq * 8;
                const v4u pw = *(const v4u*)(pp + o); f32x4 a0 = *(const f32x4*)(x + o), a1 = *(const f32x4*)(x + o + 4);
                const f32x4 g0 = acc[ai][bj][m][0] * rstd, g1 = acc[ai][bj][m][1] * rstd;
                a0[0] += bf2f(pw.x & 0xffffu) * sigmoid_f(g0[0]); a0[1] += bf2f(pw.x >> 16) * sigmoid_f(g0[1]);
                a0[2] += bf2f(pw.y & 0xffffu) * sigmoid_f(g0[2]); a0[3] += bf2f(pw.y >> 16) * sigmoid_f(g0[3]);
                a1[0] += bf2f(pw.z & 0xffffu) * sigmoid_f(g1[0]); a1[1] += bf2f(pw.z >> 16) * sigmoid_f(g1[1]);
                a1[2] += bf2f(pw.w & 0xffffu) * sigmoid_f(g1[2]); a1[3] += bf2f(pw.w >> 16) * sigmoid_f(g1[3]);
                *(f32x4*)(x + o) = a0; *(f32x4*)(x + o + 4) = a1; *(v4u*)(xb + o) = pack8(a0, a1); ss += sq4(a0) + sq4(a1); }
            ss += __shfl_xor(ss, 16); ss += __shfl_xor(ss, 32);
            if (fq == 0) rsx[(size_t)row * 16 + u.pn * 4 + wc] = ss;
        }
    }
};
struct EpiDsaIn {
    static constexpr bool PERM = true, AFTER_DRAIN = false;
    const float* rsx; bf16* q; bf16* k; bf16* v; bf16* qi; bf16* sz; bf16* ki; float* wi; const float* rope64; const float* rope32;
    __device__ __forceinline__ void operator()(AccRef acc, const pg8::Unit& u, int wr, int wc, int fr, int fq) const {
        const int pn = u.pn;
        EPI_ROWS { const int row = EPI_ROW; const float rstd = sum16_rstd(rsx, row, 1.f / 1024.f);
#pragma unroll
            for (int bj = 0; bj < 2; ++bj) { const int c = bj * 128 + wc * 32 + fq * 8;
                f32x4 v0 = acc[ai][bj][m][0] * rstd, v1 = acc[ai][bj][m][1] * rstd;
                if (pn < 4) { rope8(v0, v1, rope64 + ((size_t)row * 64 + ((c & 127) >> 1)) * 2); *(v4u*)(q + (size_t)row * 1024 + pn * 256 + c) = pack8(v0, v1); }
                else if (pn == 4) { rope8(v0, v1, rope64 + ((size_t)row * 64 + ((c & 127) >> 1)) * 2); *(v4u*)(k + (size_t)row * 256 + c) = pack8(v0, v1); }
                else if (pn == 5) { *(v4u*)(v + (size_t)row * 256 + c) = pack8(v0, v1); }
                else if (pn < 8) { rope8(v0, v1, rope32 + ((size_t)row * 32 + ((c & 63) >> 1)) * 2); *(v4u*)(qi + (size_t)row * 512 + (pn - 6) * 256 + c) = pack8(v0, v1); }
                else if (pn < 12) {
#pragma unroll
                    for (int e = 0; e < 4; ++e) { v0[e] = silu_f(v0[e]); v1[e] = silu_f(v1[e]); }
                    *(v4u*)(sz + (size_t)row * 1024 + (pn - 8) * 256 + c) = pack8(v0, v1); }
                else if (c < 64) { rope8(v0, v1, rope32 + ((size_t)row * 32 + (c >> 1)) * 2); *(v4u*)(ki + (size_t)row * 64 + c) = pack8(v0, v1); }
                else if (c == 64) { *(f32x4*)(wi + (size_t)row * 8) = v0; *(f32x4*)(wi + (size_t)row * 8 + 4) = v1; }
            }
        }
    }
};

__device__ __forceinline__ int src_col(int map, int n) {
    switch (map) {
    case 1:
        if (n < 512) return n; if (n < 1536) return n + 64; if (n < 1600) { const int c = n - 1536; return 512 + (c >> 1) + 32 * (c & 1); } return -1;
    case 2: {
        const int h = n / 192, c = n - h * 192; if (c < 128) return n; const int c2 = c - 128; return h * 192 + 128 + (c2 >> 1) + 32 * (c2 & 1); }
    case 3:
        if (n < 1280) { const int h = n >> 7, c = n & 127; return h * 128 + (c >> 1) + 64 * (c & 1); }
        if (n < 1536) return n;
        if (n < 2048) { const int c = n - 1536, h = c >> 6, cc = c & 63; return 1536 + h * 64 + (cc >> 1) + 32 * (cc & 1); }
        if (n < 3072) return 2120 + (n - 2048);
        if (n < 3136) { const int c = n - 3072; return 2048 + (c >> 1) + 32 * (c & 1); }
        if (n < 3144) return 2112 + (n - 3136);
        return -1;
    default: return n;
    }
}
__device__ __forceinline__ void tr_item(const float* W, int K, int N, bf16* WT, int Nout, const float* gain, int map, LAS float* scr, int item, int lane) {
    const int nblk = Nout / 32, kb = item / nblk, nb = item % nblk, k0 = 64 * kb, n0 = 32 * nb;
    const int src = src_col(map, n0 + (lane & 31));
#pragma unroll 8
    for (int i = 0; i < 32; ++i) { const int kk = 2 * i + (lane >> 5); float v = 0.f; if (src >= 0) v = W[(size_t)(k0 + kk) * N + src]; if (gain) v *= gain[k0 + kk]; scr[kk * 33 + (lane & 31)] = v; }
    LDS_WAIT(); asm volatile("" ::: "memory");
    const int c = lane & 7;
#pragma unroll
    for (int j = 0; j < 4; ++j) { const int n = (lane >> 3) + 8 * j; const LAS float* s = scr + (8 * c) * 33 + n;
        v4u o; o.x = cvtpk(s[0 * 33], s[1 * 33]); o.y = cvtpk(s[2 * 33], s[3 * 33]); o.z = cvtpk(s[4 * 33], s[5 * 33]); o.w = cvtpk(s[6 * 33], s[7 * 33]);
        *(v4u*)(WT + (size_t)(n0 + n) * K + k0 + 8 * c) = o; }
    LDS_WAIT(); asm volatile("" ::: "memory");
}

struct Args { const float* in[17]; float* out; unsigned char* ws; int ph_lo, ph_hi; };

__device__ __forceinline__ void prologue(const Args& a, LAS unsigned char* lds, int gw, int ngw, int wave, int lane) {
    bf16* Wb = (bf16*)(a.ws + WS_W);
    LAS float* scr = (LAS float*)(lds + wave * 16384);
    for (int mi = 0; mi < 22; ++mi) {
        const float* W; int K, N, Nout, map = 0; const float* gain = nullptr; bf16* WT;
        if (mi < 2)       { const int j = mi;      W = a.in[4] + (size_t)j * 1024 * 1600;  K = 1024; N = 1600; Nout = MLA_N; map = 1; gain = a.in[3] + (size_t)(2 * j) * 1024; WT = Wb + W_WINM + (size_t)j * MLA_N * 1024; }
        else if (mi < 4)  { const int j = mi - 2;  W = a.in[7] + (size_t)j * 256 * 1536;   K = 256;  N = 1536; Nout = 1536;  map = 2; gain = a.in[5] + (size_t)j * 256; WT = Wb + W_WUQ + (size_t)j * 1536 * 256; }
        else if (mi < 6)  { const int j = mi - 4;  W = a.in[8] + (size_t)j * 256 * 1024;   K = 256;  N = 1024; Nout = 1024;  gain = a.in[6] + (size_t)j * 256; WT = Wb + W_WUK + (size_t)j * 1024 * 256; }
        else if (mi < 8)  { const int j = mi - 6;  W = a.in[9] + (size_t)j * 256 * 1024;   K = 256;  N = 1024; Nout = 1024;  gain = a.in[6] + (size_t)j * 256; WT = Wb + W_WUV + (size_t)j * 1024 * 256; }
        else if (mi < 10) { const int j = mi - 8;  W = a.in[10] + (size_t)j * 1024 * 1024; K = 1024; N = 1024; Nout = 1024;  WT = Wb + W_WOM + (size_t)j * 1024 * 1024; }
        else if (mi < 12) { const int j = mi - 10; W = a.in[11] + (size_t)j * 1024 * 3144; K = 1024; N = 3144; Nout = DSA_N; map = 3; gain = a.in[3] + (size_t)(2 * j + 1) * 1024; WT = Wb + W_WIND + (size_t)j * DSA_N * 1024; }
        else if (mi < 14) { const int j = mi - 12; W = a.in[12] + (size_t)j * 1024 * 1024; K = 1024; N = 1024; Nout = 1024;  WT = Wb + W_WOD + (size_t)j * 1024 * 1024; }
        else if (mi < 18) { const int i = mi - 14; W = a.in[13] + (size_t)i * 256 * 1024;  K = 256;  N = 1024; Nout = 1024;  WT = Wb + W_WP + (size_t)i * 1024 * 256; }
        else              { const int i = mi - 18; W = a.in[15] + (size_t)i * 1024 * 1024; K = 1024; N = 1024; Nout = 1024;  gain = a.in[14] + (size_t)i * 1024; WT = Wb + W_WG + (size_t)i * 1024 * 1024; }
        const int nitems = (K / 64) * (Nout / 32);
        for (int it = gw; it < nitems; it += ngw) tr_item(W, K, N, WT, Nout, gain, map, scr, it, lane);
    }
    {
        const int* pos = (const int*)a.in[2]; float* r64 = (float*)(a.ws + WS_ROPE64); float* r32 = (float*)(a.ws + WS_ROPE32);
        const float inv64 = 1.0f / powf(10000.0f, (float)lane / 64.0f);
        const float inv32 = 1.0f / powf(10000.0f, (float)(lane & 31) / 32.0f);
        for (int t = gw; t < T; t += ngw) { const float pf = (float)pos[t];
            { const float ang = pf * inv64; const double d = (double)ang; *(float2*)(r64 + ((size_t)t * 64 + lane) * 2) = make_float2((float)cos(d), (float)sin(d)); }
            if (lane < 32) { const float ang = pf * inv32; const double d = (double)ang; *(float2*)(r32 + ((size_t)t * 32 + lane) * 2) = make_float2((float)cos(d), (float)sin(d)); }
        }
    }
    {
        const float* x = a.in[0]; bf16* xb = (bf16*)(a.ws + WS_XB0); float* rsx = (float*)(a.ws + WS_RSX);
        for (int r = gw; r < T; r += ngw) { const f32x4* xr = (const f32x4*)(x + (size_t)r * 1024) + lane; f32x4 v[4]; float s = 0.f;
#pragma unroll
            for (int j = 0; j < 4; ++j) { v[j] = xr[64 * j]; s += sq4(v[j]); }
            s = wave_sum(s);
            u32x2* o8 = (u32x2*)(xb + (size_t)r * 1024) + lane;
#pragma unroll
            for (int j = 0; j < 4; ++j) { u32x2 w; w.x = cvtpk(v[j][0], v[j][1]); w.y = cvtpk(v[j][2], v[j][3]); o8[64 * j] = w; }
            if (lane < 16) rsx[(size_t)r * 16 + lane] = lane == 0 ? s : 0.f;
        }
    }
}
__device__ __forceinline__ void convert_p(const float* p, bf16* pb, int gtid, int gthreads) {
    for (size_t i = gtid; i < (size_t)T * 256 / 8; i += gthreads) { const f32x4 a = *(const f32x4*)(p + i * 8), b = *(const f32x4*)(p + i * 8 + 4); *(v4u*)(pb + i * 8) = pack8(a, b); }
}

template <bool PE, bool MASKED>
__device__ __forceinline__ void simple_attn(int gw, int ngw, int lane, LAS float* qs, const bf16* Q, int ldq, int qhs, const bf16* Kn, int ldk, int kvdiv, const bf16* Kpe,
                                            const bf16* V, int ldv, bf16* G, const unsigned long long* mask, float scale) {
    constexpr int DQ = PE ? 192 : 128;
    for (int it = gw; it < NB * 8 * SEQ; it += ngw) {
        const int q = it % SEQ, bh = it / SEQ, h = bh & 7, b = bh >> 3; const size_t tok = (size_t)b * SEQ + q; const int hk = h / kvdiv;
        for (int d = lane; d < DQ; d += 64) qs[d] = bf2f(Q[tok * ldq + h * qhs + d]);
        LDS_WAIT(); asm volatile("" ::: "memory");
        float m = -1e30f, l = 0.f, o0 = 0.f, o1 = 0.f;
        for (int kc = 0; kc <= q; kc += 64) {
            const int key = kc + lane; bool valid = key <= q;
            if (MASKED) { const unsigned long long w = mask[tok * 64 + (kc >> 6)]; valid = valid && ((w >> lane) & 1ull); }
            float s = -__builtin_inff();
            if (valid) { const bf16* kr = Kn + ((size_t)b * SEQ + key) * ldk + hk * 128; float acc = 0.f;
                for (int d = 0; d < 128; d += 8) { const bf16x8 kv = *(const bf16x8*)(kr + d);
#pragma unroll
                    for (int e = 0; e < 8; ++e) acc += qs[d + e] * bf2f((unsigned short)kv[e]); }
                if (PE) { const bf16* kp = Kpe + ((size_t)b * SEQ + key) * 64;
                    for (int d = 0; d < 64; d += 8) { const bf16x8 kv = *(const bf16x8*)(kp + d);
#pragma unroll
                        for (int e = 0; e < 8; ++e) acc += qs[128 + d + e] * bf2f((unsigned short)kv[e]); } }
                s = acc * scale; }
            const float mx = wave_max(s), mn = fmaxf(m, mx), p = valid ? __expf(s - mn) : 0.f, al = __expf(m - mn);
            l = l * al + wave_sum(p); o0 *= al; o1 *= al; m = mn;
            for (int j = 0; j < 64; ++j) { const float pj = __builtin_bit_cast(float, __builtin_amdgcn_readlane(__builtin_bit_cast(int, p), j));
                if (pj != 0.f) { const unsigned vv = *(const unsigned*)(V + ((size_t)b * SEQ + kc + j) * ldv + hk * 128 + 2 * lane); o0 += pj * bf2f(vv & 0xffffu); o1 += pj * bf2f(vv >> 16); } }
        }
        unsigned* gp = (unsigned*)(G + tok * 1024 + h * 128 + 2 * lane); const unsigned szv = *gp; const float inv = 1.f / l;
        *gp = cvtpk(o0 * inv * bf2f(szv & 0xffffu), o1 * inv * bf2f(szv >> 16));
        LDS_WAIT(); asm volatile("" ::: "memory");
    }
}

__device__ __forceinline__ unsigned f2key(float s) { const unsigned u = __builtin_bit_cast(unsigned, s); return (u & 0x80000000u) ? ~u : (u | 0x80000000u); }
__device__ __forceinline__ void simple_topk(int blk, int nblk, int wave, int lane, LAS unsigned char* lds, const bf16* QI, const bf16* KI, const float* WI, unsigned long long* mask) {
    LAS unsigned* ky = (LAS unsigned*)lds + wave * 4096; LAS float* qf = (LAS float*)(lds + LDS_QIS) + wave * 512;
    for (int unit = blk; unit < T / 8; unit += nblk) {
        const int tok = unit * 8 + wave, b = tok / SEQ, q = tok % SEQ;
        for (int d = lane; d < 512; d += 64) qf[d] = bf2f(QI[(size_t)tok * 512 + d]);
        float wv[8];
#pragma unroll
        for (int h = 0; h < 8; ++h) wv[h] = WI[(size_t)tok * 8 + h] * 0.35355339059327373f;
        LDS_WAIT(); asm volatile("" ::: "memory");
        const int nw = (q >> 6) + 1;
        for (int j = 0; j < nw; ++j) { const int key = j * 64 + lane; unsigned uk = 0u;
            if (key <= q) { const bf16* kr = KI + ((size_t)b * SEQ + key) * 64; float kf[64];
#pragma unroll
                for (int d = 0; d < 64; d += 8) { const bf16x8 kv = *(const bf16x8*)(kr + d);
#pragma unroll
                    for (int e = 0; e < 8; ++e) kf[d + e] = bf2f((unsigned short)kv[e]); }
                float s = 0.f;
#pragma unroll
                for (int h = 0; h < 8; ++h) { float acc = 0.f;
#pragma unroll
                    for (int d = 0; d < 64; ++d) acc += qf[h * 64 + d] * kf[d];
                    s += fmaxf(acc * 0.125f, 0.f) * wv[h]; }
                s += 0.0f;
                uk = f2key(s); }
            ky[key] = uk; }
        LDS_WAIT(); asm volatile("" ::: "memory");
        unsigned long long myword = 0ull;
        if (q < 256) {
            for (int j = 0; j < nw; ++j) { const unsigned long long w = __ballot(j * 64 + lane <= q); if (lane == j) myword = w; }
        } else {
            unsigned prefix = 0u, thr = 0u; bool exact = false;
            for (int bit = 31; bit >= 0; --bit) { const unsigned t = prefix | (1u << bit); int cnt = 0;
                for (int j = 0; j < nw; ++j) cnt += (ky[j * 64 + lane] >= t) ? 1 : 0;
                cnt = __builtin_amdgcn_readfirstlane(wave_sum_i(cnt));
                if (cnt == 256) { thr = t; exact = true; break; }
                if (cnt > 256) prefix = t; }
            if (exact) {
                for (int j = 0; j < nw; ++j) { const unsigned long long w = __ballot(ky[j * 64 + lane] >= thr); if (lane == j) myword = w; }
            } else {
                thr = prefix; int cgt = 0;
                for (int j = 0; j < nw; ++j) cgt += (ky[j * 64 + lane] > thr) ? 1 : 0;
                cgt = __builtin_amdgcn_readfirstlane(wave_sum_i(cgt));
                const int need = 256 - cgt; int run = 0;
                for (int j = 0; j < nw; ++j) { const unsigned kk = ky[j * 64 + lane]; const bool eq = kk == thr; const unsigned long long beq = __ballot(eq);
                    const int rank = run + __popcll(beq & ((1ull << lane) - 1ull)); const bool sel = (kk > thr) || (eq && rank < need);
                    const unsigned long long w = __ballot(sel); if (lane == j) myword = w; run += __popcll(beq); }
            }
        }
        mask[(size_t)tok * 64 + lane] = myword;
        LDS_WAIT(); asm volatile("" ::: "memory");
    }
}

#define IN(k) (lo <= (k) && (k) < hi)
#define SEAM(k) do { if (IN(k) && IN((k) + 1)) xcd_barrier(bar); } while (0)
#define WSP(T_, off) ((T_*)(args.ws + (off)))
template <int I>
__device__ __forceinline__ void layer(const Args& args, LAS unsigned char* lds, const XcdBarrier& bar, const int lo, const int hi, const int G, const int bx, const int tid, const int wave, const int lane) {
    constexpr int k0 = 1 + 5 * I, j = I >> 1;
    const int gw = bx * NWAVES + wave, ngw = G * NWAVES;
    if constexpr ((I & 1) == 0) {
        if (IN(k0)) {
            convert_p(args.in[1] + (size_t)I * T * 256, WSP(bf16, WS_PB), bx * NWAVES * 64 + tid, G * NWAVES * 64);
            pg8::Gemm g{WSP(bf16, WS_XB0), WSP(bf16, WS_W) + W_WINM + (size_t)j * MLA_N * 1024, T, MLA_N, 1024}; pg8::StaticOrder S; S.init(T, MLA_N, G, bx);
            EpiMlaIn E{WSP(float, WS_RSX), WSP(bf16, WS_CQ), WSP(bf16, WS_CKV), WSP(bf16, WS_SZ), WSP(bf16, WS_KPE), WSP(float, WS_RSQ), WSP(float, WS_RSKV), WSP(float, WS_ROPE32)};
            pg8::gemm_phase<EpiMlaIn, pg8::StaticOrder, true, true>(lds, g, S, E);
        }
        SEAM(k0);
        if (IN(k0 + 1)) {
            { pg8::Gemm g{WSP(bf16, WS_CQ), WSP(bf16, WS_W) + W_WUQ + (size_t)j * 1536 * 256, T, 1536, 256}; pg8::StaticOrder S; S.init(T, 1536, G, bx); EpiMlaQ E{WSP(float, WS_RSQ), WSP(bf16, WS_Q), WSP(float, WS_ROPE32)};
              pg8::gemm_phase<EpiMlaQ, pg8::StaticOrder, true, true>(lds, g, S, E); }
            { pg8::Gemm g{WSP(bf16, WS_CKV), WSP(bf16, WS_W) + W_WUK + (size_t)j * 1024 * 256, T, 1024, 256}; pg8::StaticOrder S; S.init(T, 1024, G, bx); EpiMlaKV E{WSP(float, WS_RSKV), WSP(bf16, WS_KN)};
              pg8::gemm_phase<EpiMlaKV, pg8::StaticOrder, true, true>(lds, g, S, E); }
            { pg8::Gemm g{WSP(bf16, WS_CKV), WSP(bf16, WS_W) + W_WUV + (size_t)j * 1024 * 256, T, 1024, 256}; pg8::StaticOrder S; S.init(T, 1024, G, bx); EpiMlaKV E{WSP(float, WS_RSKV), WSP(bf16, WS_V)};
              pg8::gemm_phase<EpiMlaKV, pg8::StaticOrder, true, true>(lds, g, S, E); }
        }
        SEAM(k0 + 1);
        if (IN(k0 + 2)) {
            simple_attn<true, false>(gw, ngw, lane, (LAS float*)(lds + wave * 1024), WSP(bf16, WS_Q), 1536, 192, WSP(bf16, WS_KN), 1024, 1, WSP(bf16, WS_KPE), WSP(bf16, WS_V), 1024, WSP(bf16, WS_SZ), nullptr, 0.07216878364870323f);
        }
        SEAM(k0 + 2);
    } else {
        if (IN(k0)) {
            convert_p(args.in[1] + (size_t)I * T * 256, WSP(bf16, WS_PB), bx * NWAVES * 64 + tid, G * NWAVES * 64);
            pg8::Gemm g{WSP(bf16, WS_XB0), WSP(bf16, WS_W) + W_WIND + (size_t)j * DSA_N * 1024, T, DSA_N, 1024}; pg8::StaticOrder S; S.init(T, DSA_N, G, bx);
            EpiDsaIn E{WSP(float, WS_RSX), WSP(bf16, WS_Q), WSP(bf16, WS_KD), WSP(bf16, WS_VD), WSP(bf16, WS_QI), WSP(bf16, WS_SZ), WSP(bf16, WS_KI), WSP(float, WS_WI), WSP(float, WS_ROPE64), WSP(float, WS_ROPE32)};
            pg8::gemm_phase<EpiDsaIn, pg8::StaticOrder, true, true>(lds, g, S, E);
        }
        SEAM(k0);
        if (IN(k0 + 1)) { simple_topk(bx, G, wave, lane, lds, WSP(bf16, WS_QI), WSP(bf16, WS_KI), WSP(float, WS_WI), WSP(unsigned long long, WS_MASK)); }
        SEAM(k0 + 1);
        if (IN(k0 + 2)) {
            simple_attn<false, true>(gw, ngw, lane, (LAS float*)(lds + wave * 1024), WSP(bf16, WS_Q), 1024, 128, WSP(bf16, WS_KD), 256, 4, nullptr, WSP(bf16, WS_VD), 256, WSP(bf16, WS_SZ), WSP(unsigned long long, WS_MASK), 0.08838834764831845f);
        }
        SEAM(k0 + 2);
    }
    if (IN(k0 + 3)) {
        { pg8::Gemm g{WSP(bf16, WS_PB), WSP(bf16, WS_W) + W_WP + (size_t)I * 1024 * 256, T, 1024, 256}; pg8::StaticOrder S; S.init(T, 1024, G, bx); EpiPlain E{WSP(bf16, WS_PP)};
          pg8::gemm_phase<EpiPlain, pg8::StaticOrder, true, true>(lds, g, S, E); }
        { pg8::Gemm g{WSP(bf16, WS_SZ), WSP(bf16, WS_W) + ((I & 1) ? W_WOD : W_WOM) + (size_t)j * 1024 * 1024, T, 1024, 1024}; pg8::StaticOrder S; S.init(T, 1024, G, bx);
          EpiOut E{I == 0 ? args.in[0] : args.out, args.out, WSP(bf16, WS_XB1), WSP(float, WS_RS1)};
          pg8::gemm_phase<EpiOut, pg8::StaticOrder, true, true>(lds, g, S, E); }
    }
    SEAM(k0 + 3);
    if (IN(k0 + 4)) {
        pg8::Gemm g{WSP(bf16, WS_XB1), WSP(bf16, WS_W) + W_WG + (size_t)I * 1024 * 1024, T, 1024, 1024}; pg8::StaticOrder S; S.init(T, 1024, G, bx);
        EpiGate E{WSP(float, WS_RS1), args.out, WSP(bf16, WS_PP), WSP(bf16, WS_XB0), WSP(float, WS_RSX)};
        pg8::gemm_phase<EpiGate, pg8::StaticOrder, true, true>(lds, g, S, E);
    }
    SEAM(k0 + 4);
}

__global__ void __launch_bounds__(NWAVES * 64, 2) fwd(Args args) {
    extern __shared__ __attribute__((aligned(16))) unsigned char lds_raw[];
    LAS unsigned char* lds = (LAS unsigned char*)lds_raw;
    volatile LAS unsigned* MISC = (volatile LAS unsigned*)(lds + MISC_OFF);
    const int tid = threadIdx.x, lane = tid & 63, wave = __builtin_amdgcn_readfirstlane(tid >> 6);
    const int G = gridDim.x, bx = blockIdx.x;
    for (int u = tid; u < (LDS_BYTES - MISC_OFF) / 4; u += NWAVES * 64) ((LAS unsigned*)(lds + MISC_OFF))[u] = 0u;
    __syncthreads();
    const int lo = args.ph_lo, hi = args.ph_hi;
    XcdBarrier bar; bar.bar = (unsigned*)(args.ws + WS_CTL) + CW_BAR; bar.x = 0; bar.st = nullptr;
    if (hi - lo > 1) bar = xcd_barrier_post((unsigned*)(args.ws + WS_CTL) + CW_BAR, MISC + 8);

    if (IN(0)) { prologue(args, lds, bx * NWAVES + wave, G * NWAVES, wave, lane); }
    SEAM(0);
    layer<0>(args, lds, bar, lo, hi, G, bx, tid, wave, lane);
    layer<1>(args, lds, bar, lo, hi, G, bx, tid, wave, lane);
    layer<2>(args, lds, bar, lo, hi, G, bx, tid, wave, lane);
    layer<3>(args, lds, bar, lo, hi, G, bx, tid, wave, lane);
    if (IN(21)) {
        const int gw = bx * NWAVES + wave, ngw = G * NWAVES;
        const float* fg = args.in[16]; f32x4 gv[4];
#pragma unroll
        for (int jj = 0; jj < 4; ++jj) gv[jj] = ((const f32x4*)fg)[lane + 64 * jj];
        for (int r = gw; r < T; r += ngw) { f32x4* xr = (f32x4*)(args.out + (size_t)r * 1024) + lane; f32x4 v[4]; float s = 0.f;
#pragma unroll
            for (int jj = 0; jj < 4; ++jj) { v[jj] = xr[64 * jj]; s += sq4(v[jj]); }
            const float rstd = rsqrtf(wave_sum(s) * (1.f / 1024.f) + NORM_EPS);
#pragma unroll
            for (int jj = 0; jj < 4; ++jj) xr[64 * jj] = v[jj] * rstd * gv[jj]; }
    }
}
#undef IN
#undef SEAM

#ifndef ONE_LAUNCH
#define ONE_LAUNCH 0
#endif
extern "C" void kernel_launch(void* const* d_in, const int* in_sizes, int n_in, void* d_out, int out_size, void* d_ws, size_t ws_size, hipStream_t stream) {
    static int grid = 0;
    if (grid == 0) {
        if (n_in != 17 || out_size != T * DM || ws_size < WS_END) { fprintf(stderr, "kernel_launch: unexpected shapes (n_in %d, out %d, ws %zu)\n", n_in, out_size, ws_size); grid = -1; return; }
        int dev = 0, cus = 0, per_cu = 0;
        if (hipGetDevice(&dev) != hipSuccess || hipDeviceGetAttribute(&cus, hipDeviceAttributeMultiprocessorCount, dev) != hipSuccess) { grid = -1; return; }
        if (hipFuncSetAttribute((const void*)fwd, hipFuncAttributeMaxDynamicSharedMemorySize, LDS_BYTES) != hipSuccess) { fprintf(stderr, "kernel_launch: hipFuncSetAttribute failed\n"); grid = -1; return; }
        if (hipOccupancyMaxActiveBlocksPerMultiprocessor(&per_cu, (const void*)fwd, NWAVES * 64, LDS_BYTES) != hipSuccess || per_cu < 1) fprintf(stderr, "kernel_launch: occupancy query says %d\n", per_cu);
        (void)hipGetLastError();
        grid = cus;
    }
    if (grid < 0) return;
    (void)hipMemsetAsync((char*)d_ws + WS_CTL, 0, CTL_ZERO_BYTES, stream);
    Args a{};
    for (int i = 0; i < 17; ++i) a.in[i] = (const float*)d_in[i];
    a.out = (float*)d_out; a.ws = (unsigned char*)d_ws;
    if (ONE_LAUNCH) { a.ph_lo = 0; a.ph_hi = NPHASE; hipLaunchKernelGGL(fwd, dim3(grid), dim3(NWAVES * 64), LDS_BYTES, stream, a); }
    else for (int ph = 0; ph < NPHASE; ++ph) { a.ph_lo = ph; a.ph_hi = ph + 1; hipLaunchKernelGGL(fwd, dim3(grid), dim3(NWAVES * 64), LDS_BYTES, stream, a); }
}
```

```cpp
#include <hip/hip_runtime.h>
#include <cstdio>
#include <cstdint>
namespace pg8 {
#define PG8_LAS __attribute__((address_space(3)))
typedef unsigned short bf16_t;
typedef short bf16x8 __attribute__((ext_vector_type(8)));
typedef float f32x4 __attribute__((ext_vector_type(4)));
typedef unsigned u32x4 __attribute__((ext_vector_type(4)));
constexpr int BM = 256, BK = 64, HALF = 128, HTB = HALF * BK * 2  , STAGE_BYTES = 8 * HTB, NXCD = 8, WGM = 8;

__host__ __device__ __forceinline__ int lds_byte(int r, int c) { const int st = (r >> 4) * 2 + (c >> 5), rr = r & 15, cc = c & 31, ob = rr * 64 + cc * 2; return st * 1024 + (ob ^ (((ob >> 9) & 1) << 5)); }
__host__ __device__ __forceinline__ void stage_rc(int b, int& R, int& C) { const int st = b / 1024, sb = b % 1024, swz = sb ^ (((sb >> 9) & 1) << 5); R = (st >> 1) * 16 + swz / 64; C = (st & 1) * 32 + (swz % 64) / 2; }
__host__ __device__ __forceinline__ int perm32(int rho) { const int n = rho >> 4, i = rho & 15; return 8 * (i >> 2) + 4 * n + (i & 3); }

struct Unit { int pm, pn; };
struct Gemm { const bf16_t* A; const bf16_t* Bt; int M, N, K; };

struct StaticOrder {
    int nM, nN, nwg, G, c;
    __host__ __device__ void init(int M, int N, int G_, int c_) { nM = M / BM; nN = N / BM; nwg = nM * nN; G = G_; c = c_; }
    __host__ __device__ bool next(int i, Unit& u) const {
        const long L = (long)i * G + c; if (L >= nwg) return false;
        int wgid = (int)L; { const int q = nwg / NXCD, r = nwg % NXCD, xcd = wgid % NXCD, off = wgid / NXCD; wgid = (xcd < r ? xcd * (q + 1) : r * (q + 1) + (xcd - r) * q) + off; }
        const int nig = WGM * nN, gid = wgid / nig, fm = gid * WGM, gsz = (nM - fm) < WGM ? (nM - fm) : WGM;
        u.pm = fm + ((wgid % nig) % gsz); u.pn = (wgid % nig) / gsz; return true;
    }
    __device__ __forceinline__ void a_ready(const Unit&) const {}
    __device__ __forceinline__ void done(const Unit&) const {}
};

__device__ __forceinline__ unsigned cvt_pk_bf16(float lo, float hi) { unsigned r; asm volatile("v_cvt_pk_bf16_f32 %0, %1, %2" : "=v"(r) : "v"(lo), "v"(hi)); return r; }
typedef float f32x2 __attribute__((ext_vector_type(2)));
template <class Epi, class Sched, bool ALIGN_EPI = false, bool SP2 = false>
__device__ __forceinline__ void gemm_phase(PG8_LAS unsigned char* lds, const Gemm g, const Sched& S, const Epi& E) {
    const int tid = threadIdx.x, wid = __builtin_amdgcn_readfirstlane(tid >> 6), lane = tid & 63, wr = wid >> 2, wc = wid & 3, fr = lane & 15, fq = lane >> 4;
    const int K = g.K, nt = K / BK;
    unsigned voffA[2], voffB[2];
#pragma unroll
    for (int i = 0; i < 2; ++i) { int R, C; stage_rc(tid * 16 + i * 8192, R, C); const int Rb = Epi::PERM ? ((R & ~31) + perm32(R & 31)) : R;
        voffA[i] = (unsigned)(R * K + C) * 2u; voffB[i] = (unsigned)(Rb * K + C) * 2u; }
    const size_t kstep = (size_t)(BK * 2);
    const size_t hstep = (size_t)HALF * K * 2;
    const size_t tstep = 2 * hstep;
    const unsigned ldsw = (unsigned)wid * 1024u;
    const int aoff = lds_byte(wr * 64 + fr, fq * 8), boff = lds_byte(wc * 32 + fr, fq * 8);
#define PG8_SA(b, h) (((b) * 2 + (h)) * HTB)
#define PG8_SB(b, h) ((4 + (b) * 2 + (h)) * HTB)
#define PG8_STAGE(bufoff, gbase, voff) do { _Pragma("unroll") for (int _i = 0; _i < 2; ++_i) \
        __builtin_amdgcn_global_load_lds((const unsigned*)((const char*)(gbase) + (voff)[_i]), (PG8_LAS unsigned*)(lds + (bufoff) + ldsw + _i * 8192), 16, 0, 0); } while (0)
#define PG8_LDA(dst, b, h) do { _Pragma("unroll") for (int m = 0; m < 4; ++m) _Pragma("unroll") for (int k = 0; k < 2; ++k) dst[m][k] = *(const PG8_LAS bf16x8*)(lds + PG8_SA(b, h) + aoff + m * 2048 + k * 1024); } while (0)
#define PG8_LDB(dst, b, h) do { _Pragma("unroll") for (int n = 0; n < 2; ++n) _Pragma("unroll") for (int k = 0; k < 2; ++k) dst[n][k] = *(const PG8_LAS bf16x8*)(lds + PG8_SB(b, h) + boff + n * 2048 + k * 1024); } while (0)
#define PG8_MMA(ai, bj, At, Bt) do { __builtin_amdgcn_s_setprio(1); _Pragma("unroll") for (int m = 0; m < 4; ++m) _Pragma("unroll") for (int n = 0; n < 2; ++n) _Pragma("unroll") for (int k = 0; k < 2; ++k) \
        acc[ai][bj][m][n] = __builtin_amdgcn_mfma_f32_16x16x32_bf16(Bt[n][k], At[m][k], acc[ai][bj][m][n], 0, 0, 0); __builtin_amdgcn_s_setprio(0); } while (0)
#define PG8_WAIT_V(n) asm volatile("s_waitcnt vmcnt(" #n ")" ::: "memory")
#define PG8_WAIT_L(n) asm volatile("s_waitcnt lgkmcnt(" #n ")" ::: "memory")
#define PG8_BAR __builtin_amdgcn_s_barrier()
#define PG8_SCHED __builtin_amdgcn_sched_barrier(0)
    Unit cur, nxt; int ui = 0;
    if (!S.next(0, cur)) return;
    f32x4 acc[2][2][4][2];
#pragma unroll
    for (int a = 0; a < 2; ++a)
#pragma unroll
        for (int b = 0; b < 2; ++b)
#pragma unroll
            for (int m = 0; m < 4; ++m)
#pragma unroll
                for (int n = 0; n < 2; ++n) acc[a][b][m][n] = (f32x4){0.f, 0.f, 0.f, 0.f};
    bf16x8 At[4][2], B0[2][2], B1[2][2];
    const char* cA = (const char*)g.A + (size_t)cur.pm * tstep; const char* cB = (const char*)g.Bt + (size_t)cur.pn * tstep;
    S.a_ready(cur);
    if constexpr (SP2) {
        PG8_STAGE(PG8_SB(0, 0), cB, voffB); PG8_STAGE(PG8_SB(0, 1), cB + hstep, voffB); PG8_STAGE(PG8_SA(0, 0), cA, voffA); PG8_STAGE(PG8_SA(0, 1), cA + hstep, voffA);
        if (wr == 1) PG8_BAR;
        PG8_WAIT_V(2); PG8_BAR;
        PG8_STAGE(PG8_SB(1, 0), cB + kstep, voffB); PG8_STAGE(PG8_SA(1, 0), cA + kstep, voffA); PG8_STAGE(PG8_SB(1, 1), cB + hstep + kstep, voffB);
        PG8_WAIT_V(6); PG8_BAR;
    } else {
        PG8_STAGE(PG8_SB(0, 0), cB, voffB); PG8_STAGE(PG8_SA(0, 0), cA, voffA); PG8_STAGE(PG8_SB(0, 1), cB + hstep, voffB); PG8_STAGE(PG8_SA(0, 1), cA + hstep, voffA);
        if (wr == 1) PG8_BAR;
        PG8_WAIT_V(4); PG8_BAR;
        PG8_STAGE(PG8_SB(1, 0), cB + kstep, voffB); PG8_STAGE(PG8_SA(1, 0), cA + kstep, voffA); PG8_STAGE(PG8_SB(1, 1), cB + hstep + kstep, voffB);
        PG8_WAIT_V(6); PG8_BAR;
    }
    for (;;) {
        const bool has_next = S.next(ui + 1, nxt);
        const char* nA = has_next ? (const char*)g.A + (size_t)nxt.pm * tstep : cA; const char* nB = has_next ? (const char*)g.Bt + (size_t)nxt.pn * tstep : cB;
        _Pragma("nounroll") for (int t = 0; t < nt; t += 2) {
            const bool last = (t == nt - 2);
            const char* a1 = cA + (size_t)(t + 1) * kstep;
            const char* a2 = last ? nA : cA + (size_t)(t + 2) * kstep; const char* b2 = last ? nB : cB + (size_t)(t + 2) * kstep;
            const char* a3 = a2 + kstep; const char* b3 = b2 + kstep;
            if (last && has_next) S.a_ready(nxt);
            if constexpr (SP2) {
            PG8_LDB(B0, 0, 0); PG8_LDB(B1, 0, 1); PG8_SCHED; PG8_LDA(At, 0, 0); PG8_STAGE(PG8_SA(1, 1), a1 + hstep, voffA);
            PG8_WAIT_V(8); PG8_WAIT_L(0); PG8_BAR; PG8_MMA(0, 0, At, B0); PG8_MMA(0, 1, At, B1); PG8_BAR; PG8_SCHED;
            PG8_LDA(At, 0, 1); PG8_STAGE(PG8_SB(0, 0), b2, voffB); PG8_STAGE(PG8_SB(0, 1), b2 + hstep, voffB); PG8_STAGE(PG8_SA(0, 0), a2, voffA);
            PG8_WAIT_V(8); PG8_WAIT_L(0); PG8_BAR; PG8_MMA(1, 0, At, B0); PG8_MMA(1, 1, At, B1); PG8_BAR; PG8_SCHED;
            PG8_LDB(B0, 1, 0); PG8_LDB(B1, 1, 1); PG8_SCHED; PG8_LDA(At, 1, 0); PG8_STAGE(PG8_SA(0, 1), a2 + hstep, voffA);
            PG8_WAIT_V(8); PG8_WAIT_L(0); PG8_BAR; PG8_MMA(0, 0, At, B0); PG8_MMA(0, 1, At, B1); PG8_BAR; PG8_SCHED;
            PG8_LDA(At, 1, 1); PG8_STAGE(PG8_SB(1, 0), b3, voffB); PG8_STAGE(PG8_SB(1, 1), b3 + hstep, voffB); PG8_STAGE(PG8_SA(1, 0), a3, voffA);
            PG8_WAIT_V(8); PG8_WAIT_L(0); PG8_BAR; PG8_MMA(1, 0, At, B0); PG8_MMA(1, 1, At, B1); PG8_BAR; PG8_SCHED;
            } else {
            PG8_LDB(B0, 0, 0); PG8_SCHED; PG8_LDA(At, 0, 0); PG8_STAGE(PG8_SA(1, 1), a1 + hstep, voffA);
            PG8_WAIT_L(8); PG8_BAR; PG8_WAIT_L(0); PG8_MMA(0, 0, At, B0); PG8_BAR; PG8_SCHED;
            PG8_LDB(B1, 0, 1); PG8_STAGE(PG8_SB(0, 0), b2, voffB);
            PG8_BAR; PG8_WAIT_L(0); PG8_MMA(0, 1, At, B1); PG8_BAR;
            PG8_LDA(At, 0, 1); PG8_STAGE(PG8_SA(0, 0), a2, voffA);
            PG8_BAR; PG8_WAIT_L(0); PG8_MMA(1, 0, At, B0); PG8_BAR; PG8_SCHED;
            PG8_STAGE(PG8_SB(0, 1), b2 + hstep, voffB);
            PG8_WAIT_V(6); PG8_BAR; PG8_MMA(1, 1, At, B1); PG8_BAR;
            PG8_LDB(B0, 1, 0); PG8_SCHED; PG8_LDA(At, 1, 0); PG8_STAGE(PG8_SA(0, 1), a2 + hstep, voffA);
            PG8_WAIT_L(8); PG8_BAR; PG8_WAIT_L(0); PG8_MMA(0, 0, At, B0); PG8_BAR; PG8_SCHED;
            PG8_LDB(B1, 1, 1); PG8_STAGE(PG8_SB(1, 0), b3, voffB);
            PG8_BAR; PG8_WAIT_L(0); PG8_MMA(0, 1, At, B1); PG8_BAR;
            PG8_LDA(At, 1, 1); PG8_STAGE(PG8_SA(1, 0), a3, voffA);
            PG8_BAR; PG8_WAIT_L(0); PG8_MMA(1, 0, At, B0); PG8_BAR; PG8_SCHED;
            PG8_STAGE(PG8_SB(1, 1), b3 + hstep, voffB);
            PG8_WAIT_V(6); PG8_BAR; PG8_MMA(1, 1, At, B1); PG8_BAR;
            }
        }
        if constexpr (ALIGN_EPI) { if (wr == 0) PG8_BAR; }
        if constexpr (!Epi::AFTER_DRAIN) { E(acc, cur, wr, wc, fr, fq); S.done(cur); }
        if (!has_next) break;
#pragma unroll
        for (int a = 0; a < 2; ++a)
#pragma unroll
            for (int b = 0; b < 2; ++b)
#pragma unroll
                for (int m = 0; m < 4; ++m)
#pragma unroll
                    for (int n = 0; n < 2; ++n) acc[a][b][m][n] = (f32x4){0.f, 0.f, 0.f, 0.f};
        cur = nxt; cA = nA; cB = nB; ++ui;
        if constexpr (ALIGN_EPI) { if (wr == 1) PG8_BAR; }
    }
    PG8_WAIT_V(0);
    if constexpr (!ALIGN_EPI) { if (wr == 0) PG8_BAR; }
    PG8_BAR;
    if constexpr (Epi::AFTER_DRAIN) { E.fused(acc, cur, wr, wc, fr, fq, lds, wid, lane); S.done(cur); }
#undef PG8_SA
#undef PG8_SB
#undef PG8_STAGE
#undef PG8_LDA
#undef PG8_LDB
#undef PG8_MMA
#undef PG8_WAIT_V
#undef PG8_WAIT_L
#undef PG8_BAR
#undef PG8_SCHED
}
}
constexpr int NB = 16, SEQ = 4096, T = NB * SEQ, DM = 1024, DEPTH = 4;
constexpr int MLA_N = 1792;
constexpr int DSA_N = 3328;
constexpr float NORM_EPS = 1e-6f;
constexpr int NPHASE = 22;

constexpr size_t MiB = 1u << 20;
constexpr size_t WS_CTL = 0, CTL_ZERO_BYTES = 1 * MiB;
constexpr size_t WS_W = 2 * MiB;
constexpr size_t W_WINM = 0, W_WUQ = W_WINM + 2ull * MLA_N * 1024, W_WUK = W_WUQ + 2ull * 1536 * 256, W_WUV = W_WUK + 2ull * 1024 * 256,
                 W_WOM = W_WUV + 2ull * 1024 * 256, W_WIND = W_WOM + 2ull * 1024 * 1024, W_WOD = W_WIND + 2ull * DSA_N * 1024,
                 W_WP = W_WOD + 2ull * 1024 * 1024, W_WG = W_WP + 4ull * 1024 * 256, W_END = W_WG + 4ull * 1024 * 1024;
static_assert(WS_W + W_END * 2 <= 46 * MiB, "weights");
constexpr size_t WS_ROPE64 = 48 * MiB, WS_ROPE32 = 80 * MiB;
constexpr size_t WS_RSX = 96 * MiB, WS_RS1 = 100 * MiB, WS_RSQ = 104 * MiB, WS_RSKV = 105 * MiB;
constexpr size_t WS_PB = 112 * MiB;
constexpr size_t WS_XB0 = 144 * MiB;
constexpr size_t WS_SZ = 272 * MiB;
constexpr size_t WS_CQ = 400 * MiB, WS_CKV = 432 * MiB, WS_KPE = 464 * MiB;
constexpr size_t WS_QI = 400 * MiB, WS_KI = 464 * MiB, WS_WI = 472 * MiB;
constexpr size_t WS_Q = 480 * MiB;
constexpr size_t WS_PP = 480 * MiB;
constexpr size_t WS_KN = 672 * MiB, WS_V = 800 * MiB;
constexpr size_t WS_KD = 672 * MiB, WS_VD = 704 * MiB, WS_MASK = 736 * MiB;
constexpr size_t WS_XB1 = 672 * MiB;
constexpr size_t WS_END = 928 * MiB;
constexpr int CW_BAR = 4096;

constexpr int RING_BYTES = 131072;
constexpr int LDS_QIS = 131072;
constexpr int MISC_OFF = 159744;
constexpr int LDS_BYTES = 159744 + 512;
constexpr int NWAVES = 8;

#define GAS __attribute__((address_space(1)))
#define LAS __attribute__((address_space(3)))
typedef unsigned short bf16;
typedef unsigned v4u __attribute__((ext_vector_type(4)));
typedef float f32x4 __attribute__((ext_vector_type(4)));
typedef short bf16x8 __attribute__((ext_vector_type(8)));
typedef GAS unsigned gu32;
#define LDS_WAIT() asm volatile("s_waitcnt lgkmcnt(0)" ::: "memory")
#define VM_WAIT() asm volatile("s_waitcnt vmcnt(0)" ::: "memory")
__device__ __forceinline__ unsigned f2bf(float f) { unsigned u = __builtin_bit_cast(unsigned, f); return (u + 0x7fffu + ((u >> 16) & 1u)) >> 16; }
#define XB_TMO      128
#define XB_XCNT(j)  (256  + 64 * (j))
#define XB_XSUB(j)  (1280 + 64 * (j))
#define XB_XGEN(j)  (2304 + 64 * (j))
#define XB_TOP      3328
#define XB_TOPGEN   3392
#define XCD_BAR_WORDS 3456
#define XB_SPIN_CAP (1u << 25)

__device__ __forceinline__ unsigned xb_ld(unsigned* p)              { return __hip_atomic_load(p, __ATOMIC_RELAXED, __HIP_MEMORY_SCOPE_AGENT); }
__device__ __forceinline__ unsigned xb_add(unsigned* p, unsigned v) { return __hip_atomic_fetch_add(p, v, __ATOMIC_RELAXED, __HIP_MEMORY_SCOPE_AGENT); }
__device__ __forceinline__ unsigned xb_xcc_id() { return (unsigned)__builtin_amdgcn_s_getreg((3 << 11) | 20) & 0xFu; }
#define XB_SPIN(cond, bar) do { unsigned _sp = 0; while (cond) { __builtin_amdgcn_s_sleep(1); \
    if ((++_sp & 255u) == 0u) { if (xb_ld(&(bar)[XB_TMO])) break; if (_sp > XB_SPIN_CAP) { atomicAdd(&(bar)[XB_TMO], 1u); break; } } } } while (0)

struct XcdBarrier {
    unsigned* bar; unsigned x;
    volatile LAS unsigned* st;
};

__device__ __forceinline__ XcdBarrier xcd_barrier_post(unsigned* bar, volatile LAS unsigned* st) {
    XcdBarrier b; b.bar = bar; b.x = xb_xcc_id(); b.st = st;
    if (threadIdx.x == 0) (void)xb_add(&bar[XB_XCNT(b.x)], 1u);
    return b;
}
__device__ __forceinline__ void xcd_barrier_complete(unsigned* bar, unsigned x, unsigned& nloc, unsigned& nx) {
    const unsigned G = gridDim.x * gridDim.y * gridDim.z;
    unsigned sum, cnt, mine, sp = 0u;
    for (;;) {
        sum = 0u; cnt = 0u; mine = 0u;
#pragma unroll
        for (unsigned j = 0; j < 16; ++j) { const unsigned c = xb_ld(&bar[XB_XCNT(j)]); sum += c; cnt += (c > 0u) ? 1u : 0u; mine = (j == x) ? c : mine; }
        if (sum == G) break;
        __builtin_amdgcn_s_sleep(1);
        if ((++sp & 255u) == 0u) { if (xb_ld(&bar[XB_TMO])) break; if (sp > XB_SPIN_CAP) { atomicAdd(&bar[XB_TMO], 1u); break; } }
    }
    nloc = mine > 0u ? mine : 1u; nx = cnt > 0u ? cnt : 1u;
}

__device__ __forceinline__ void xcd_barrier(const XcdBarrier& b) {
    asm volatile("s_waitcnt vmcnt(0)" ::: "memory");
    __syncthreads();
    if (threadIdx.x == 0) {
        unsigned* bar = b.bar;
        __builtin_amdgcn_s_waitcnt(0);
        unsigned nloc = b.st[0], nx = b.st[1];
        if (nloc == 0u) { xcd_barrier_complete(bar, b.x, nloc, nx); b.st[0] = nloc; b.st[1] = nx; }
        const unsigned old = xb_add(&bar[XB_XSUB(b.x)], 1u);
        const unsigned gen = old / nloc;
        if (old + 1u == (gen + 1u) * nloc) {
            __builtin_amdgcn_fence(__ATOMIC_RELEASE, "agent");
            asm volatile("s_waitcnt vmcnt(0)" ::: "memory");
            const unsigned og = xb_add(&bar[XB_TOP], 1u);
            const unsigned tg = og / nx;
            if (og + 1u == (tg + 1u) * nx) xb_add(&bar[XB_TOPGEN], 1u);
            else XB_SPIN(xb_ld(&bar[XB_TOPGEN]) == tg, bar);
            __builtin_amdgcn_fence(__ATOMIC_ACQUIRE, "agent");
            xb_add(&bar[XB_XGEN(b.x)], 1u);
            asm volatile("s_waitcnt vmcnt(0)" ::: "memory");
        } else {
            XB_SPIN(xb_ld(&bar[XB_XGEN(b.x)]) == gen, bar);
            __builtin_amdgcn_fence(__ATOMIC_ACQUIRE, "agent");
            asm volatile("s_waitcnt vmcnt(0)" ::: "memory");
        }
    }
    __syncthreads();
}


typedef unsigned u32x2 __attribute__((ext_vector_type(2)));
__device__ __forceinline__ float bf2f(unsigned h) { return __builtin_bit_cast(float, h << 16); }
typedef __bf16 bf16x2_t __attribute__((ext_vector_type(2)));
typedef float f32x2_t __attribute__((ext_vector_type(2)));
__device__ __forceinline__ unsigned cvtpk(float lo, float hi) { const f32x2_t v = {lo, hi}; return __builtin_bit_cast(unsigned, __builtin_convertvector(v, bf16x2_t)); }
__device__ __forceinline__ v4u pack8(f32x4 a, f32x4 b) { v4u w; w.x = cvtpk(a[0], a[1]); w.y = cvtpk(a[2], a[3]); w.z = cvtpk(b[0], b[1]); w.w = cvtpk(b[2], b[3]); return w; }
__device__ __forceinline__ float wave_sum(float v) {
#pragma unroll
    for (int o = 1; o < 64; o <<= 1) v += __shfl_xor(v, o);
    return v;
}
__device__ __forceinline__ float wave_max(float v) {
#pragma unroll
    for (int o = 1; o < 64; o <<= 1) v = fmaxf(v, __shfl_xor(v, o));
    return v;
}
__device__ __forceinline__ int wave_sum_i(int v) {
#pragma unroll
    for (int o = 1; o < 64; o <<= 1) v += __shfl_xor(v, o);
    return v;
}
__device__ __forceinline__ float sum16_rstd(const float* rs, int row, float invn) {
    const f32x4* p = (const f32x4*)(rs + (size_t)row * 16); const f32x4 a = p[0], b = p[1], c = p[2], d = p[3];
    const float s = ((a[0] + a[1]) + (a[2] + a[3])) + ((b[0] + b[1]) + (b[2] + b[3])) + ((c[0] + c[1]) + (c[2] + c[3])) + ((d[0] + d[1]) + (d[2] + d[3]));
    return rsqrtf(s * invn + NORM_EPS);
}
__device__ __forceinline__ float sum4_rstd(const float* rs, int row, float invn) {
    const f32x4 a = *(const f32x4*)(rs + (size_t)row * 4); return rsqrtf(((a[0] + a[1]) + (a[2] + a[3])) * invn + NORM_EPS);
}
__device__ __forceinline__ float silu_f(float v) { return v * __builtin_amdgcn_rcpf(1.f + __expf(-v)); }
__device__ __forceinline__ float sigmoid_f(float v) { return __builtin_amdgcn_rcpf(1.f + __expf(-v)); }
__device__ __forceinline__ float sq4(f32x4 v) { return (v[0] * v[0] + v[1] * v[1]) + (v[2] * v[2] + v[3] * v[3]); }
__device__ __forceinline__ void rope8(f32x4& v0, f32x4& v1, const f32x4 c0, const f32x4 c1) {
    f32x4 o0, o1;
    o0[0] = v0[0] * c0[0] - v0[1] * c0[1]; o0[1] = v0[1] * c0[0] + v0[0] * c0[1];
    o0[2] = v0[2] * c0[2] - v0[3] * c0[3]; o0[3] = v0[3] * c0[2] + v0[2] * c0[3];
    o1[0] = v1[0] * c1[0] - v1[1] * c1[1]; o1[1] = v1[1] * c1[0] + v1[0] * c1[1];
    o1[2] = v1[2] * c1[2] - v1[3] * c1[3]; o1[3] = v1[3] * c1[2] + v1[2] * c1[3];
    v0 = o0; v1 = o1;
}
typedef _Float16 f16x2_t __attribute__((ext_vector_type(2)));
__device__ __forceinline__ unsigned pack_cs(float c, float sn) { const f16x2_t h = {(_Float16)c, (_Float16)sn}; return __builtin_bit_cast(unsigned, h); }
__device__ __forceinline__ f16x2_t as_h2(unsigned u) { return __builtin_bit_cast(f16x2_t, u); }
__device__ __forceinline__ void rope8h(f32x4& v0, f32x4& v1, const v4u w) {
    f32x4 c0, c1;
#pragma unroll
    for (int e = 0; e < 2; ++e) { const f16x2_t a = as_h2(w[e]), b = as_h2(w[2 + e]);
        c0[2 * e] = (float)a[0]; c0[2 * e + 1] = (float)a[1]; c1[2 * e] = (float)b[0]; c1[2 * e + 1] = (float)b[1]; }
    rope8(v0, v1, c0, c1);
}


namespace att {
constexpr int NW = 8, QBLK = 32, KVBLK = 64, QB = NW * QBLK, D = 128;
constexpr int KROW = D * 2 + 16, SHM_V = KVBLK * D * 2, SHM_K = KVBLK * KROW, KPROW = 144, SHM_KP = KVBLK * KPROW;
constexpr int OFF_V = 0, OFF_K = 2 * SHM_V, OFF_WS = OFF_K + 2 * SHM_K, OFF_KP = OFF_WS + NW * 64 * 4, OFF_QP = OFF_KP + 2 * SHM_KP, LDS_NEED = OFF_QP + NW * QBLK * 272;
constexpr float THR = 8.f;
typedef short s16x4 __attribute__((ext_vector_type(4)));
typedef float f32x16 __attribute__((ext_vector_type(16)));

#define KSWZ(row, colB) ((row) * KROW + (colB))
#define KPSWZ(row, ch) ((row) * KPROW + ((ch) << 4))
#define SBAR() __builtin_amdgcn_sched_barrier(0)
__device__ __forceinline__ int v_st(int k, int c) { const int kk = (k & ~0xC) | ((k & 4) << 1) | ((k & 8) >> 1); return ((kk >> 3) * 4 + (c >> 5)) * 512 + ((kk & 7) * 32 + (c & 31)) * 2; }
__device__ __forceinline__ int v_rd_base(int lane) { return ((lane & 3) << 3) | (((lane >> 2) & 3) << 6) | (((lane >> 4) & 1) << 5) | (((lane >> 5) & 1) << 8); }
constexpr int v_rd_off(int d0, int ks, int half) { return d0 * 512 + ks * 4096 + half * 2048; }
__device__ __forceinline__ int crow(int r, int hi) { return (r & 3) + 8 * (r >> 2) + 4 * hi; }
__device__ __forceinline__ bf16x8 load8(const bf16* p) { return *reinterpret_cast<const bf16x8*>(p); }
__device__ __forceinline__ unsigned long long gld_u64(const unsigned long long* ubase, unsigned voff) {
    const unsigned long long b_ = (unsigned long long)ubase;
    const unsigned lo_ = __builtin_amdgcn_readfirstlane((unsigned)b_), hi_ = __builtin_amdgcn_readfirstlane((unsigned)(b_ >> 32));
    __amdgpu_buffer_rsrc_t r_ = __builtin_amdgcn_make_buffer_rsrc((void*)(((unsigned long long)hi_ << 32) | lo_), (short)0, 0x7fffffff, 0x00020000);
    typedef unsigned u32x2_ __attribute__((ext_vector_type(2)));
    const u32x2_ w_ = __builtin_amdgcn_raw_buffer_load_b64(r_, (int)voff, 0, 0); return ((unsigned long long)w_.y << 32) | w_.x; }
__device__ __forceinline__ bf16x8 gld8(const bf16* ubase, unsigned voff) {
    const unsigned long long b_ = (unsigned long long)ubase;
    const unsigned lo_ = __builtin_amdgcn_readfirstlane((unsigned)b_), hi_ = __builtin_amdgcn_readfirstlane((unsigned)(b_ >> 32));
    __amdgpu_buffer_rsrc_t r_ = __builtin_amdgcn_make_buffer_rsrc((void*)(((unsigned long long)hi_ << 32) | lo_), (short)0, 0x7fffffff, 0x00020000);
    const v4u w_ = __builtin_amdgcn_raw_buffer_load_b128(r_, (int)voff, 0, 0); return __builtin_bit_cast(bf16x8, w_); }

__device__ __forceinline__ unsigned selbits(unsigned m, int c) { unsigned t; asm("v_bfe_i32 %0, %1, %2, 1" : "=v"(t) : "v"(m), "n"(c)); return t; }
__device__ __forceinline__ void mask_tile(f32x16& p0, f32x16& p1, int dq) {
    const float NEG = -__builtin_inff();
#pragma unroll
    for (int r = 0; r < 16; ++r) {
        const int c = (r & 3) + 8 * (r >> 2);
        if (dq - c < 0) p0[r] = NEG;
        if (dq - c - 32 < 0) p1[r] = NEG;
    }
}
template <bool MASKED>
__device__ __forceinline__ void partialSM(f32x16& p0, f32x16& p1, float& m_reg, float& mn, float& alpha, const float SCALE, unsigned mlo) {
    float pmax = p0[0]; for (int r = 1; r < 16; ++r) pmax = fmaxf(pmax, p0[r]); for (int r = 0; r < 16; ++r) pmax = fmaxf(pmax, p1[r]);
    { auto rr = __builtin_amdgcn_permlane32_swap(__float_as_uint(pmax), __float_as_uint(pmax), false, false);
      pmax = fmaxf(__uint_as_float(rr[0]), __uint_as_float(rr[1])); }
    const float C2 = 1.4426950408889634f * SCALE;
    if (__builtin_expect(__all((pmax - m_reg) * SCALE <= THR), 1)) { mn = m_reg; alpha = 1.f; }
    else { mn = fmaxf(m_reg, pmax); alpha = __builtin_amdgcn_exp2f((m_reg - mn) * C2); m_reg = mn; }
    const float mnL = -mn * C2;
    for (int r = 0; r < 16; ++r) p0[r] = fmaf(p0[r], C2, mnL); for (int r = 0; r < 16; ++r) p1[r] = fmaf(p1[r], C2, mnL);
    for (int r = 0; r < 16; ++r) p0[r] = __builtin_amdgcn_exp2f(p0[r]);
    if (MASKED) {
#pragma unroll
        for (int r = 0; r < 16; ++r) { const int c = (r & 3) + 8 * (r >> 2); p0[r] = __uint_as_float(__float_as_uint(p0[r]) & selbits(mlo, c)); }
    }
}
template <bool MASKED>
__device__ __forceinline__ void finishSM(f32x16& p0, f32x16& p1, float alpha, float& l_reg, bf16x8& pa0, bf16x8& pa1, bf16x8& pa2, bf16x8& pa3, unsigned mhi) {
    for (int r = 0; r < 16; ++r) p1[r] = __builtin_amdgcn_exp2f(p1[r]);
    if (MASKED) {
#pragma unroll
        for (int r = 0; r < 16; ++r) { const int c = (r & 3) + 8 * (r >> 2); p1[r] = __uint_as_float(__float_as_uint(p1[r]) & selbits(mhi, c)); }
    }
    float ps = 0; for (int r = 0; r < 16; ++r) ps += p0[r]; for (int r = 0; r < 16; ++r) ps += p1[r];
    { auto rr = __builtin_amdgcn_permlane32_swap(__float_as_uint(ps), __float_as_uint(ps), false, false);
      ps = __uint_as_float(rr[0]) + __uint_as_float(rr[1]); }
    l_reg = l_reg * alpha + ps;
#define PK4(P, B_, OUT) do { unsigned a0 = cvtpk(P[B_+0], P[B_+1]), a1 = cvtpk(P[B_+2], P[B_+3]);                          \
        unsigned b0 = cvtpk(P[B_+4], P[B_+5]), b1 = cvtpk(P[B_+6], P[B_+7]);                                             \
        auto r0 = __builtin_amdgcn_permlane32_swap(a0, b0, false, false); auto r1 = __builtin_amdgcn_permlane32_swap(a1, b1, false, false); \
        v4u w = {r0[0], r1[0], r0[1], r1[1]}; OUT = *reinterpret_cast<bf16x8*>(&w); } while (0)
    PK4(p0, 0, pa0); PK4(p0, 8, pa1); PK4(p1, 0, pa2); PK4(p1, 8, pa3);
#undef PK4
}
template <int KB, bool PE>
__device__ __forceinline__ void qkt(f32x16& p0, f32x16& p1, const char* lds, int r32, int hi, const bf16x8* qr, int kpb, int qpb) {
    p0 = f32x16{}; p1 = f32x16{};
    const char* kb[4];
#pragma unroll
    for (int dd = 0; dd < 4; ++dd) kb[dd] = lds + OFF_K + KB * SHM_K + KSWZ(r32, (dd * 16 + hi * 8) * 2);
    const char* qp_ = lds + qpb;
#pragma unroll
    for (int d0 = 0; d0 < 8; ++d0) { const char* a = kb[d0 & 3] + (d0 >> 2) * 128;
        bf16x8 b0 = *reinterpret_cast<const bf16x8*>(a);
        bf16x8 b1 = *reinterpret_cast<const bf16x8*>(a + 32 * KROW);
        bf16x8 qf; if (d0 >= 4) qf = *reinterpret_cast<const bf16x8*>(qp_ + (d0 - 4) * 32); else qf = qr[d0];
        p0 = __builtin_amdgcn_mfma_f32_32x32x16_bf16(b0, qf, p0, 0, 0, 0);
        p1 = __builtin_amdgcn_mfma_f32_32x32x16_bf16(b1, qf, p1, 0, 0, 0); }
    if (PE) {
        const char* kp_ = lds + kpb;
#pragma unroll
        for (int d0 = 0; d0 < 4; ++d0) {
            bf16x8 b0 = *reinterpret_cast<const bf16x8*>(kp_ + (KB * SHM_KP + d0 * 32));
            bf16x8 b1 = *reinterpret_cast<const bf16x8*>(kp_ + (KB * SHM_KP + d0 * 32 + 32 * KPROW));
            const bf16x8 qf = *reinterpret_cast<const bf16x8*>(qp_ + 128 + d0 * 32);
            p0 = __builtin_amdgcn_mfma_f32_32x32x16_bf16(b0, qf, p0, 0, 0, 0);
            p1 = __builtin_amdgcn_mfma_f32_32x32x16_bf16(b1, qf, p1, 0, 0, 0); }
    }
}
template <int VB>
__device__ __forceinline__ void pv_tile(f32x16* o, int vb0, bf16x8 pa0, bf16x8 pa1, bf16x8 pa2, bf16x8 pa3) {
#define TRRD(dst, off) asm volatile("ds_read_b64_tr_b16 %0, %1 offset:%2" : "=&v"(dst) : "v"(vb0), "i"(off) : "memory")
#define PV_D0(d0) do { s16x4 l0, l1, l2, l3, h0, h1, h2, h3; constexpr int b_ = OFF_V + VB * SHM_V + v_rd_off(d0, 0, 0); \
        TRRD(l0, b_); TRRD(h0, b_ + 2048); TRRD(l1, b_ + 4096); TRRD(h1, b_ + 6144); TRRD(l2, b_ + 8192); TRRD(h2, b_ + 10240); TRRD(l3, b_ + 12288); TRRD(h3, b_ + 14336); \
        asm volatile("s_waitcnt lgkmcnt(0)" ::: "memory"); SBAR();   \
        o[d0] = __builtin_amdgcn_mfma_f32_32x32x16_bf16(pa0, (bf16x8){l0[0], l0[1], l0[2], l0[3], h0[0], h0[1], h0[2], h0[3]}, o[d0], 0, 0, 0);   \
        o[d0] = __builtin_amdgcn_mfma_f32_32x32x16_bf16(pa1, (bf16x8){l1[0], l1[1], l1[2], l1[3], h1[0], h1[1], h1[2], h1[3]}, o[d0], 0, 0, 0);   \
        o[d0] = __builtin_amdgcn_mfma_f32_32x32x16_bf16(pa2, (bf16x8){l2[0], l2[1], l2[2], l2[3], h2[0], h2[1], h2[2], h2[3]}, o[d0], 0, 0, 0);   \
        o[d0] = __builtin_amdgcn_mfma_f32_32x32x16_bf16(pa3, (bf16x8){l3[0], l3[1], l3[2], l3[3], h3[0], h3[1], h3[2], h3[3]}, o[d0], 0, 0, 0); } while (0)
    PV_D0(0); PV_D0(1); PV_D0(2); PV_D0(3);
#undef PV_D0
#undef TRRD
}

template <int VB, bool MASKED>
__device__ __forceinline__ void pv_sm(f32x16* o, int vb0, bf16x8 pa0, bf16x8 pa1, bf16x8 pa2, bf16x8 pa3,
                                      f32x16& p0, f32x16& p1, float& m_reg, float& mn, float& alpha, const float SCALE, unsigned mlo) {
#define TRRD(dst, off) asm volatile("ds_read_b64_tr_b16 %0, %1 offset:%2" : "=&v"(dst) : "v"(vb0), "i"(off) : "memory")
#define PVS_LD(d0) s16x4 l0, l1, l2, l3, h0, h1, h2, h3; { constexpr int b_ = OFF_V + VB * SHM_V + v_rd_off(d0, 0, 0); \
        TRRD(l0, b_); TRRD(h0, b_ + 2048); TRRD(l1, b_ + 4096); TRRD(h1, b_ + 6144); TRRD(l2, b_ + 8192); TRRD(h2, b_ + 10240); TRRD(l3, b_ + 12288); TRRD(h3, b_ + 14336); \
        asm volatile("s_waitcnt lgkmcnt(0)" ::: "memory"); SBAR(); }
#define PVS_MM(d0) do { \
        o[d0] = __builtin_amdgcn_mfma_f32_32x32x16_bf16(pa0, (bf16x8){l0[0], l0[1], l0[2], l0[3], h0[0], h0[1], h0[2], h0[3]}, o[d0], 0, 0, 0);   \
        o[d0] = __builtin_amdgcn_mfma_f32_32x32x16_bf16(pa1, (bf16x8){l1[0], l1[1], l1[2], l1[3], h1[0], h1[1], h1[2], h1[3]}, o[d0], 0, 0, 0);   \
        o[d0] = __builtin_amdgcn_mfma_f32_32x32x16_bf16(pa2, (bf16x8){l2[0], l2[1], l2[2], l2[3], h2[0], h2[1], h2[2], h2[3]}, o[d0], 0, 0, 0);   \
        o[d0] = __builtin_amdgcn_mfma_f32_32x32x16_bf16(pa3, (bf16x8){l3[0], l3[1], l3[2], l3[3], h3[0], h3[1], h3[2], h3[3]}, o[d0], 0, 0, 0); } while (0)
#define PVS_SGB(nv) do { _Pragma("unroll") for (int g_ = 0; g_ < 4; ++g_) { __builtin_amdgcn_sched_group_barrier(0x008, 1, 0); __builtin_amdgcn_sched_group_barrier(0x402, nv, 0); } } while (0)
    const float C2 = 1.4426950408889634f * SCALE;
    float pmax, mnL;
    { PVS_LD(0); PVS_MM(0);
      float pm0 = p0[0], pm1 = p1[0];
#pragma unroll
      for (int r = 1; r < 16; ++r) { pm0 = fmaxf(pm0, p0[r]); pm1 = fmaxf(pm1, p1[r]); }
      pmax = fmaxf(pm0, pm1);
      { auto rr = __builtin_amdgcn_permlane32_swap(__float_as_uint(pmax), __float_as_uint(pmax), false, false);
        pmax = fmaxf(__uint_as_float(rr[0]), __uint_as_float(rr[1])); }
      PVS_SGB(5); }
    { PVS_LD(1); PVS_MM(1);
      const bool keep = __all((pmax - m_reg) * SCALE <= THR);
      mn = keep ? m_reg : fmaxf(m_reg, pmax); alpha = keep ? 1.f : __builtin_amdgcn_exp2f((m_reg - mn) * C2); m_reg = mn;
      mnL = -mn * C2;
#pragma unroll
      for (int r = 0; r < 16; ++r) p0[r] = fmaf(p0[r], C2, mnL);
      PVS_SGB(7); }
    { PVS_LD(2); PVS_MM(2);
#pragma unroll
      for (int r = 0; r < 16; ++r) p1[r] = fmaf(p1[r], C2, mnL);
#pragma unroll
      for (int r = 0; r < 6; ++r) p0[r] = __builtin_amdgcn_exp2f(p0[r]);
      PVS_SGB(6); }
    { PVS_LD(3); PVS_MM(3);
#pragma unroll
      for (int r = 6; r < 16; ++r) p0[r] = __builtin_amdgcn_exp2f(p0[r]);
      if (MASKED) {
#pragma unroll
          for (int r = 0; r < 16; ++r) { const int c = (r & 3) + 8 * (r >> 2); p0[r] = __uint_as_float(__float_as_uint(p0[r]) & selbits(mlo, c)); }
      }
      asm volatile("" : "+v"(p0), "+v"(p1));
      PVS_SGB(MASKED ? 8 : 3); }
#undef PVS_LD
#undef PVS_MM
#undef PVS_SGB
#undef TRRD
}

struct BlockRef { const bf16* Q; const bf16* K; const bf16* V; const bf16* KP; bf16* O; const unsigned long long* M; int P0; };
template <bool PE> struct Seam { bf16x8 qr[4]; bf16x8 qx[PE ? 8 : 4]; bf16x8 st_v0, st_v1, st_k0, st_k1, st_kp; };

#define VMW() asm volatile("s_waitcnt vmcnt(0)" ::: "memory")
#define VMWN(n) asm volatile("s_waitcnt vmcnt(%0)" :: "i"(n) : "memory")
#define SLOAD_H(Kp, Vp, KPp, k0) do { S.st_v0 = gld8((Vp) + (size_t)(k0) * LDV, voffkv); S.st_v1 = gld8((Vp) + (size_t)((k0) + 32) * LDV, voffkv);     \
                         S.st_k0 = gld8((Kp) + (size_t)(k0) * LDK, voffkv); S.st_k1 = gld8((Kp) + (size_t)((k0) + 32) * LDK, voffkv);                       \
                         if (PE) S.st_kp = gld8((KPp) + (size_t)(k0) * 64, voffkp); } while (0)
#define SWRITE_HK(bf) do { *(bf16x8*)(lds + OFF_K + (bf) * SHM_K + kws) = S.st_k0; *(bf16x8*)(lds + OFF_K + (bf) * SHM_K + kws + 32 * KROW) = S.st_k1;   \
                           if (PE) *(bf16x8*)(lds + kpws + (bf) * SHM_KP) = S.st_kp; } while (0)
#define SWRITE_HV(bf) do { *(bf16x8*)(lds + OFF_V + (bf) * SHM_V + vst0) = S.st_v0; *(bf16x8*)(lds + OFF_V + (bf) * SHM_V + vst1) = S.st_v1; } while (0)
#define SWRITE_H(bf) do { SWRITE_HV(bf); SWRITE_HK(bf); } while (0)
#define QLOAD(ref) do { _Pragma("unroll") for (int d0 = 0; d0 < 4; ++d0) S.qr[d0] = gld8((ref).Q + d0 * 16, voffq); } while (0)
#define QXLOAD(ref) do { _Pragma("unroll") for (int c_ = 0; c_ < QX / 16; ++c_) S.qx[c_] = gld8((ref).Q + (size_t)(c_ * (512 / QX)) * LDQ, voffqx); } while (0)
#define QXWRITE() do { _Pragma("unroll") for (int c_ = 0; c_ < QX / 16; ++c_) *(bf16x8*)(lds + qxw + c_ * (512 / QX) * QXROW) = S.qx[c_]; } while (0)

#define ATT_LANE_CONSTS \
    constexpr int QX = PE ? 128 : 64, QXROW = 2 * QX + 16, SHM_QP = QBLK * QXROW, CPR = QX / 8;                                                  \
    const int tid = threadIdx.x, wid = __builtin_amdgcn_readfirstlane(tid >> 6), lane = tid & 63, r32 = lane & 31, hi = lane >> 5;             \
    const int sr = tid >> 4, sc = (tid & 15) * 8, kws = KSWZ(sr, sc * 2), kpws = OFF_KP + KPSWZ(tid >> 3, tid & 7);                            \
    const unsigned voffkv = (unsigned)(sr * LDK + sc) * 2u, voffkp = (unsigned)((tid >> 3) * 64 + (tid & 7) * 8) * 2u;                          \
    const unsigned voffq = (unsigned)((wid * QBLK + r32) * LDQ + hi * 8) * 2u, voffqx = (unsigned)((wid * QBLK + lane / CPR) * LDQ + 64 + (lane % CPR) * 8) * 2u; \
    const int qxw = OFF_QP + wid * SHM_QP + (lane / CPR) * QXROW + (lane % CPR) * 16;
template <bool PE, bool MASKED, int LDQ, int LDK, int LDV>
__device__ __forceinline__ void attn_prime(const BlockRef& cur, char* lds, Seam<PE>& S) {
    static_assert(LDK == LDV, "k and v share the staging offset");
    ATT_LANE_CONSTS
    (void)kws; (void)kpws; (void)qxw; (void)r32; (void)hi;
    QLOAD(cur); QXLOAD(cur);
    SLOAD_H(cur.K, cur.V, cur.KP, 0); VMW(); SWRITE_HK(0);
    __syncthreads();
}
template <bool PE, bool MASKED, int LDQ, int LDK, int LDV, bool DRY>
__device__ __forceinline__ void attn_block(const BlockRef& cur, const BlockRef& nxt, char* lds, Seam<PE>& S, const float SCALE, const bool rdry, const float* psrc, bf16* pdst, const int kblk) {
    ATT_LANE_CONSTS
    const int NT = (cur.P0 + QB - 1) / KVBLK + 1;
    const int qlo = cur.P0 + wid * QBLK, qm = qlo + r32 - 4 * hi;
    float* ws = (float*)(lds + OFF_WS) + wid * 64; float* li_l = ws, * al_l = ws + 32;
    float m_reg = -1e30f, l_reg = 0; f32x16 o[4] = {};
    const int vst0 = v_st(sr, sc), vst1 = v_st(32 + sr, sc);
    const int vb0 = (int)(uintptr_t)lds + v_rd_base(lane);
    const int kpb = OFF_KP + r32 * KPROW + hi * 16, qpb = OFF_QP + wid * SHM_QP + r32 * QXROW + hi * 16 - (PE ? 0 : 0);
    const bf16* Kh = cur.K; const bf16* Vh = cur.V; const bf16* KPh = cur.KP;
    const unsigned voffm = (unsigned)(wid * QBLK + r32) * 512u;
#define RESC(a) do { if (__any((a) < 1.f)) { if (hi == 0) al_l[r32] = (a); asm volatile("s_waitcnt lgkmcnt(0)" ::: "memory");              \
                     for (int d_ = 0; d_ < 4; ++d_) for (int r = 0; r < 16; ++r) o[d_][r] *= al_l[crow(r, hi)]; } } while (0)
#define KBASE(t) ((t) * KVBLK)
#define MASKT(P0_, P1_, t) do { if (!MASKED) { const int kb_ = KBASE(t); if (kb_ + KVBLK - 1 > qlo) mask_tile(P0_, P1_, qm - kb_); } } while (0)
#define MLOAD(mw, t) do { if (MASKED) mw = gld_u64(cur.M + (t), voffm); } while (0)
#define MLO(mw) ((unsigned)(mw) >> (4 * hi))
#define MHI(mw) ((unsigned)((mw) >> 32) >> (4 * hi))
    constexpr int NQL = 4;
#define SEAM_K0() do { VMWN(NQL); SWRITE_HK(0); SBAR(); } while (0)
    f32x16 pA0, pA1, pB0, pB1; float mnA, mnB, alA, alB; bf16x8 pa0, pa1, pa2, pa3; unsigned long long mwA = 0, mwB = 0;
    QXWRITE(); SWRITE_HV(0); SBAR();
    if (NT > 1) SLOAD_H(Kh, Vh, KPh, KBASE(1));
    MLOAD(mwA, 0);
    SBAR(); qkt<0, PE>(pA0, pA1, lds, r32, hi, S.qr, kpb, qpb);
    MASKT(pA0, pA1, 0); partialSM<MASKED>(pA0, pA1, m_reg, mnA, alA, SCALE, MLO(mwA));
    if (NT > 1) { VMW(); SWRITE_H(1); }
    __syncthreads();
#define SGB_(mask, n) __builtin_amdgcn_sched_group_barrier(mask, n, 0)
#define SGB_STEP(nrd, nva) do { SGB_(0x100, nrd); SGB_(0x008, 1); SGB_(0x402, nva); SGB_(0x008, 1); SGB_(0x402, nva); } while (0)
#define SGB_QK_FIN() do { constexpr int NV_ = MASKED ? 6 : 3; SGB_(0x100, 2);                                              \
        SGB_STEP(2, NV_); SGB_STEP(2, NV_); SGB_STEP(2, NV_); SGB_STEP(3, NV_); SGB_STEP(3, NV_); SGB_STEP(3, NV_); SGB_STEP(3, NV_);                      \
        if (PE) { SGB_STEP(3, NV_); SGB_STEP(3, NV_); SGB_STEP(3, NV_); SGB_STEP(3, NV_); SGB_STEP(0, NV_); } else SGB_STEP(0, NV_); } while (0)
#define HALF_STEP(PX0, PX1, mnX, alX, mwX, PY0, PY1, alY, mwY, t, KB, VB, SB) do {                                            \
        SBAR(); MLOAD(mwX, t); if ((t) + 1 < NT) { SLOAD_H(Kh, Vh, KPh, KBASE((t) + 1)); SBAR(); }     \
        qkt<KB, PE>(PX0, PX1, lds, r32, hi, S.qr, kpb, qpb);                                                                      \
        finishSM<MASKED>(PY0, PY1, alY, l_reg, pa0, pa1, pa2, pa3, MHI(mwY)); SGB_QK_FIN(); SBAR();                            \
        MASKT(PX0, PX1, (t)); SBAR(); pv_sm<VB, MASKED>(o, vb0, pa0, pa1, pa2, pa3, PX0, PX1, m_reg, mnX, alX, SCALE, MLO(mwX));                   \
        __syncthreads();                                                                                                      \
        if ((t) + 1 < NT) { VMW(); SWRITE_H(SB); }                                                                            \
        RESC(alX); __syncthreads(); } while (0)
    for (int t = 1; t + 1 < NT; t += 2) {
        HALF_STEP(pB0, pB1, mnB, alB, mwB, pA0, pA1, alA, mwA, t, 1, 0, 0);
        HALF_STEP(pA0, pA1, mnA, alA, mwA, pB0, pB1, alB, mwB, t + 1, 0, 1, 1);
    }
    const bool even = (NT & 1) == 0;
    (void)even;
    MLOAD(mwB, NT - 1);
    SBAR();
    const unsigned voffg = (unsigned)((wid * QBLK + (lane >> 4)) * 1024 + (lane & 15) * 8) * 2u;
    bf16x8 szq[8];
#pragma unroll
    for (int j = 0; j < 8; ++j) szq[j] = gld8(cur.O + (size_t)(4 * j) * 1024, voffg);
    constexpr size_t PNCH = (size_t)NB * 4096 * 256 / 8;
    f32x4 pcv[2][2]; size_t pcc[2];
    { const size_t gth_ = (size_t)gridDim.x * (NW * 64), gid_ = (size_t)blockIdx.x * (NW * 64) + tid;
#pragma unroll
      for (int u = 0; u < 2; ++u) { const size_t c_ = (size_t)(kblk * 2 + u) * gth_ + gid_; pcc[u] = c_; const size_t cl_ = c_ < PNCH ? c_ : PNCH - 1;
          pcv[u][0] = *(const f32x4*)(psrc + cl_ * 8); pcv[u][1] = *(const f32x4*)(psrc + cl_ * 8 + 4); } }
    SBAR(); qkt<1, PE>(pB0, pB1, lds, r32, hi, S.qr, kpb, qpb);
    finishSM<MASKED>(pA0, pA1, alA, l_reg, pa0, pa1, pa2, pa3, MHI(mwA)); SGB_QK_FIN(); SBAR();
    MASKT(pB0, pB1, NT - 1); SBAR(); pv_sm<0, MASKED>(o, vb0, pa0, pa1, pa2, pa3, pB0, pB1, m_reg, mnB, alB, SCALE, MLO(mwB));
    SBAR(); SLOAD_H(nxt.K, nxt.V, nxt.KP, 0); SBAR();
    QLOAD(nxt);
    SBAR();
    __syncthreads(); RESC(alB);
    finishSM<MASKED>(pB0, pB1, alB, l_reg, pa0, pa1, pa2, pa3, MHI(mwB)); SBAR();
    pv_tile<1>(o, vb0, pa0, pa1, pa2, pa3);
    SBAR(); SEAM_K0(); QXLOAD(nxt); SBAR();
    if (hi == 0) li_l[r32] = l_reg; asm volatile("s_waitcnt lgkmcnt(0)" ::: "memory");
    float rli[16];
#pragma unroll
    for (int r = 0; r < 16; ++r) rli[r] = __builtin_amdgcn_rcpf(li_l[crow(r, hi)]);
    char* stg = lds + OFF_QP + wid * (QBLK * 272) + (4 * hi) * 272 + r32 * 2;
#pragma unroll
    for (int d0 = 0; d0 < 4; ++d0)
#pragma unroll
        for (int r = 0; r < 16; r += 2) { const unsigned w = cvtpk(o[d0][r] * rli[r], o[d0][r + 1] * rli[r + 1]);
            *(unsigned short*)(stg + ((r & 3) + 8 * (r >> 2)) * 272 + d0 * 64) = (unsigned short)w;
            *(unsigned short*)(stg + (((r + 1) & 3) + 8 * ((r + 1) >> 2)) * 272 + d0 * 64) = (unsigned short)(w >> 16); }
    asm volatile("s_waitcnt lgkmcnt(0)" ::: "memory");
    const char* strd = lds + OFF_QP + wid * (QBLK * 272) + (lane >> 4) * 272 + (lane & 15) * 16;
#pragma unroll
    for (int j = 0; j < 8; ++j) { const v4u ow = *(const v4u*)(strd + (4 * j) * 272); const v4u zw = __builtin_bit_cast(v4u, szq[j]); v4u gw;
#pragma unroll
        for (int e = 0; e < 4; ++e) gw[e] = cvtpk(__uint_as_float(ow[e] << 16) * __uint_as_float(zw[e] << 16), __uint_as_float(ow[e] & 0xffff0000u) * __uint_as_float(zw[e] & 0xffff0000u));
        v4u* gp = (v4u*)((char*)(cur.O + (size_t)(4 * j) * 1024) + voffg);
        if (!DRY && !rdry) *gp = gw; else asm volatile("" :: "v"(gw)); }
#pragma unroll
    for (int u = 0; u < 2; ++u) { const v4u pw = pack8(pcv[u][0], pcv[u][1]); if (pcc[u] < PNCH) *(v4u*)(pdst + pcc[u] * 8) = pw; }
    __syncthreads();
#undef RESC
#undef KBASE
#undef MASKT
#undef MLOAD
#undef MLO
#undef MHI
#undef SEAM_K0
#undef HALF_STEP
}
#undef VMW
#undef VMWN
#undef SLOAD_H
#undef SWRITE_HK
#undef SWRITE_HV
#undef SWRITE_H
#undef QLOAD
#undef QXLOAD
#undef QXWRITE

struct Item { int bh, qb0, qb1; };
__device__ __forceinline__ Item decode(int L, int nhkv) {
    const int Gq = 8 / nhkv, xcd = L & 7, k = L >> 3, per = Gq * 8, gi = k / per, r = k - gi * per;
    Item it; it.bh = (gi * 8 + xcd) * Gq + r / 8; const int x = r % 8; it.qb0 = x; it.qb1 = 15 - x; return it;
}
template <bool PE, bool MASKED, int LDQ, int QH, int LDK, int LDV, int NHKV>
__device__ __forceinline__ BlockRef make_ref(const Item& it, int pass, const bf16* Q, const bf16* K, const bf16* V, const bf16* KP, bf16* O, const unsigned long long* M) {
    const int qb = pass ? it.qb1 : it.qb0, b = it.bh >> 3, h = it.bh & 7, hk = h / (8 / NHKV); const size_t tok0 = (size_t)b * SEQ + (size_t)qb * QB;
    BlockRef r; r.Q = Q + tok0 * LDQ + h * QH; r.K = K + (size_t)b * SEQ * LDK + hk * 128; r.V = V + (size_t)b * SEQ * LDV + hk * 128; r.KP = PE ? KP + (size_t)b * SEQ * 64 : nullptr;
    r.O = O + tok0 * 1024 + h * 128; r.M = MASKED ? M + tok0 * 64 : nullptr; r.P0 = qb * QB; return r;
}
template <bool PE, bool MASKED, int LDQ, int QH, int LDK, int LDV, int NHKV, bool DRY = false>
__device__ __forceinline__ void attn_phase(char* lds, const bf16* Q, const bf16* K, const bf16* V, const bf16* KP, bf16* O, const unsigned long long* M, const float SCALE, const float* psrc, bf16* pdst, const bool rdry = false) {
    const int total = 8 * NB * 8, stride = gridDim.x;
    int L = blockIdx.x; if (L >= total) return;
    if (__builtin_amdgcn_readfirstlane((int)threadIdx.x) >= 256) __builtin_amdgcn_s_setprio(1);
    Item it = decode(L, NHKV); int pass = 0, kblk = 0;
    BlockRef cur = make_ref<PE, MASKED, LDQ, QH, LDK, LDV, NHKV>(it, 0, Q, K, V, KP, O, M);
    Seam<PE> S;
    attn_prime<PE, MASKED, LDQ, LDK, LDV>(cur, lds, S);
    for (;;) {
        const bool more_pass = pass == 0, more_item = L + stride < total, last = !more_pass && !more_item;
        Item itn = it; int passn = pass + 1, Ln = L;
        if (!more_pass) { passn = 0; Ln = more_item ? L + stride : L; itn = decode(Ln, NHKV); }
        const BlockRef nxt = last ? cur : make_ref<PE, MASKED, LDQ, QH, LDK, LDV, NHKV>(itn, passn, Q, K, V, KP, O, M);
        attn_block<PE, MASKED, LDQ, LDK, LDV, DRY>(cur, nxt, lds, S, SCALE, rdry, psrc, pdst, kblk); ++kblk;
        if (last) break;
        cur = nxt; it = itn; pass = passn; L = Ln;
    }
    __builtin_amdgcn_s_setprio(0);
    { constexpr size_t PNCH = (size_t)NB * 4096 * 256 / 8; const size_t gth_ = (size_t)gridDim.x * (NW * 64);
      for (size_t c_ = (size_t)kblk * 2 * gth_ + (size_t)blockIdx.x * (NW * 64) + threadIdx.x; c_ < PNCH; c_ += gth_) {
          const f32x4 a_ = *(const f32x4*)(psrc + c_ * 8), b_ = *(const f32x4*)(psrc + c_ * 8 + 4); *(v4u*)(pdst + c_ * 8) = pack8(a_, b_); } }
}
#undef KSWZ
#undef KPSWZ
#undef SBAR
}
#define EPI_ROWS _Pragma("unroll") for (int ai = 0; ai < 2; ++ai) _Pragma("unroll") for (int m = 0; m < 4; ++m)
#define EPI_ROW (u.pm * 256 + ai * 128 + wr * 64 + m * 16 + fr)
#define EPI_FENCE() __builtin_amdgcn_sched_barrier(0)
typedef const f32x4 (&AccRef)[2][2][4][2];
template <int NP>
__device__ __forceinline__ void wave_rstd(const float* rs, int pm, int wr, int fr, int fq, float invn, float (&out)[2][4]) {
    const int l = fq * 16 + fr; float r2[2];
#pragma unroll
    for (int ai = 0; ai < 2; ++ai) { const int row = pm * 256 + ai * 128 + wr * 64 + l; float s;
        if (NP == 16) { const f32x4* p = (const f32x4*)(rs + (size_t)row * 16); const f32x4 a = p[0], b = p[1], c = p[2], d = p[3];
            s = ((a[0] + a[1]) + (a[2] + a[3])) + ((b[0] + b[1]) + (b[2] + b[3])) + ((c[0] + c[1]) + (c[2] + c[3])) + ((d[0] + d[1]) + (d[2] + d[3])); }
        else { const f32x4 a = *(const f32x4*)(rs + (size_t)row * 4); s = (a[0] + a[1]) + (a[2] + a[3]); }
        r2[ai] = rsqrtf(s * invn + NORM_EPS); }
#pragma unroll
    for (int ai = 0; ai < 2; ++ai)
#pragma unroll
        for (int m = 0; m < 4; ++m) out[ai][m] = __shfl(r2[ai], m * 16 + fr);
}

struct EpiMlaIn {
    static constexpr bool PERM = true, AFTER_DRAIN = false;
    const float* rsx; bf16* cq; bf16* ckv; bf16* sz; bf16* kpe; float* rsq; float* rskv; const unsigned* rope32;
    __device__ __forceinline__ void operator()(AccRef acc, const pg8::Unit& u, int wr, int wc, int fr, int fq) const {
        const int pn = u.pn; float rst[2][4]; wave_rstd<16>(rsx, u.pm, wr, fr, fq, 1.f / 1024.f, rst);
        if (pn < 2) { bf16* dst = pn == 0 ? cq : ckv; float* rs = pn == 0 ? rsq : rskv;
            EPI_ROWS { const int row = EPI_ROW; const float rstd = rst[ai][m]; float ss = 0.f;
#pragma unroll
                for (int bj = 0; bj < 2; ++bj) { const f32x4 v0 = acc[ai][bj][m][0] * rstd, v1 = acc[ai][bj][m][1] * rstd; ss += sq4(v0) + sq4(v1);
                    *(v4u*)(dst + (size_t)row * 256 + bj * 128 + wc * 32 + fq * 8) = pack8(v0, v1); }
                ss += __shfl_xor(ss, 16); ss += __shfl_xor(ss, 32);
                if (fq == 0) rs[(size_t)row * 4 + wc] = ss; }
        } else if (pn < 6) {
            EPI_ROWS { const int row = EPI_ROW; const float rstd = rst[ai][m];
#pragma unroll
                for (int bj = 0; bj < 2; ++bj) { f32x4 v0 = acc[ai][bj][m][0] * rstd, v1 = acc[ai][bj][m][1] * rstd;
#pragma unroll
                    for (int e = 0; e < 4; ++e) { v0[e] = silu_f(v0[e]); v1[e] = silu_f(v1[e]); }
                    *(v4u*)(sz + (size_t)row * 1024 + (pn - 2) * 256 + bj * 128 + wc * 32 + fq * 8) = pack8(v0, v1); } }
        } else if (wc < 2) {
            const int c = wc * 32 + fq * 8;
#pragma unroll
            for (int ai = 0; ai < 2; ++ai)
            { v4u cs[4];
#pragma unroll
                for (int m = 0; m < 4; ++m) cs[m] = *(const v4u*)(rope32 + (size_t)EPI_ROW * 32 + (c >> 1));
                EPI_FENCE();
#pragma unroll
                for (int m = 0; m < 4; ++m) { const int row = EPI_ROW; const float rstd = rst[ai][m]; f32x4 v0 = acc[ai][0][m][0] * rstd, v1 = acc[ai][0][m][1] * rstd;
                    rope8h(v0, v1, cs[m]);
                    *(v4u*)(kpe + (size_t)row * 64 + c) = pack8(v0, v1); } }
        }
    }
};
struct EpiMlaQ {
    static constexpr bool PERM = true, AFTER_DRAIN = false;
    const float* rsq; bf16* q; const unsigned* rope32;
    __device__ __forceinline__ void operator()(AccRef acc, const pg8::Unit& u, int wr, int wc, int fr, int fq) const {
        int col[2], cin[2];
#pragma unroll
        for (int bj = 0; bj < 2; ++bj) { col[bj] = u.pn * 256 + bj * 128 + wc * 32 + fq * 8; const int h = col[bj] / 192; cin[bj] = col[bj] - h * 192; }
        v4u cs0[4][2];
        { const int ai = 0;
#pragma unroll
            for (int m = 0; m < 4; ++m) {
#pragma unroll
                for (int bj = 0; bj < 2; ++bj) if (cin[bj] >= 128) cs0[m][bj] = *(const v4u*)(rope32 + (size_t)EPI_ROW * 32 + ((cin[bj] - 128) >> 1)); } }
        float rst[2][4]; wave_rstd<4>(rsq, u.pm, wr, fr, fq, 1.f / 256.f, rst);
#pragma unroll
        for (int ai = 0; ai < 2; ++ai)
        { v4u cs[4][2];
#pragma unroll
            for (int m = 0; m < 4; ++m) {
#pragma unroll
                for (int bj = 0; bj < 2; ++bj) { if (ai == 0) cs[m][bj] = cs0[m][bj]; else if (cin[bj] >= 128) cs[m][bj] = *(const v4u*)(rope32 + (size_t)EPI_ROW * 32 + ((cin[bj] - 128) >> 1)); } }
            EPI_FENCE();
#pragma unroll
            for (int m = 0; m < 4; ++m) { const int row = EPI_ROW; const float rstd = rst[ai][m];
#pragma unroll
                for (int bj = 0; bj < 2; ++bj) { f32x4 v0 = acc[ai][bj][m][0] * rstd, v1 = acc[ai][bj][m][1] * rstd;
                    if (cin[bj] >= 128) rope8h(v0, v1, cs[m][bj]);
                    *(v4u*)(q + (size_t)row * 1536 + col[bj]) = pack8(v0, v1); } } }
    }
};
struct EpiMlaKV {
    static constexpr bool PERM = true, AFTER_DRAIN = false;
    const float* rskv; bf16* dst;
    __device__ __forceinline__ void operator()(AccRef acc, const pg8::Unit& u, int wr, int wc, int fr, int fq) const {
        float rst[2][4]; wave_rstd<4>(rskv, u.pm, wr, fr, fq, 1.f / 256.f, rst);
        EPI_ROWS { const int row = EPI_ROW; const float rstd = rst[ai][m];
#pragma unroll
            for (int bj = 0; bj < 2; ++bj) { const int col = u.pn * 256 + bj * 128 + wc * 32 + fq * 8;
                *(v4u*)(dst + (size_t)row * 1024 + col) = pack8(acc[ai][bj][m][0] * rstd, acc[ai][bj][m][1] * rstd); }
        }
    }
};
struct EpiPlain {
    static constexpr bool PERM = true, AFTER_DRAIN = false;
    bf16* dst;
    __device__ __forceinline__ void operator()(AccRef acc, const pg8::Unit& u, int wr, int wc, int fr, int fq) const {
        EPI_ROWS { const int row = EPI_ROW;
#pragma unroll
            for (int bj = 0; bj < 2; ++bj) { const int col = u.pn * 256 + bj * 128 + wc * 32 + fq * 8;
                *(v4u*)(dst + (size_t)row * 1024 + col) = pack8(acc[ai][bj][m][0], acc[ai][bj][m][1]); }
        }
    }
};
#define SS8(ow) ({ const float r0 = bf2f((ow).x & 0xffffu), r1 = bf2f((ow).x >> 16), r2 = bf2f((ow).y & 0xffffu), r3 = bf2f((ow).y >> 16), r4 = bf2f((ow).z & 0xffffu), r5 = bf2f((ow).z >> 16), r6 = bf2f((ow).w & 0xffffu), r7 = bf2f((ow).w >> 16); \
                   ((r0 * r0 + r1 * r1) + (r2 * r2 + r3 * r3)) + ((r4 * r4 + r5 * r5) + (r6 * r6 + r7 * r7)); })
struct EpiOut {
    static constexpr bool PERM = true, AFTER_DRAIN = false;
    const bf16* xin; bf16* xb; float* rs1; bool dry;
    __device__ __forceinline__ void operator()(AccRef acc, const pg8::Unit& u, int wr, int wc, int fr, int fq) const {
        const size_t c0 = (size_t)u.pn * 256 + wc * 32 + fq * 8;
        v4u xw[2][4][2];
#pragma unroll
        for (int ai = 0; ai < 2; ++ai)
#pragma unroll
        for (int m = 0; m < 4; ++m) {
#pragma unroll
            for (int bj = 0; bj < 2; ++bj) xw[ai][m][bj] = *(const v4u*)(xin + (size_t)EPI_ROW * 1024 + c0 + bj * 128); }
        EPI_FENCE();
#pragma unroll
        for (int ai = 0; ai < 2; ++ai) {
#pragma unroll
        for (int m = 0; m < 4; ++m) { const int row = EPI_ROW; float ss = 0.f;
#pragma unroll
            for (int bj = 0; bj < 2; ++bj) { const v4u w = xw[ai][m][bj]; f32x4 a0 = acc[ai][bj][m][0], a1 = acc[ai][bj][m][1];
                a0[0] += bf2f(w.x & 0xffffu); a0[1] += bf2f(w.x >> 16); a0[2] += bf2f(w.y & 0xffffu); a0[3] += bf2f(w.y >> 16);
                a1[0] += bf2f(w.z & 0xffffu); a1[1] += bf2f(w.z >> 16); a1[2] += bf2f(w.w & 0xffffu); a1[3] += bf2f(w.w >> 16);
                const v4u ow = pack8(a0, a1); if (!dry) *(v4u*)(xb + (size_t)row * 1024 + c0 + bj * 128) = ow; ss += SS8(ow); }
            ss += __shfl_xor(ss, 16); ss += __shfl_xor(ss, 32);
            if (fq == 0 && !dry) rs1[(size_t)row * 16 + u.pn * 4 + wc] = ss; else asm volatile("" :: "v"(ss));
        } }
    }
};
struct EpiGate {
    static constexpr bool PERM = true, AFTER_DRAIN = false;
    const float* rs1; const bf16* x1; const bf16* pp; bf16* xb; float* rsx; bool dry;
    __device__ __forceinline__ void operator()(AccRef acc, const pg8::Unit& u, int wr, int wc, int fr, int fq) const {
        float rst[2][4]; wave_rstd<16>(rs1, u.pm, wr, fr, fq, 1.f / 1024.f, rst);
        const size_t c0 = (size_t)u.pn * 256 + wc * 32 + fq * 8;
#pragma unroll
        for (int ai = 0; ai < 2; ++ai) { v4u xw[4][2], pw[4][2];
#pragma unroll
            for (int m = 0; m < 4; ++m)
#pragma unroll
                for (int bj = 0; bj < 2; ++bj) { xw[m][bj] = *(const v4u*)(x1 + (size_t)EPI_ROW * 1024 + c0 + bj * 128); pw[m][bj] = *(const v4u*)(pp + (size_t)EPI_ROW * 1024 + c0 + bj * 128); }
            EPI_FENCE();
#pragma unroll
            for (int m = 0; m < 4; ++m) { const int row = EPI_ROW; const float rstd = rst[ai][m]; float ss = 0.f;
#pragma unroll
                for (int bj = 0; bj < 2; ++bj) { const v4u xv = xw[m][bj], pv = pw[m][bj];
                    const f32x4 g0 = acc[ai][bj][m][0] * rstd, g1 = acc[ai][bj][m][1] * rstd; f32x4 a0, a1;
                    a0[0] = bf2f(xv.x & 0xffffu) + bf2f(pv.x & 0xffffu) * sigmoid_f(g0[0]); a0[1] = bf2f(xv.x >> 16) + bf2f(pv.x >> 16) * sigmoid_f(g0[1]);
                    a0[2] = bf2f(xv.y & 0xffffu) + bf2f(pv.y & 0xffffu) * sigmoid_f(g0[2]); a0[3] = bf2f(xv.y >> 16) + bf2f(pv.y >> 16) * sigmoid_f(g0[3]);
                    a1[0] = bf2f(xv.z & 0xffffu) + bf2f(pv.z & 0xffffu) * sigmoid_f(g1[0]); a1[1] = bf2f(xv.z >> 16) + bf2f(pv.z >> 16) * sigmoid_f(g1[1]);
                    a1[2] = bf2f(xv.w & 0xffffu) + bf2f(pv.w & 0xffffu) * sigmoid_f(g1[2]); a1[3] = bf2f(xv.w >> 16) + bf2f(pv.w >> 16) * sigmoid_f(g1[3]);
                    const v4u ow = pack8(a0, a1); if (!dry) *(v4u*)(xb + (size_t)row * 1024 + c0 + bj * 128) = ow; ss += SS8(ow); }
                ss += __shfl_xor(ss, 16); ss += __shfl_xor(ss, 32);
                if (fq == 0 && !dry) rsx[(size_t)row * 16 + u.pn * 4 + wc] = ss; else asm volatile("" :: "v"(ss)); } }
    }
};
struct EpiDsaIn {
    static constexpr bool PERM = true, AFTER_DRAIN = false;
    const float* rsx; bf16* q; bf16* k; bf16* v; bf16* qi; bf16* sz; bf16* ki; float* wi; const unsigned* rope64; const unsigned* rope32;
    __device__ __forceinline__ void operator()(AccRef acc, const pg8::Unit& u, int wr, int wc, int fr, int fq) const {
        const int pn = u.pn;
        const int cb = wc * 32 + fq * 8;
        const bool rope_tile = pn < 5 || pn == 6 || pn == 7 || pn == 12;
        const unsigned* tab = (pn < 5) ? rope64 : rope32; const int tw = (pn < 5) ? 64 : 32, cm = (pn < 5) ? 127 : 63;
        v4u cs0[4][2];
        if (rope_tile) { const int ai = 0;
#pragma unroll
            for (int m = 0; m < 4; ++m) {
#pragma unroll
                for (int bj = 0; bj < 2; ++bj) { const int c = bj * 128 + cb; if (pn != 12 || c < 64) cs0[m][bj] = *(const v4u*)(tab + (size_t)EPI_ROW * tw + ((c & cm) >> 1)); } } }
        float rst[2][4]; wave_rstd<16>(rsx, u.pm, wr, fr, fq, 1.f / 1024.f, rst);
#pragma unroll
        for (int ai = 0; ai < 2; ++ai)
        { v4u cs[4][2];
            if (ai == 0) {
#pragma unroll
                for (int m = 0; m < 4; ++m) { cs[m][0] = cs0[m][0]; cs[m][1] = cs0[m][1]; }
            } else if (rope_tile) {
#pragma unroll
                for (int m = 0; m < 4; ++m) {
#pragma unroll
                    for (int bj = 0; bj < 2; ++bj) { const int c = bj * 128 + cb; if (pn != 12 || c < 64) cs[m][bj] = *(const v4u*)(tab + (size_t)EPI_ROW * tw + ((c & cm) >> 1)); } }
            }
            EPI_FENCE();
#pragma unroll
            for (int m = 0; m < 4; ++m) { const int row = EPI_ROW; const float rstd = rst[ai][m];
#pragma unroll
                for (int bj = 0; bj < 2; ++bj) { const int c = bj * 128 + cb;
                    f32x4 v0 = acc[ai][bj][m][0] * rstd, v1 = acc[ai][bj][m][1] * rstd;
                    if (pn < 4) { rope8h(v0, v1, cs[m][bj]); *(v4u*)(q + (size_t)row * 1024 + pn * 256 + c) = pack8(v0, v1); }
                    else if (pn == 4) { rope8h(v0, v1, cs[m][bj]); *(v4u*)(k + (size_t)row * 256 + c) = pack8(v0, v1); }
                    else if (pn == 5) { *(v4u*)(v + (size_t)row * 256 + c) = pack8(v0, v1); }
                    else if (pn < 8) { rope8h(v0, v1, cs[m][bj]); *(v4u*)(qi + (size_t)row * 512 + (pn - 6) * 256 + c) = pack8(v0, v1); }
                    else if (pn < 12) {
#pragma unroll
                        for (int e = 0; e < 4; ++e) { v0[e] = silu_f(v0[e]); v1[e] = silu_f(v1[e]); }
                        *(v4u*)(sz + (size_t)row * 1024 + (pn - 8) * 256 + c) = pack8(v0, v1); }
                    else if (c < 64) { rope8h(v0, v1, cs[m][bj]); *(v4u*)(ki + (size_t)row * 64 + c) = pack8(v0, v1); }
                    else if (c == 64) { *(f32x4*)(wi + (size_t)row * 8) = v0; *(f32x4*)(wi + (size_t)row * 8 + 4) = v1; }
                } } }
    }
};

__device__ __forceinline__ int src_col(int map, int n) {
    switch (map) {
    case 1:
        if (n < 512) return n; if (n < 1536) return n + 64; if (n < 1600) { const int c = n - 1536; return 512 + (c >> 1) + 32 * (c & 1); } return -1;
    case 2: {
        const int h = n / 192, c = n - h * 192; if (c < 128) return n; const int c2 = c - 128; return h * 192 + 128 + (c2 >> 1) + 32 * (c2 & 1); }
    case 3:
        if (n < 1280) { const int h = n >> 7, c = n & 127; return h * 128 + (c >> 1) + 64 * (c & 1); }
        if (n < 1536) return n;
        if (n < 2048) { const int c = n - 1536, h = c >> 6, cc = c & 63; return 1536 + h * 64 + (cc >> 1) + 32 * (cc & 1); }
        if (n < 3072) return 2120 + (n - 2048);
        if (n < 3136) { const int c = n - 3072; return 2048 + (c >> 1) + 32 * (c & 1); }
        if (n < 3144) return 2112 + (n - 3136);
        return -1;
    default: return n;
    }
}
__device__ __forceinline__ void tr_item(const float* W, int K, int N, bf16* WT, int Nout, const float* gain, int map, LAS float* scr, int item, int lane) {
    const int nblk = Nout / 32, kb = item / nblk, nb = item % nblk, k0 = 64 * kb, n0 = 32 * nb;
    const int src = src_col(map, n0 + (lane & 31));
    const int srcc = src >= 0 ? src : 0; float wv_[32], gv_[32];
#pragma unroll
    for (int i = 0; i < 32; ++i) { const int kk = 2 * i + (lane >> 5); wv_[i] = W[(size_t)(k0 + kk) * N + srcc]; gv_[i] = gain ? gain[k0 + kk] : 1.f; }
#pragma unroll
    for (int i = 0; i < 32; ++i) { const int kk = 2 * i + (lane >> 5); scr[kk * 33 + (lane & 31)] = src >= 0 ? wv_[i] * gv_[i] : 0.f; }
    LDS_WAIT(); asm volatile("" ::: "memory");
    const int c = lane & 7;
#pragma unroll
    for (int j = 0; j < 4; ++j) { const int n = (lane >> 3) + 8 * j; const LAS float* s = scr + (8 * c) * 33 + n;
        v4u o; o.x = cvtpk(s[0 * 33], s[1 * 33]); o.y = cvtpk(s[2 * 33], s[3 * 33]); o.z = cvtpk(s[4 * 33], s[5 * 33]); o.w = cvtpk(s[6 * 33], s[7 * 33]);
        *(v4u*)(WT + (size_t)(n0 + n) * K + k0 + 8 * c) = o; }
    LDS_WAIT(); asm volatile("" ::: "memory");
}

struct Args { const float* in[17]; float* out; unsigned char* ws; int ph_lo, ph_hi, pmode, pad; };

__device__ __forceinline__ void prologue(const Args& a, LAS unsigned char* lds, int gw, int ngw, int wave, int lane) {
    bf16* Wb = (bf16*)(a.ws + WS_W);
    LAS float* scr = (LAS float*)(lds + wave * 16384);
    for (int mi = 0; mi < 22; ++mi) {
        const float* W; int K, N, Nout, map = 0; const float* gain = nullptr; bf16* WT;
        if (mi < 2)       { const int j = mi;      W = a.in[4] + (size_t)j * 1024 * 1600;  K = 1024; N = 1600; Nout = MLA_N; map = 1; gain = a.in[3] + (size_t)(2 * j) * 1024; WT = Wb + W_WINM + (size_t)j * MLA_N * 1024; }
        else if (mi < 4)  { const int j = mi - 2;  W = a.in[7] + (size_t)j * 256 * 1536;   K = 256;  N = 1536; Nout = 1536;  map = 2; gain = a.in[5] + (size_t)j * 256; WT = Wb + W_WUQ + (size_t)j * 1536 * 256; }
        else if (mi < 6)  { const int j = mi - 4;  W = a.in[8] + (size_t)j * 256 * 1024;   K = 256;  N = 1024; Nout = 1024;  gain = a.in[6] + (size_t)j * 256; WT = Wb + W_WUK + (size_t)j * 1024 * 256; }
        else if (mi < 8)  { const int j = mi - 6;  W = a.in[9] + (size_t)j * 256 * 1024;   K = 256;  N = 1024; Nout = 1024;  gain = a.in[6] + (size_t)j * 256; WT = Wb + W_WUV + (size_t)j * 1024 * 256; }
        else if (mi < 10) { const int j = mi - 8;  W = a.in[10] + (size_t)j * 1024 * 1024; K = 1024; N = 1024; Nout = 1024;  WT = Wb + W_WOM + (size_t)j * 1024 * 1024; }
        else if (mi < 12) { const int j = mi - 10; W = a.in[11] + (size_t)j * 1024 * 3144; K = 1024; N = 3144; Nout = DSA_N; map = 3; gain = a.in[3] + (size_t)(2 * j + 1) * 1024; WT = Wb + W_WIND + (size_t)j * DSA_N * 1024; }
        else if (mi < 14) { const int j = mi - 12; W = a.in[12] + (size_t)j * 1024 * 1024; K = 1024; N = 1024; Nout = 1024;  WT = Wb + W_WOD + (size_t)j * 1024 * 1024; }
        else if (mi < 18) { const int i = mi - 14; W = a.in[13] + (size_t)i * 256 * 1024;  K = 256;  N = 1024; Nout = 1024;  WT = Wb + W_WP + (size_t)i * 1024 * 256; }
        else              { const int i = mi - 18; W = a.in[15] + (size_t)i * 1024 * 1024; K = 1024; N = 1024; Nout = 1024;  gain = a.in[14] + (size_t)i * 1024; WT = Wb + W_WG + (size_t)i * 1024 * 1024; }
        const int nitems = (K / 64) * (Nout / 32);
        for (int it = gw; it < nitems; it += ngw) tr_item(W, K, N, WT, Nout, gain, map, scr, it, lane);
    }
    {
        const int* pos = (const int*)a.in[2]; unsigned* r64 = (unsigned*)(a.ws + WS_ROPE64); unsigned* r32 = (unsigned*)(a.ws + WS_ROPE32);
        const float inv64 = 1.0f / powf(10000.0f, (float)lane / 64.0f);
        const float inv32 = 1.0f / powf(10000.0f, (float)(lane & 31) / 32.0f);
        for (int t0 = gw * 4; t0 < T; t0 += ngw * 4) { int pi[4];
#pragma unroll
          for (int a = 0; a < 4; ++a) pi[a] = pos[t0 + a];
#pragma unroll
          for (int a = 0; a < 4; ++a) { const int t = t0 + a; const float pf = (float)pi[a];
            { const float ang = pf * inv64; float sn, cs; sincosf(ang, &sn, &cs); r64[(size_t)t * 64 + lane] = pack_cs(cs, sn); }
            if (lane < 32) { const float ang = pf * inv32; float sn, cs; sincosf(ang, &sn, &cs); r32[(size_t)t * 32 + lane] = pack_cs(cs, sn); }
          } }
    }
    {
        const float* x = a.in[0]; bf16* xb = (bf16*)(a.ws + WS_XB0); float* rsx = (float*)(a.ws + WS_RSX);
        for (int r0 = gw * 4; r0 < T; r0 += ngw * 4) {
            f32x4 v[4][4];
#pragma unroll
            for (int a = 0; a < 4; ++a) { const f32x4* xr = (const f32x4*)(x + (size_t)(r0 + a) * 1024) + lane;
#pragma unroll
                for (int j = 0; j < 4; ++j) v[a][j] = xr[64 * j]; }
#pragma unroll
            for (int a = 0; a < 4; ++a) { float s = 0.f;
#pragma unroll
                for (int j = 0; j < 4; ++j) s += sq4(v[a][j]);
                s = wave_sum(s);
                u32x2* o8 = (u32x2*)(xb + (size_t)(r0 + a) * 1024) + lane;
#pragma unroll
                for (int j = 0; j < 4; ++j) { u32x2 w; w.x = cvtpk(v[a][j][0], v[a][j][1]); w.y = cvtpk(v[a][j][2], v[a][j][3]); o8[64 * j] = w; }
                if (lane < 16) rsx[(size_t)(r0 + a) * 16 + lane] = lane == 0 ? s : 0.f; }
        }
    }
}
__device__ __forceinline__ void convert_p(const float* p, bf16* pb, int gtid_in, int gthreads) {
    const int gtid = gtid_in;
    constexpr size_t NCH = (size_t)T * 256 / 8;
    size_t i = gtid;
    for (; i + 3 * (size_t)gthreads < NCH; i += 4 * (size_t)gthreads) { f32x4 a[4], b[4];
#pragma unroll
        for (int u = 0; u < 4; ++u) { const size_t c = i + u * (size_t)gthreads; a[u] = *(const f32x4*)(p + c * 8); b[u] = *(const f32x4*)(p + c * 8 + 4); }
#pragma unroll
        for (int u = 0; u < 4; ++u) { const size_t c = i + u * (size_t)gthreads; *(v4u*)(pb + c * 8) = pack8(a[u], b[u]); } }
    for (; i < NCH; i += gthreads) { const f32x4 a = *(const f32x4*)(p + i * 8), b = *(const f32x4*)(p + i * 8 + 4); *(v4u*)(pb + i * 8) = pack8(a, b); }
}

__device__ __forceinline__ unsigned f2key(float s) { const unsigned u = __builtin_bit_cast(unsigned, s); return (u & 0x80000000u) ? ~u : (u | 0x80000000u); }
__device__ __forceinline__ float relu_bits(float x) { const int i = __float_as_int(x); return __int_as_float(i > 0 ? i : 0); }
struct TkUnit { int b, q0; };
__device__ __forceinline__ TkUnit tk_unit(int i, int blk, int nblk, int per) {
    const int pass = i / (NB * per), rem = i - pass * NB * per, b = rem / per, w0 = blk + (rem - b * per) * nblk; TkUnit u; u.b = b; u.q0 = (pass ? 511 - w0 : w0) * 8; return u;
}
constexpr int TK_H1 = 131072, TK_HW = 131072 + 16384, TK_HWS = 576;
struct TkPre { bf16x8 aX[4], aY[4]; f32x4 w[4][2]; bf16x8 kA[4], kB[4], kC[4]; };
__device__ __forceinline__ void tk_preload(TkPre& P, const TkUnit u, int aw, int lane, const bf16* QI, const bf16* KI, const float* WI) {
    const int r = lane & 31, hb = lane >> 5;
    const int a_q = ((r >> 2) & 1) * 2 + (r >> 4), a_h = (r & 3) + 4 * ((r >> 3) & 1);
    const size_t tok0 = (size_t)u.b * SEQ + u.q0; const int ntile = (u.q0 + 8 + 31) >> 5;
#pragma unroll
    for (int s = 0; s < 4; ++s) { P.aX[s] = *(const bf16x8*)(QI + (tok0 + a_q) * 512 + a_h * 64 + 16 * s + 8 * hb); P.aY[s] = *(const bf16x8*)(QI + (tok0 + 4 + a_q) * 512 + a_h * 64 + 16 * s + 8 * hb); }
#pragma unroll
    for (int i = 0; i < 4; ++i) { const int qc = (i >> 1) * 4 + 2 * hb + (i & 1); P.w[i][0] = *(const f32x4*)(WI + (tok0 + qc) * 8); P.w[i][1] = *(const f32x4*)(WI + (tok0 + qc) * 8 + 4); }
    const bf16* kbase = KI + ((size_t)u.b * SEQ + r) * 64 + 8 * hb;
#pragma unroll
    for (int j = 0; j < 3; ++j) { const int t = aw + 4 * j, tt = t < ntile ? t : ntile - 1;
#pragma unroll
        for (int s = 0; s < 4; ++s) { const bf16x8 v = *(const bf16x8*)(kbase + (size_t)tt * 32 * 64 + 16 * s); if (j == 0) P.kA[s] = v; else if (j == 1) P.kB[s] = v; else P.kC[s] = v; } }
}
__device__ __forceinline__ void tk_stepA(TkPre& P, const TkUnit u, const TkUnit nxt, bool has_next, int aw, int lane, LAS unsigned char* lds, const bf16* QI, const bf16* KI, const float* WI) {
    typedef float f32x16 __attribute__((ext_vector_type(16)));
    LAS unsigned* ky = (LAS unsigned*)lds; LAS unsigned* h1 = (LAS unsigned*)(lds + TK_H1) + (lane & 3) * 1024;
    const int r = lane & 31, hb = lane >> 5;
    const int q0 = u.q0;
    float wv[4][8];
#pragma unroll
    for (int i = 0; i < 4; ++i) {
#pragma unroll
        for (int e = 0; e < 4; ++e) { wv[i][e] = P.w[i][0][e] * (0.125f * 0.35355339059327373f); wv[i][4 + e] = P.w[i][1][e] * (0.125f * 0.35355339059327373f); } }
    const int ntile = (q0 + 8 + 31) >> 5;
    const unsigned kvoff = (unsigned)(r * 64 + 8 * hb) * 2u;
    __amdgpu_buffer_rsrc_t krs; { const unsigned long long b_ = (unsigned long long)(KI + (size_t)u.b * SEQ * 64);
        const unsigned lo_ = __builtin_amdgcn_readfirstlane((unsigned)b_), hi_ = __builtin_amdgcn_readfirstlane((unsigned)(b_ >> 32));
        krs = __builtin_amdgcn_make_buffer_rsrc((void*)(((unsigned long long)hi_ << 32) | lo_), (short)0, 0x7fffffff, 0x00020000); }
    bf16x8 kD[4];
#define TK_KLOAD(buf, t) do { const int tt_ = (t) < ntile ? (t) : ntile - 1;     \
        _Pragma("unroll") for (int s = 0; s < 4; ++s) buf[s] = __builtin_bit_cast(bf16x8, __builtin_amdgcn_raw_buffer_load_b128(krs, (int)(kvoff + 32u * s), tt_ * 4096, 0)); } while (0)
#define TK_TILE(buf, t) do { if ((t) < ntile) { const int key = (t) * 32 + r; f32x16 cX = {}, cY = {};                                                            \
        _Pragma("unroll") for (int s = 0; s < 4; ++s) { cX = __builtin_amdgcn_mfma_f32_32x32x16_bf16(P.aX[s], buf[s], cX, 0, 0, 0); cY = __builtin_amdgcn_mfma_f32_32x32x16_bf16(P.aY[s], buf[s], cY, 0, 0, 0); } \
        float sc[4] = {0.f, 0.f, 0.f, 0.f};                                                                                                                      \
        _Pragma("unroll") for (int e = 0; e < 8; ++e) { sc[0] = __builtin_fmaf(relu_bits(cX[e]), wv[0][e], sc[0]); sc[1] = __builtin_fmaf(relu_bits(cX[8 + e]), wv[1][e], sc[1]); \
                                                        sc[2] = __builtin_fmaf(relu_bits(cY[e]), wv[2][e], sc[2]); sc[3] = __builtin_fmaf(relu_bits(cY[8 + e]), wv[3][e], sc[3]); } \
        _Pragma("unroll") for (int i = 0; i < 4; ++i) { const int qc = (i >> 1) * 4 + 2 * hb + (i & 1); const unsigned ub = __builtin_bit_cast(unsigned, sc[i] + 0.0f);        \
            const unsigned kf = ub ^ ((unsigned)((int)ub >> 31) | 0x80000000u);                                      \
            const unsigned kk = (key <= q0 + qc) ? kf : 0u; ky[qc * 4096 + key] = kk;                                                                            \
            __hip_atomic_fetch_add(h1 + qc * 128 + (kk >> 25), 1u << ((kk >> 20) & 16u), __ATOMIC_RELAXED, __HIP_MEMORY_SCOPE_WORKGROUP); } } } while (0)
    for (int tile = aw; tile < ntile; tile += 16) {
        TK_KLOAD(kD, tile + 12); TK_TILE(P.kA, tile);
        TK_KLOAD(P.kA, tile + 16); TK_TILE(P.kB, tile + 4);
        TK_KLOAD(P.kB, tile + 20); TK_TILE(P.kC, tile + 8);
        TK_KLOAD(P.kC, tile + 24); TK_TILE(kD, tile + 12);
    }
#undef TK_KLOAD
#undef TK_TILE
    const int kend = ((q0 + 8 + 511) >> 9) << 9;
    for (int key = ntile * 32 + aw * 64 + lane; key < kend; key += 256) {
#pragma unroll
        for (int i = 0; i < 8; ++i) ky[i * 4096 + key] = 0u; }
    if (has_next) tk_preload(P, nxt, aw, lane, QI, KI, WI);
}
__device__ __forceinline__ void tk_stepB(const unsigned (&k)[64], int q, size_t tok, int ngrp, int lane, const int (&c0)[4], LAS unsigned* hw, unsigned long long* mask) {
    unsigned thr = 0u; int need = 0;
    if (q >= 256) {
        unsigned prefix = 0u; int rem = 256; bool done = false;
#pragma unroll
        for (int p = 0; p < 4; ++p) {
            constexpr int SH[4] = {24, 15, 6, 0}, NBITS[4] = {8, 9, 9, 6};
            const int sh = SH[p], nb = NBITS[p];
            int c[8];
            if (p == 0) { c[0] = c0[0]; c[1] = c0[1]; c[2] = c0[2]; c[3] = c0[3]; c[4] = 0; c[5] = 0; c[6] = 0; c[7] = 0; }
            else {
                *(LAS v4u*)(hw + lane * 8) = (v4u){0u, 0u, 0u, 0u}; *(LAS v4u*)(hw + lane * 8 + 4) = (v4u){0u, 0u, 0u, 0u};
                const unsigned pfx = prefix >> (sh + nb), dummy = 512u + (unsigned)lane;
#pragma unroll
                for (int g = 0; g < 8; ++g) if (g < ngrp) {
#pragma unroll
                    for (int e = 0; e < 8; ++e) { const unsigned kk = k[g * 8 + e]; const bool cand = (kk >> (sh + nb)) == pfx; const unsigned bin = (kk >> sh) & ((1u << nb) - 1u);
                        if (p == 1) __hip_atomic_fetch_add(hw + (cand ? bin : dummy), 1u, __ATOMIC_RELAXED, __HIP_MEMORY_SCOPE_WORKGROUP);
                        else if (__ballot(cand) != 0ull) { if (cand) __hip_atomic_fetch_add(hw + bin, 1u, __ATOMIC_RELAXED, __HIP_MEMORY_SCOPE_WORKGROUP); } }
                    __builtin_amdgcn_sched_barrier(0); }
                LDS_WAIT(); asm volatile("" ::: "memory");
                const v4u h0 = *(const LAS v4u*)(hw + lane * 8), h1v = *(const LAS v4u*)(hw + lane * 8 + 4);
                c[0] = (int)h0.x; c[1] = (int)h0.y; c[2] = (int)h0.z; c[3] = (int)h0.w; c[4] = (int)h1v.x; c[5] = (int)h1v.y; c[6] = (int)h1v.z; c[7] = (int)h1v.w; }
            const int tot = ((c[0] + c[1]) + (c[2] + c[3])) + ((c[4] + c[5]) + (c[6] + c[7]));
            int P = tot;
            P += __builtin_amdgcn_update_dpp(0, P, 0x111, 0xf, 0xf, false); P += __builtin_amdgcn_update_dpp(0, P, 0x112, 0xf, 0xf, false);
            P += __builtin_amdgcn_update_dpp(0, P, 0x114, 0xf, 0xf, false); P += __builtin_amdgcn_update_dpp(0, P, 0x118, 0xf, 0xf, false);
            P += __builtin_amdgcn_update_dpp(0, P, 0x142, 0xa, 0xf, false); P += __builtin_amdgcn_update_dpp(0, P, 0x143, 0xc, 0xf, false);
            const int total = __builtin_amdgcn_readlane(P, 63);
            const int snext = total - P;
            const int L = __popcll(__ballot(snext + tot >= rem)) - 1;
            int s = snext, dl = 0, cgl = 0, cel = 0;
#pragma unroll
            for (int e = 7; e >= 0; --e) { const int s2 = s + c[e]; const bool hit = (s < rem) && (s2 >= rem); dl = hit ? e : dl; cgl = hit ? s : cgl; cel = hit ? c[e] : cel; s = s2; }
            const int d = L * (p == 0 ? 4 : 8) + __builtin_amdgcn_readlane(dl, L), cgt = __builtin_amdgcn_readlane(cgl, L), ceq = __builtin_amdgcn_readlane(cel, L);
            rem -= cgt; prefix |= (unsigned)d << sh;
            if (ceq == rem) { done = true; break; }
        }
        if (done) { thr = prefix - 1u; need = 0; } else { thr = prefix; need = rem; }
    }
    unsigned wlo = 0u, whi = 0u;
#define WL(J, w) do { const unsigned lo_ = (unsigned)(w), hi_ = (unsigned)((w) >> 32);                                                                      \
                asm volatile("s_nop 3\n\tv_writelane_b32 %0, %2, " #J "\n\tv_writelane_b32 %1, %3, " #J : "+v"(wlo), "+v"(whi) : "s"(lo_), "s"(hi_)); } while (0)
#define REP64(M) M(0); M(1); M(2); M(3); M(4); M(5); M(6); M(7); __builtin_amdgcn_sched_barrier(0); M(8); M(9); M(10); M(11); M(12); M(13); M(14); M(15); __builtin_amdgcn_sched_barrier(0); \
                 M(16); M(17); M(18); M(19); M(20); M(21); M(22); M(23); __builtin_amdgcn_sched_barrier(0); M(24); M(25); M(26); M(27); M(28); M(29); M(30); M(31); __builtin_amdgcn_sched_barrier(0); \
                 M(32); M(33); M(34); M(35); M(36); M(37); M(38); M(39); __builtin_amdgcn_sched_barrier(0); M(40); M(41); M(42); M(43); M(44); M(45); M(46); M(47); __builtin_amdgcn_sched_barrier(0); \
                 M(48); M(49); M(50); M(51); M(52); M(53); M(54); M(55); __builtin_amdgcn_sched_barrier(0); M(56); M(57); M(58); M(59); M(60); M(61); M(62); M(63); __builtin_amdgcn_sched_barrier(0)
    if (need == 0) {
#define SEL_GT8(J0, J1, J2, J3, J4, J5, J6, J7) do { const unsigned long long w0_ = __ballot(k[J0] > thr); const unsigned long long w1_ = __ballot(k[J1] > thr); const unsigned long long w2_ = __ballot(k[J2] > thr); const unsigned long long w3_ = __ballot(k[J3] > thr); const unsigned long long w4_ = __ballot(k[J4] > thr); const unsigned long long w5_ = __ballot(k[J5] > thr); const unsigned long long w6_ = __ballot(k[J6] > thr); const unsigned long long w7_ = __ballot(k[J7] > thr);                                     \
                asm volatile("s_nop 3\n\t" "v_writelane_b32 %0, %2, " #J0 "\n\tv_writelane_b32 %1, %3, " #J0 "\n\t" "v_writelane_b32 %0, %4, " #J1 "\n\tv_writelane_b32 %1, %5, " #J1 "\n\t" "v_writelane_b32 %0, %6, " #J2 "\n\tv_writelane_b32 %1, %7, " #J2 "\n\t" "v_writelane_b32 %0, %8, " #J3 "\n\tv_writelane_b32 %1, %9, " #J3 "\n\t" "v_writelane_b32 %0, %10, " #J4 "\n\tv_writelane_b32 %1, %11, " #J4 "\n\t" "v_writelane_b32 %0, %12, " #J5 "\n\tv_writelane_b32 %1, %13, " #J5 "\n\t" "v_writelane_b32 %0, %14, " #J6 "\n\tv_writelane_b32 %1, %15, " #J6 "\n\t" "v_writelane_b32 %0, %16, " #J7 "\n\tv_writelane_b32 %1, %17, " #J7 "\n\t" : "+v"(wlo), "+v"(whi) : "s"((unsigned)(w0_)), "s"((unsigned)((w0_) >> 32)), "s"((unsigned)(w1_)), "s"((unsigned)((w1_) >> 32)), "s"((unsigned)(w2_)), "s"((unsigned)((w2_) >> 32)), "s"((unsigned)(w3_)), "s"((unsigned)((w3_) >> 32)), "s"((unsigned)(w4_)), "s"((unsigned)((w4_) >> 32)), "s"((unsigned)(w5_)), "s"((unsigned)((w5_) >> 32)), "s"((unsigned)(w6_)), "s"((unsigned)((w6_) >> 32)), "s"((unsigned)(w7_)), "s"((unsigned)((w7_) >> 32))); __builtin_amdgcn_sched_barrier(0); } while (0)
        SEL_GT8(0, 1, 2, 3, 4, 5, 6, 7); SEL_GT8(8, 9, 10, 11, 12, 13, 14, 15); SEL_GT8(16, 17, 18, 19, 20, 21, 22, 23); SEL_GT8(24, 25, 26, 27, 28, 29, 30, 31);
        SEL_GT8(32, 33, 34, 35, 36, 37, 38, 39); SEL_GT8(40, 41, 42, 43, 44, 45, 46, 47); SEL_GT8(48, 49, 50, 51, 52, 53, 54, 55); SEL_GT8(56, 57, 58, 59, 60, 61, 62, 63);
#undef SEL_GT8
    } else {
        int run = 0; const unsigned long long ltmask = (1ull << lane) - 1ull;
#define SEL_TIE(J) do { const unsigned kk = k[J]; const bool eq = kk == thr; const unsigned long long beq = __ballot(eq);                                   \
                const int rank = run + __popcll(beq & ltmask); const bool sel = (kk > thr) || (eq && rank < need);                                          \
                const unsigned long long w = __ballot(sel); WL(J, w); run += __popcll(beq); } while (0)
        REP64(SEL_TIE);
#undef SEL_TIE
    }
#undef REP64
#undef WL
    mask[tok * 64 + lane] = ((unsigned long long)whi << 32) | wlo;
}
#define TK_LOADK(kk, rowi, ngrp_) do { const LAS unsigned* row_ = (const LAS unsigned*)lds + (rowi) * 4096;                                      \
        _Pragma("unroll") for (int g = 0; g < 8; ++g) { if (g < (ngrp_)) { _Pragma("unroll") for (int e = 0; e < 8; ++e) kk[g * 8 + e] = row_[(g * 8 + e) * 64 + lane]; } \
            else { _Pragma("unroll") for (int e = 0; e < 8; ++e) kk[g * 8 + e] = 0u; } } } while (0)
__device__ __forceinline__ void topk_phase(int blk, int nblk, int wave, int lane, LAS unsigned char* lds, const bf16* QI, const bf16* KI, const float* WI, unsigned long long* mask) {
    const bool isA = wave < 4; const int aw = wave, bw = wave - 4;
    const int per = (256 - blk + nblk - 1) / nblk, n = NB * 2 * per;
    if (per <= 0) return;
    { LAS unsigned* z = (LAS unsigned*)(lds + TK_H1); for (int i = wave * 64 + lane; i < 4096; i += 512) z[i] = 0u; }
    LDS_WAIT(); __syncthreads();
    if (isA) {
        TkPre P; tk_preload(P, tk_unit(0, blk, nblk, per), aw, lane, QI, KI, WI);
        tk_stepA(P, tk_unit(0, blk, nblk, per), tk_unit(n > 1 ? 1 : 0, blk, nblk, per), n > 1, aw, lane, lds, QI, KI, WI);
        LDS_WAIT(); __builtin_amdgcn_s_barrier();
        for (int s = 1; s <= n; ++s) {
            LDS_WAIT(); __builtin_amdgcn_s_barrier();
            if (s < n) tk_stepA(P, tk_unit(s, blk, nblk, per), tk_unit(s + 1 < n ? s + 1 : s, blk, nblk, per), s + 1 < n, aw, lane, lds, QI, KI, WI);
            LDS_WAIT(); __builtin_amdgcn_s_barrier();
        }
    } else {
        LDS_WAIT(); __builtin_amdgcn_s_barrier();
        for (int s = 1; s <= n; ++s) {
            const TkUnit up = tk_unit(s - 1, blk, nblk, per);
            const int ngrp = (((up.q0 + 8 + 511) >> 9) << 9) >> 9;
            unsigned k0[64], k1[64];
            TK_LOADK(k0, 2 * bw, ngrp); TK_LOADK(k1, 2 * bw + 1, ngrp);
            int c00[4] = {0, 0, 0, 0}, c01[4] = {0, 0, 0, 0};
            { LAS unsigned* hb0 = (LAS unsigned*)(lds + TK_H1) + (2 * bw) * 128 + lane * 2;
#pragma unroll
              for (int cp = 0; cp < 4; ++cp) { const u32x2 a = *(const LAS u32x2*)(hb0 + cp * 1024), b = *(const LAS u32x2*)(hb0 + cp * 1024 + 128);
                  c00[0] += (int)(a.x & 0xffffu); c00[1] += (int)(a.x >> 16); c00[2] += (int)(a.y & 0xffffu); c00[3] += (int)(a.y >> 16);
                  c01[0] += (int)(b.x & 0xffffu); c01[1] += (int)(b.x >> 16); c01[2] += (int)(b.y & 0xffffu); c01[3] += (int)(b.y >> 16);
                  *(LAS u32x2*)(hb0 + cp * 1024) = (u32x2){0u, 0u}; *(LAS u32x2*)(hb0 + cp * 1024 + 128) = (u32x2){0u, 0u}; } }
            LDS_WAIT(); __builtin_amdgcn_s_barrier();
            LAS unsigned* hw = (LAS unsigned*)(lds + TK_HW) + bw * TK_HWS;
            const size_t tok0 = (size_t)up.b * SEQ + up.q0;
            tk_stepB(k0, up.q0 + 2 * bw, tok0 + 2 * bw, ngrp, lane, c00, hw, mask);
            tk_stepB(k1, up.q0 + 2 * bw + 1, tok0 + 2 * bw + 1, ngrp, lane, c01, hw, mask);
            LDS_WAIT(); __builtin_amdgcn_s_barrier();
        }
    }
    __syncthreads();
}
#undef TK_LOADK

#define PROBE 0
#define IN(k) (lo <= (k) && (k) < hi)
#define SEAM(k) do { if (IN(k) && IN((k) + 1)) { xcd_barrier(bar); if (PROBE == 50) xcd_barrier(bar); } } while (0)
#define WSP(T_, off) ((T_*)(args.ws + (off)))
__device__ __forceinline__ int opaque_tid() { int t = threadIdx.x; asm volatile("" : "+v"(t)); return t; }
#define PROBE 0
template <int I>
__device__ __forceinline__ void layer(const Args& args, LAS unsigned char* lds, const XcdBarrier& bar, const int lo, const int hi, const int G, const int bx) {
    constexpr int k0 = 1 + 5 * I, j = I >> 1;
    extern __shared__ __attribute__((aligned(16))) unsigned char lds_dyn[];
#define ldsg ((char*)lds_dyn)
#define TID_ (opaque_tid())
#define LANE_ ((int)threadIdx.x & 63)
#define WAVE_ (__builtin_amdgcn_readfirstlane((int)threadIdx.x >> 6))
    if constexpr ((I & 1) == 0) {
        if (IN(k0)) {
            pg8::Gemm g{WSP(bf16, WS_XB0), WSP(bf16, WS_W) + W_WINM + (size_t)j * MLA_N * 1024, T, MLA_N, 1024}; pg8::StaticOrder S; S.init(T, MLA_N, G, bx);
            EpiMlaIn E{WSP(float, WS_RSX), WSP(bf16, WS_CQ), WSP(bf16, WS_CKV), WSP(bf16, WS_SZ), WSP(bf16, WS_KPE), WSP(float, WS_RSQ), WSP(float, WS_RSKV), WSP(unsigned, WS_ROPE32)};
            if (PROBE == 5 && I == 0) pg8::gemm_phase<EpiMlaIn, pg8::StaticOrder, true, true>(lds, g, S, E);
            pg8::gemm_phase<EpiMlaIn, pg8::StaticOrder, true, true>(lds, g, S, E);
        }
        SEAM(k0);
        if (IN(k0 + 1)) for (int rep = 0; rep < ((PROBE == 4 && I < 2) ? 2 : 1); ++rep) {
            { pg8::Gemm g{WSP(bf16, WS_CQ), WSP(bf16, WS_W) + W_WUQ + (size_t)j * 1536 * 256, T, 1536, 256}; pg8::StaticOrder S; S.init(T, 1536, G, bx); EpiMlaQ E{WSP(float, WS_RSQ), WSP(bf16, WS_Q), WSP(unsigned, WS_ROPE32)};
              pg8::gemm_phase<EpiMlaQ, pg8::StaticOrder, true, true>(lds, g, S, E); }
            { pg8::Gemm g{WSP(bf16, WS_CKV), WSP(bf16, WS_W) + W_WUK + (size_t)j * 1024 * 256, T, 1024, 256}; pg8::StaticOrder S; S.init(T, 1024, G, bx); EpiMlaKV E{WSP(float, WS_RSKV), WSP(bf16, WS_KN)};
              pg8::gemm_phase<EpiMlaKV, pg8::StaticOrder, true, true>(lds, g, S, E); }
            { pg8::Gemm g{WSP(bf16, WS_CKV), WSP(bf16, WS_W) + W_WUV + (size_t)j * 1024 * 256, T, 1024, 256}; pg8::StaticOrder S; S.init(T, 1024, G, bx); EpiMlaKV E{WSP(float, WS_RSKV), WSP(bf16, WS_V)};
              pg8::gemm_phase<EpiMlaKV, pg8::StaticOrder, true, true>(lds, g, S, E); }
        }
        SEAM(k0 + 1);
        if (IN(k0 + 2)) {
            for (int rep = (PROBE == 11 && I == 0) ? 0 : 1; rep < 2; ++rep)
            att::attn_phase<true, false, 1536, 192, 1024, 1024, 8>(ldsg, WSP(bf16, WS_Q), WSP(bf16, WS_KN), WSP(bf16, WS_V), WSP(bf16, WS_KPE), WSP(bf16, WS_SZ), nullptr, 0.07216878364870323f, args.in[1] + (size_t)I * T * 256, WSP(bf16, WS_PB), rep == 0);
        }
        SEAM(k0 + 2);
    } else {
        if (IN(k0)) {
            pg8::Gemm g{WSP(bf16, WS_XB0), WSP(bf16, WS_W) + W_WIND + (size_t)j * DSA_N * 1024, T, DSA_N, 1024}; pg8::StaticOrder S; S.init(T, DSA_N, G, bx);
            EpiDsaIn E{WSP(float, WS_RSX), WSP(bf16, WS_Q), WSP(bf16, WS_KD), WSP(bf16, WS_VD), WSP(bf16, WS_QI), WSP(bf16, WS_SZ), WSP(bf16, WS_KI), WSP(float, WS_WI), WSP(unsigned, WS_ROPE64), WSP(unsigned, WS_ROPE32)};
            for (int rep = 0; rep < ((PROBE == 4 && I < 2) ? 2 : 1); ++rep) pg8::gemm_phase<EpiDsaIn, pg8::StaticOrder, true, true>(lds, g, S, E);
        }
        SEAM(k0);
        if (IN(k0 + 1)) {
            topk_phase(bx, G, WAVE_, LANE_, lds, WSP(bf16, WS_QI), WSP(bf16, WS_KI), WSP(float, WS_WI), WSP(unsigned long long, WS_MASK)); }
        SEAM(k0 + 1);
        if (IN(k0 + 2)) {
            if (PROBE == 2 && I == 1) att::attn_phase<false, true, 1024, 128, 256, 256, 2, true>(ldsg, WSP(bf16, WS_Q), WSP(bf16, WS_KD), WSP(bf16, WS_VD), nullptr, WSP(bf16, WS_SZ), WSP(unsigned long long, WS_MASK), 0.08838834764831845f, args.in[1] + (size_t)I * T * 256, WSP(bf16, WS_PB));
            att::attn_phase<false, true, 1024, 128, 256, 256, 2>(ldsg, WSP(bf16, WS_Q), WSP(bf16, WS_KD), WSP(bf16, WS_VD), nullptr, WSP(bf16, WS_SZ), WSP(unsigned long long, WS_MASK), 0.08838834764831845f, args.in[1] + (size_t)I * T * 256, WSP(bf16, WS_PB));
        }
        SEAM(k0 + 2);
    }
    if (IN(k0 + 3)) for (int rep = ((PROBE == 4 && I < 2) ? 0 : 1); rep < 2; ++rep) {
        { pg8::Gemm g{WSP(bf16, WS_PB), WSP(bf16, WS_W) + W_WP + (size_t)I * 1024 * 256, T, 1024, 256}; pg8::StaticOrder S; S.init(T, 1024, G, bx); EpiPlain E{WSP(bf16, WS_PP)};
          pg8::gemm_phase<EpiPlain, pg8::StaticOrder, true, true>(lds, g, S, E); }
        { pg8::Gemm g{WSP(bf16, WS_SZ), WSP(bf16, WS_W) + ((I & 1) ? W_WOD : W_WOM) + (size_t)j * 1024 * 1024, T, 1024, 1024}; pg8::StaticOrder S; S.init(T, 1024, G, bx);
          EpiOut E{WSP(bf16, WS_XB0), WSP(bf16, WS_XB1), WSP(float, WS_RS1), rep == 0};
          pg8::gemm_phase<EpiOut, pg8::StaticOrder, true, true>(lds, g, S, E); }
    }
    SEAM(k0 + 3);
    if (IN(k0 + 4)) for (int rep = ((PROBE == 4 && I < 2) ? 0 : 1); rep < 2; ++rep) {
        pg8::Gemm g{WSP(bf16, WS_XB1), WSP(bf16, WS_W) + W_WG + (size_t)I * 1024 * 1024, T, 1024, 1024}; pg8::StaticOrder S; S.init(T, 1024, G, bx);
        EpiGate E{WSP(float, WS_RS1), WSP(bf16, WS_XB1), WSP(bf16, WS_PP), WSP(bf16, WS_XB0), WSP(float, WS_RSX), rep == 0};
        pg8::gemm_phase<EpiGate, pg8::StaticOrder, true, true>(lds, g, S, E);
    }
    SEAM(k0 + 4);
#undef TID_
#undef LANE_
#undef WAVE_
#undef ldsg
}

__global__ void __launch_bounds__(NWAVES * 64, 2) fwd(Args args) {
    extern __shared__ __attribute__((aligned(16))) unsigned char lds_raw[];
    LAS unsigned char* lds = (LAS unsigned char*)lds_raw;
    volatile LAS unsigned* MISC = (volatile LAS unsigned*)(lds + MISC_OFF);
    const int G = gridDim.x, bx = blockIdx.x;
    for (int u = threadIdx.x; u < (LDS_BYTES - MISC_OFF) / 4; u += NWAVES * 64) ((LAS unsigned*)(lds + MISC_OFF))[u] = 0u;
    __syncthreads();
    const int lo = args.ph_lo, hi = args.ph_hi;
    XcdBarrier bar; bar.bar = (unsigned*)(args.ws + WS_CTL) + CW_BAR; bar.x = 0; bar.st = nullptr;
    if (hi - lo > 1) bar = xcd_barrier_post((unsigned*)(args.ws + WS_CTL) + CW_BAR, MISC + 8);

    if (IN(0)) { const int lane = threadIdx.x & 63, wave = __builtin_amdgcn_readfirstlane((int)threadIdx.x >> 6);
        if (PROBE == 8) prologue(args, lds, bx * NWAVES + wave, G * NWAVES, wave, lane); prologue(args, lds, bx * NWAVES + wave, G * NWAVES, wave, lane); }
    SEAM(0);
    layer<0>(args, lds, bar, lo, hi, G, bx);
    layer<1>(args, lds, bar, lo, hi, G, bx);
    layer<2>(args, lds, bar, lo, hi, G, bx);
    layer<3>(args, lds, bar, lo, hi, G, bx);
    if (IN(21)) {
        const int lane = threadIdx.x & 63, wave = __builtin_amdgcn_readfirstlane((int)threadIdx.x >> 6);
        const int gw = bx * NWAVES + wave, ngw = G * NWAVES;
        const float* fg = args.in[16]; f32x4 gv[4];
#pragma unroll
        for (int jj = 0; jj < 4; ++jj) gv[jj] = ((const f32x4*)fg)[lane + 64 * jj];
        const bf16* xbf = (const bf16*)(args.ws + WS_XB0);
        for (int r0 = gw * 2; r0 < T; r0 += ngw * 2) { u32x2 w[2][4];
#pragma unroll
            for (int a = 0; a < 2; ++a) { const u32x2* xr = (const u32x2*)(xbf + (size_t)(r0 + a) * 1024) + lane;
#pragma unroll
                for (int jj = 0; jj < 4; ++jj) w[a][jj] = xr[64 * jj]; }
#pragma unroll
            for (int a = 0; a < 2; ++a) { f32x4 v[4]; float s = 0.f;
#pragma unroll
                for (int jj = 0; jj < 4; ++jj) { v[jj][0] = bf2f(w[a][jj].x & 0xffffu); v[jj][1] = bf2f(w[a][jj].x >> 16); v[jj][2] = bf2f(w[a][jj].y & 0xffffu); v[jj][3] = bf2f(w[a][jj].y >> 16); s += sq4(v[jj]); }
                const float rstd = rsqrtf(wave_sum(s) * (1.f / 1024.f) + NORM_EPS);
                f32x4* orow = (f32x4*)(args.out + (size_t)(r0 + a) * 1024) + lane;
#pragma unroll
                for (int jj = 0; jj < 4; ++jj) orow[64 * jj] = v[jj] * rstd * gv[jj]; } }
    }
}
#undef IN
#undef SEAM

#if PROBE == 12 || PROBE == 13
__global__ void __launch_bounds__(NWAVES * 64, 2) probe_attn(Args args) {
    extern __shared__ __attribute__((aligned(16))) unsigned char lds_raw[];
#if PROBE == 12
    att::attn_phase<true, false, 1536, 192, 1024, 1024, 8, true>((char*)lds_raw, WSP(bf16, WS_Q), WSP(bf16, WS_KN), WSP(bf16, WS_V), WSP(bf16, WS_KPE), WSP(bf16, WS_SZ), nullptr, 0.07216878364870323f, args.in[1], WSP(bf16, WS_PB));
#else
    att::attn_phase<false, true, 1024, 128, 256, 256, 2, true>((char*)lds_raw, WSP(bf16, WS_Q), WSP(bf16, WS_KD), WSP(bf16, WS_VD), nullptr, WSP(bf16, WS_SZ), WSP(unsigned long long, WS_MASK), 0.08838834764831845f, args.in[1], WSP(bf16, WS_PB));
#endif
}
#endif
#ifndef ONE_LAUNCH
#define ONE_LAUNCH 1
#endif
extern "C" void kernel_launch(void* const* d_in, const int* in_sizes, int n_in, void* d_out, int out_size, void* d_ws, size_t ws_size, hipStream_t stream) {
    static int grid = 0;
    if (grid == 0) {
        if (n_in != 17 || out_size != T * DM || ws_size < WS_END) { fprintf(stderr, "kernel_launch: unexpected shapes (n_in %d, out %d, ws %zu)\n", n_in, out_size, ws_size); grid = -1; return; }
        int dev = 0, cus = 0, per_cu = 0;
        if (hipGetDevice(&dev) != hipSuccess || hipDeviceGetAttribute(&cus, hipDeviceAttributeMultiprocessorCount, dev) != hipSuccess) { grid = -1; return; }
        if (hipFuncSetAttribute((const void*)fwd, hipFuncAttributeMaxDynamicSharedMemorySize, LDS_BYTES) != hipSuccess) { fprintf(stderr, "kernel_launch: hipFuncSetAttribute failed\n"); grid = -1; return; }
        if (hipOccupancyMaxActiveBlocksPerMultiprocessor(&per_cu, (const void*)fwd, NWAVES * 64, LDS_BYTES) != hipSuccess || per_cu < 1) fprintf(stderr, "kernel_launch: occupancy query says %d\n", per_cu);
        (void)hipGetLastError();
        grid = cus;
    }
    if (grid < 0) return;
    (void)hipMemsetAsync((char*)d_ws + WS_CTL, 0, CTL_ZERO_BYTES, stream);
    Args a{};
    for (int i = 0; i < 17; ++i) a.in[i] = (const float*)d_in[i];
    a.out = (float*)d_out; a.ws = (unsigned char*)d_ws;
    if (ONE_LAUNCH) { a.ph_lo = 0; a.ph_hi = NPHASE; hipLaunchKernelGGL(fwd, dim3(grid), dim3(NWAVES * 64), LDS_BYTES, stream, a); }
    else for (int ph = 0; ph < NPHASE; ++ph) { a.ph_lo = ph; a.ph_hi = ph + 1; hipLaunchKernelGGL(fwd, dim3(grid), dim3(NWAVES * 64), LDS_BYTES, stream, a); }
#if PROBE >= 100
    a.pmode = (PROBE / 100) - 1; a.ph_lo = PROBE % 100; a.ph_hi = PROBE % 100 + 1; hipLaunchKernelGGL(fwd, dim3(grid), dim3(NWAVES * 64), LDS_BYTES, stream, a);
#endif
#if PROBE == 12 || PROBE == 13
    { static bool attr2 = false; if (!attr2) { attr2 = true; (void)hipFuncSetAttribute((const void*)probe_attn, hipFuncAttributeMaxDynamicSharedMemorySize, LDS_BYTES); }
      hipLaunchKernelGGL(probe_attn, dim3(grid), dim3(NWAVES * 64), LDS_BYTES, stream, a); }
#endif
}
```

```cpp
#include <hip/hip_runtime.h>
#include <cstdio>
#include <cstdint>
namespace pg8 {
#define PG8_LAS __attribute__((address_space(3)))
typedef unsigned short bf16_t;
typedef short bf16x8 __attribute__((ext_vector_type(8)));
typedef float f32x4 __attribute__((ext_vector_type(4)));
typedef unsigned u32x4 __attribute__((ext_vector_type(4)));
constexpr int BM = 256, BK = 64, HALF = 128, HTB = HALF * BK * 2  , STAGE_BYTES = 8 * HTB, NXCD = 8, WGM = 8;

__host__ __device__ __forceinline__ int lds_byte(int r, int c) { const int st = (r >> 4) * 2 + (c >> 5), rr = r & 15, cc = c & 31, ob = rr * 64 + cc * 2; return st * 1024 + (ob ^ (((ob >> 9) & 1) << 5)); }
__host__ __device__ __forceinline__ void stage_rc(int b, int& R, int& C) { const int st = b / 1024, sb = b % 1024, swz = sb ^ (((sb >> 9) & 1) << 5); R = (st >> 1) * 16 + swz / 64; C = (st & 1) * 32 + (swz % 64) / 2; }
__host__ __device__ __forceinline__ int perm32(int rho) { const int n = rho >> 4, i = rho & 15; return 8 * (i >> 2) + 4 * n + (i & 3); }

struct Unit { int pm, pn; };
struct Gemm { const bf16_t* A; const bf16_t* Bt; int M, N, K; };

struct StaticOrder {
    int nM, nN, nwg, G, c;
    __host__ __device__ void init(int M, int N, int G_, int c_) { nM = M / BM; nN = N / BM; nwg = nM * nN; G = G_; c = c_; }
    __host__ __device__ bool next(int i, Unit& u) const {
        const long L = (long)i * G + c; if (L >= nwg) return false;
        int wgid = (int)L; { const int q = nwg / NXCD, r = nwg % NXCD, xcd = wgid % NXCD, off = wgid / NXCD; wgid = (xcd < r ? xcd * (q + 1) : r * (q + 1) + (xcd - r) * q) + off; }
        const int nig = WGM * nN, gid = wgid / nig, fm = gid * WGM, gsz = (nM - fm) < WGM ? (nM - fm) : WGM;
        u.pm = fm + ((wgid % nig) % gsz); u.pn = (wgid % nig) / gsz; return true;
    }
    __device__ __forceinline__ void a_ready(const Unit&) const {}
    __device__ __forceinline__ void done(const Unit&) const {}
};

__device__ __forceinline__ unsigned cvt_pk_bf16(float lo, float hi) { unsigned r; asm volatile("v_cvt_pk_bf16_f32 %0, %1, %2" : "=v"(r) : "v"(lo), "v"(hi)); return r; }
typedef float f32x2 __attribute__((ext_vector_type(2)));
template <class Epi, class Sched, bool ALIGN_EPI = false, bool SP2 = false>
__device__ __forceinline__ void gemm_phase(PG8_LAS unsigned char* lds, const Gemm g, const Sched& S, const Epi& E) {
    const int tid = threadIdx.x, wid = __builtin_amdgcn_readfirstlane(tid >> 6), lane = tid & 63, wr = wid >> 2, wc = wid & 3, fr = lane & 15, fq = lane >> 4;
    const int K = g.K, nt = K / BK;
    unsigned voffA[2], voffB[2];
#pragma unroll
    for (int i = 0; i < 2; ++i) { int R, C; stage_rc(tid * 16 + i * 8192, R, C); const int Rb = Epi::PERM ? ((R & ~31) + perm32(R & 31)) : R;
        voffA[i] = (unsigned)(R * K + C) * 2u; voffB[i] = (unsigned)(Rb * K + C) * 2u; }
    const size_t kstep = (size_t)(BK * 2);
    const size_t hstep = (size_t)HALF * K * 2;
    const size_t tstep = 2 * hstep;
    const unsigned ldsw = (unsigned)wid * 1024u;
    const int aoff = lds_byte(wr * 64 + fr, fq * 8), boff = lds_byte(wc * 32 + fr, fq * 8);
#define PG8_SA(b, h) (((b) * 2 + (h)) * HTB)
#define PG8_SB(b, h) ((4 + (b) * 2 + (h)) * HTB)
#define PG8_STAGE(bufoff, gbase, voff) do { _Pragma("unroll") for (int _i = 0; _i < 2; ++_i) \
        __builtin_amdgcn_global_load_lds((const unsigned*)((const char*)(gbase) + (voff)[_i]), (PG8_LAS unsigned*)(lds + (bufoff) + ldsw + _i * 8192), 16, 0, 0); } while (0)
#define PG8_LDA(dst, b, h) do { _Pragma("unroll") for (int m = 0; m < 4; ++m) _Pragma("unroll") for (int k = 0; k < 2; ++k) dst[m][k] = *(const PG8_LAS bf16x8*)(lds + PG8_SA(b, h) + aoff + m * 2048 + k * 1024); } while (0)
#define PG8_LDB(dst, b, h) do { _Pragma("unroll") for (int n = 0; n < 2; ++n) _Pragma("unroll") for (int k = 0; k < 2; ++k) dst[n][k] = *(const PG8_LAS bf16x8*)(lds + PG8_SB(b, h) + boff + n * 2048 + k * 1024); } while (0)
#define PG8_MMA(ai, bj, At, Bt) do { __builtin_amdgcn_s_setprio(1); _Pragma("unroll") for (int m = 0; m < 4; ++m) _Pragma("unroll") for (int n = 0; n < 2; ++n) _Pragma("unroll") for (int k = 0; k < 2; ++k) \
        acc[ai][bj][m][n] = __builtin_amdgcn_mfma_f32_16x16x32_bf16(Bt[n][k], At[m][k], acc[ai][bj][m][n], 0, 0, 0); __builtin_amdgcn_s_setprio(0); } while (0)
#define PG8_WAIT_V(n) asm volatile("s_waitcnt vmcnt(" #n ")" ::: "memory")
#define PG8_WAIT_L(n) asm volatile("s_waitcnt lgkmcnt(" #n ")" ::: "memory")
#define PG8_BAR __builtin_amdgcn_s_barrier()
#define PG8_SCHED __builtin_amdgcn_sched_barrier(0)
    Unit cur, nxt; int ui = 0;
    if (!S.next(0, cur)) return;
    f32x4 acc[2][2][4][2];
#pragma unroll
    for (int a = 0; a < 2; ++a)
#pragma unroll
        for (int b = 0; b < 2; ++b)
#pragma unroll
            for (int m = 0; m < 4; ++m)
#pragma unroll
                for (int n = 0; n < 2; ++n) acc[a][b][m][n] = (f32x4){0.f, 0.f, 0.f, 0.f};
    bf16x8 At[4][2], B0[2][2], B1[2][2];
    const char* cA = (const char*)g.A + (size_t)cur.pm * tstep; const char* cB = (const char*)g.Bt + (size_t)cur.pn * tstep;
    S.a_ready(cur);
    if constexpr (SP2) {
        PG8_STAGE(PG8_SB(0, 0), cB, voffB); PG8_STAGE(PG8_SB(0, 1), cB + hstep, voffB); PG8_STAGE(PG8_SA(0, 0), cA, voffA); PG8_STAGE(PG8_SA(0, 1), cA + hstep, voffA);
        if (wr == 1) PG8_BAR;
        PG8_WAIT_V(2); PG8_BAR;
        PG8_STAGE(PG8_SB(1, 0), cB + kstep, voffB); PG8_STAGE(PG8_SA(1, 0), cA + kstep, voffA); PG8_STAGE(PG8_SB(1, 1), cB + hstep + kstep, voffB);
        PG8_WAIT_V(6); PG8_BAR;
    } else {
        PG8_STAGE(PG8_SB(0, 0), cB, voffB); PG8_STAGE(PG8_SA(0, 0), cA, voffA); PG8_STAGE(PG8_SB(0, 1), cB + hstep, voffB); PG8_STAGE(PG8_SA(0, 1), cA + hstep, voffA);
        if (wr == 1) PG8_BAR;
        PG8_WAIT_V(4); PG8_BAR;
        PG8_STAGE(PG8_SB(1, 0), cB + kstep, voffB); PG8_STAGE(PG8_SA(1, 0), cA + kstep, voffA); PG8_STAGE(PG8_SB(1, 1), cB + hstep + kstep, voffB);
        PG8_WAIT_V(6); PG8_BAR;
    }
    for (;;) {
        const bool has_next = S.next(ui + 1, nxt);
        const char* nA = has_next ? (const char*)g.A + (size_t)nxt.pm * tstep : cA; const char* nB = has_next ? (const char*)g.Bt + (size_t)nxt.pn * tstep : cB;
        _Pragma("nounroll") for (int t = 0; t < nt; t += 2) {
            const bool last = (t == nt - 2);
            const char* a1 = cA + (size_t)(t + 1) * kstep;
            const char* a2 = last ? nA : cA + (size_t)(t + 2) * kstep; const char* b2 = last ? nB : cB + (size_t)(t + 2) * kstep;
            const char* a3 = a2 + kstep; const char* b3 = b2 + kstep;
            if (last && has_next) S.a_ready(nxt);
            if constexpr (SP2) {
            PG8_LDB(B0, 0, 0); PG8_LDB(B1, 0, 1); PG8_SCHED; PG8_LDA(At, 0, 0); PG8_STAGE(PG8_SA(1, 1), a1 + hstep, voffA);
            PG8_WAIT_V(8); PG8_WAIT_L(0); PG8_BAR; PG8_MMA(0, 0, At, B0); PG8_MMA(0, 1, At, B1); PG8_BAR; PG8_SCHED;
            PG8_LDA(At, 0, 1); PG8_STAGE(PG8_SB(0, 0), b2, voffB); PG8_STAGE(PG8_SB(0, 1), b2 + hstep, voffB); PG8_STAGE(PG8_SA(0, 0), a2, voffA);
            PG8_WAIT_V(8); PG8_WAIT_L(0); PG8_BAR; PG8_MMA(1, 0, At, B0); PG8_MMA(1, 1, At, B1); PG8_BAR; PG8_SCHED;
            PG8_LDB(B0, 1, 0); PG8_LDB(B1, 1, 1); PG8_SCHED; PG8_LDA(At, 1, 0); PG8_STAGE(PG8_SA(0, 1), a2 + hstep, voffA);
            PG8_WAIT_V(8); PG8_WAIT_L(0); PG8_BAR; PG8_MMA(0, 0, At, B0); PG8_MMA(0, 1, At, B1); PG8_BAR; PG8_SCHED;
            PG8_LDA(At, 1, 1); PG8_STAGE(PG8_SB(1, 0), b3, voffB); PG8_STAGE(PG8_SB(1, 1), b3 + hstep, voffB); PG8_STAGE(PG8_SA(1, 0), a3, voffA);
            PG8_WAIT_V(8); PG8_WAIT_L(0); PG8_BAR; PG8_MMA(1, 0, At, B0); PG8_MMA(1, 1, At, B1); PG8_BAR; PG8_SCHED;
            } else {
            PG8_LDB(B0, 0, 0); PG8_SCHED; PG8_LDA(At, 0, 0); PG8_STAGE(PG8_SA(1, 1), a1 + hstep, voffA);
            PG8_WAIT_L(8); PG8_BAR; PG8_WAIT_L(0); PG8_MMA(0, 0, At, B0); PG8_BAR; PG8_SCHED;
            PG8_LDB(B1, 0, 1); PG8_STAGE(PG8_SB(0, 0), b2, voffB);
            PG8_BAR; PG8_WAIT_L(0); PG8_MMA(0, 1, At, B1); PG8_BAR;
            PG8_LDA(At, 0, 1); PG8_STAGE(PG8_SA(0, 0), a2, voffA);
            PG8_BAR; PG8_WAIT_L(0); PG8_MMA(1, 0, At, B0); PG8_BAR; PG8_SCHED;
            PG8_STAGE(PG8_SB(0, 1), b2 + hstep, voffB);
            PG8_WAIT_V(6); PG8_BAR; PG8_MMA(1, 1, At, B1); PG8_BAR;
            PG8_LDB(B0, 1, 0); PG8_SCHED; PG8_LDA(At, 1, 0); PG8_STAGE(PG8_SA(0, 1), a2 + hstep, voffA);
            PG8_WAIT_L(8); PG8_BAR; PG8_WAIT_L(0); PG8_MMA(0, 0, At, B0); PG8_BAR; PG8_SCHED;
            PG8_LDB(B1, 1, 1); PG8_STAGE(PG8_SB(1, 0), b3, voffB);
            PG8_BAR; PG8_WAIT_L(0); PG8_MMA(0, 1, At, B1); PG8_BAR;
            PG8_LDA(At, 1, 1); PG8_STAGE(PG8_SA(1, 0), a3, voffA);
            PG8_BAR; PG8_WAIT_L(0); PG8_MMA(1, 0, At, B0); PG8_BAR; PG8_SCHED;
            PG8_STAGE(PG8_SB(1, 1), b3 + hstep, voffB);
            PG8_WAIT_V(6); PG8_BAR; PG8_MMA(1, 1, At, B1); PG8_BAR;
            }
        }
        if constexpr (ALIGN_EPI) { if (wr == 0) PG8_BAR; }
        if constexpr (!Epi::AFTER_DRAIN) { E(acc, cur, wr, wc, fr, fq); S.done(cur); }
        if (!has_next) break;
#pragma unroll
        for (int a = 0; a < 2; ++a)
#pragma unroll
            for (int b = 0; b < 2; ++b)
#pragma unroll
                for (int m = 0; m < 4; ++m)
#pragma unroll
                    for (int n = 0; n < 2; ++n) acc[a][b][m][n] = (f32x4){0.f, 0.f, 0.f, 0.f};
        cur = nxt; cA = nA; cB = nB; ++ui;
        if constexpr (ALIGN_EPI) { if (wr == 1) PG8_BAR; }
    }
    PG8_WAIT_V(0);
    if constexpr (!ALIGN_EPI) { if (wr == 0) PG8_BAR; }
    PG8_BAR;
    if constexpr (Epi::AFTER_DRAIN) { E.fused(acc, cur, wr, wc, fr, fq, lds, wid, lane); S.done(cur); }
#undef PG8_SA
#undef PG8_SB
#undef PG8_STAGE
#undef PG8_LDA
#undef PG8_LDB
#undef PG8_MMA
#undef PG8_WAIT_V
#undef PG8_WAIT_L
#undef PG8_BAR
#undef PG8_SCHED
}
}
constexpr int NB = 16, SEQ = 4096, T = NB * SEQ, DM = 1024, DEPTH = 4;
constexpr int MLA_N = 1792;
constexpr int DSA_N = 3328;
constexpr float NORM_EPS = 1e-6f;
constexpr int NPHASE = 22;

constexpr size_t MiB = 1u << 20;
constexpr size_t WS_CTL = 0, CTL_ZERO_BYTES = 1 * MiB;
constexpr size_t WS_W = 2 * MiB;
constexpr size_t W_WINM = 0, W_WUQ = W_WINM + 2ull * MLA_N * 1024, W_WUK = W_WUQ + 2ull * 1536 * 256, W_WUV = W_WUK + 2ull * 1024 * 256,
                 W_WOM = W_WUV + 2ull * 1024 * 256, W_WIND = W_WOM + 2ull * 1024 * 1024, W_WOD = W_WIND + 2ull * DSA_N * 1024,
                 W_WP = W_WOD + 2ull * 1024 * 1024, W_WG = W_WP + 4ull * 1024 * 256, W_END = W_WG + 4ull * 1024 * 1024;
static_assert(WS_W + W_END * 2 <= 46 * MiB, "weights");
constexpr size_t WS_ROPE64 = 48 * MiB, WS_ROPE32 = 80 * MiB;
constexpr size_t WS_RSX = 96 * MiB, WS_RS1 = 100 * MiB, WS_RSQ = 104 * MiB, WS_RSKV = 105 * MiB;
constexpr size_t WS_PB = 112 * MiB;
constexpr size_t WS_XB0 = 144 * MiB;
constexpr size_t WS_SZ = 272 * MiB;
constexpr size_t WS_CQ = 400 * MiB, WS_CKV = 432 * MiB, WS_KPE = 464 * MiB;
constexpr size_t WS_QI = 400 * MiB, WS_KI = 464 * MiB, WS_WI = 472 * MiB;
constexpr size_t WS_Q = 480 * MiB;
constexpr size_t WS_PP = 480 * MiB;
constexpr size_t WS_KN = 672 * MiB, WS_V = 800 * MiB;
constexpr size_t WS_KD = 672 * MiB, WS_VD = 704 * MiB, WS_MASK = 736 * MiB;
constexpr size_t WS_XB1 = 672 * MiB;
constexpr size_t WS_END = 928 * MiB;
constexpr int CW_BAR = 4096;

constexpr int RING_BYTES = 131072;
constexpr int LDS_QIS = 131072;
constexpr int MISC_OFF = 159744;
constexpr int LDS_BYTES = 159744 + 512;
constexpr int NWAVES = 8;

#define GAS __attribute__((address_space(1)))
#define LAS __attribute__((address_space(3)))
typedef unsigned short bf16;
typedef unsigned v4u __attribute__((ext_vector_type(4)));
typedef float f32x4 __attribute__((ext_vector_type(4)));
typedef short bf16x8 __attribute__((ext_vector_type(8)));
typedef GAS unsigned gu32;
#define LDS_WAIT() asm volatile("s_waitcnt lgkmcnt(0)" ::: "memory")
#define VM_WAIT() asm volatile("s_waitcnt vmcnt(0)" ::: "memory")
__device__ __forceinline__ unsigned f2bf(float f) { unsigned u = __builtin_bit_cast(unsigned, f); return (u + 0x7fffu + ((u >> 16) & 1u)) >> 16; }
#define XB_TMO      128
#define XB_XCNT(j)  (256  + 64 * (j))
#define XB_XSUB(j)  (1280 + 64 * (j))
#define XB_XGEN(j)  (2304 + 64 * (j))
#define XB_TOP      3328
#define XB_TOPGEN   3392
#define XCD_BAR_WORDS 3456
#define XB_SPIN_CAP (1u << 25)

__device__ __forceinline__ unsigned xb_ld(unsigned* p)              { return __hip_atomic_load(p, __ATOMIC_RELAXED, __HIP_MEMORY_SCOPE_AGENT); }
__device__ __forceinline__ unsigned xb_add(unsigned* p, unsigned v) { return __hip_atomic_fetch_add(p, v, __ATOMIC_RELAXED, __HIP_MEMORY_SCOPE_AGENT); }
__device__ __forceinline__ unsigned xb_xcc_id() { return (unsigned)__builtin_amdgcn_s_getreg((3 << 11) | 20) & 0xFu; }
#define XB_SPIN(cond, bar) do { unsigned _sp = 0; while (cond) { __builtin_amdgcn_s_sleep(1); \
    if ((++_sp & 255u) == 0u) { if (xb_ld(&(bar)[XB_TMO])) break; if (_sp > XB_SPIN_CAP) { atomicAdd(&(bar)[XB_TMO], 1u); break; } } } } while (0)

struct XcdBarrier {
    unsigned* bar; unsigned x;
    volatile LAS unsigned* st;
};

__device__ __forceinline__ XcdBarrier xcd_barrier_post(unsigned* bar, volatile LAS unsigned* st) {
    XcdBarrier b; b.bar = bar; b.x = xb_xcc_id(); b.st = st;
    if (threadIdx.x == 0) (void)xb_add(&bar[XB_XCNT(b.x)], 1u);
    return b;
}
__device__ __forceinline__ void xcd_barrier_complete(unsigned* bar, unsigned x, unsigned& nloc, unsigned& nx) {
    const unsigned G = gridDim.x * gridDim.y * gridDim.z;
    unsigned sum, cnt, mine, sp = 0u;
    for (;;) {
        sum = 0u; cnt = 0u; mine = 0u;
#pragma unroll
        for (unsigned j = 0; j < 16; ++j) { const unsigned c = xb_ld(&bar[XB_XCNT(j)]); sum += c; cnt += (c > 0u) ? 1u : 0u; mine = (j == x) ? c : mine; }
        if (sum == G) break;
        __builtin_amdgcn_s_sleep(1);
        if ((++sp & 255u) == 0u) { if (xb_ld(&bar[XB_TMO])) break; if (sp > XB_SPIN_CAP) { atomicAdd(&bar[XB_TMO], 1u); break; } }
    }
    nloc = mine > 0u ? mine : 1u; nx = cnt > 0u ? cnt : 1u;
}

__device__ __forceinline__ void xcd_barrier(const XcdBarrier& b) {
    asm volatile("s_waitcnt vmcnt(0)" ::: "memory");
    __syncthreads();
    if (threadIdx.x == 0) {
        unsigned* bar = b.bar;
        __builtin_amdgcn_s_waitcnt(0);
        unsigned nloc = b.st[0], nx = b.st[1];
        if (nloc == 0u) { xcd_barrier_complete(bar, b.x, nloc, nx); b.st[0] = nloc; b.st[1] = nx; }
        const unsigned old = xb_add(&bar[XB_XSUB(b.x)], 1u);
        const unsigned gen = old / nloc;
        if (old + 1u == (gen + 1u) * nloc) {
            __builtin_amdgcn_fence(__ATOMIC_RELEASE, "agent");
            asm volatile("s_waitcnt vmcnt(0)" ::: "memory");
            const unsigned og = xb_add(&bar[XB_TOP], 1u);
            const unsigned tg = og / nx;
            if (og + 1u == (tg + 1u) * nx) xb_add(&bar[XB_TOPGEN], 1u);
            else XB_SPIN(xb_ld(&bar[XB_TOPGEN]) == tg, bar);
            __builtin_amdgcn_fence(__ATOMIC_ACQUIRE, "agent");
            xb_add(&bar[XB_XGEN(b.x)], 1u);
            asm volatile("s_waitcnt vmcnt(0)" ::: "memory");
        } else {
            XB_SPIN(xb_ld(&bar[XB_XGEN(b.x)]) == gen, bar);
            __builtin_amdgcn_fence(__ATOMIC_ACQUIRE, "agent");
            asm volatile("s_waitcnt vmcnt(0)" ::: "memory");
        }
    }
    __syncthreads();
}


typedef unsigned u32x2 __attribute__((ext_vector_type(2)));
__device__ __forceinline__ float bf2f(unsigned h) { return __builtin_bit_cast(float, h << 16); }
typedef __bf16 bf16x2_t __attribute__((ext_vector_type(2)));
typedef float f32x2_t __attribute__((ext_vector_type(2)));
__device__ __forceinline__ unsigned cvtpk(float lo, float hi) { const f32x2_t v = {lo, hi}; return __builtin_bit_cast(unsigned, __builtin_convertvector(v, bf16x2_t)); }
__device__ __forceinline__ v4u pack8(f32x4 a, f32x4 b) { v4u w; w.x = cvtpk(a[0], a[1]); w.y = cvtpk(a[2], a[3]); w.z = cvtpk(b[0], b[1]); w.w = cvtpk(b[2], b[3]); return w; }
__device__ __forceinline__ float wave_sum(float v) {
#pragma unroll
    for (int o = 1; o < 64; o <<= 1) v += __shfl_xor(v, o);
    return v;
}
__device__ __forceinline__ float wave_max(float v) {
#pragma unroll
    for (int o = 1; o < 64; o <<= 1) v = fmaxf(v, __shfl_xor(v, o));
    return v;
}
__device__ __forceinline__ int wave_sum_i(int v) {
#pragma unroll
    for (int o = 1; o < 64; o <<= 1) v += __shfl_xor(v, o);
    return v;
}
__device__ __forceinline__ float sum16_rstd(const float* rs, int row, float invn) {
    const f32x4* p = (const f32x4*)(rs + (size_t)row * 16); const f32x4 a = p[0], b = p[1], c = p[2], d = p[3];
    const float s = ((a[0] + a[1]) + (a[2] + a[3])) + ((b[0] + b[1]) + (b[2] + b[3])) + ((c[0] + c[1]) + (c[2] + c[3])) + ((d[0] + d[1]) + (d[2] + d[3]));
    return rsqrtf(s * invn + NORM_EPS);
}
__device__ __forceinline__ float sum4_rstd(const float* rs, int row, float invn) {
    const f32x4 a = *(const f32x4*)(rs + (size_t)row * 4); return rsqrtf(((a[0] + a[1]) + (a[2] + a[3])) * invn + NORM_EPS);
}
__device__ __forceinline__ float silu_f(float v) { return v * __builtin_amdgcn_rcpf(1.f + __expf(-v)); }
__device__ __forceinline__ float sigmoid_f(float v) { return __builtin_amdgcn_rcpf(1.f + __expf(-v)); }
__device__ __forceinline__ float sq4(f32x4 v) { return (v[0] * v[0] + v[1] * v[1]) + (v[2] * v[2] + v[3] * v[3]); }
__device__ __forceinline__ void rope8(f32x4& v0, f32x4& v1, const f32x4 c0, const f32x4 c1) {
    f32x4 o0, o1;
    o0[0] = v0[0] * c0[0] - v0[1] * c0[1]; o0[1] = v0[1] * c0[0] + v0[0] * c0[1];
    o0[2] = v0[2] * c0[2] - v0[3] * c0[3]; o0[3] = v0[3] * c0[2] + v0[2] * c0[3];
    o1[0] = v1[0] * c1[0] - v1[1] * c1[1]; o1[1] = v1[1] * c1[0] + v1[0] * c1[1];
    o1[2] = v1[2] * c1[2] - v1[3] * c1[3]; o1[3] = v1[3] * c1[2] + v1[2] * c1[3];
    v0 = o0; v1 = o1;
}
typedef _Float16 f16x2_t __attribute__((ext_vector_type(2)));
__device__ __forceinline__ unsigned pack_cs(float c, float sn) { const f16x2_t h = {(_Float16)c, (_Float16)sn}; return __builtin_bit_cast(unsigned, h); }
__device__ __forceinline__ f16x2_t as_h2(unsigned u) { return __builtin_bit_cast(f16x2_t, u); }
__device__ __forceinline__ void rope8h(f32x4& v0, f32x4& v1, const v4u w) {
    f32x4 c0, c1;
#pragma unroll
    for (int e = 0; e < 2; ++e) { const f16x2_t a = as_h2(w[e]), b = as_h2(w[2 + e]);
        c0[2 * e] = (float)a[0]; c0[2 * e + 1] = (float)a[1]; c1[2 * e] = (float)b[0]; c1[2 * e + 1] = (float)b[1]; }
    rope8(v0, v1, c0, c1);
}


namespace att {
constexpr int NW = 8, QBLK = 32, KVBLK = 64, QB = NW * QBLK, D = 128;
constexpr int KROW = D * 2 + 16, SHM_V = KVBLK * D * 2, SHM_K = KVBLK * KROW, KPROW = 144, SHM_KP = KVBLK * KPROW;
constexpr int OFF_V = 0, OFF_K = 2 * SHM_V, OFF_WS = OFF_K + 2 * SHM_K, OFF_KP = OFF_WS + NW * 64 * 4, OFF_QP = OFF_KP + 2 * SHM_KP, LDS_NEED = OFF_QP + NW * QBLK * 272;
constexpr float THR = 8.f;
typedef short s16x4 __attribute__((ext_vector_type(4)));
typedef float f32x16 __attribute__((ext_vector_type(16)));

#define KSWZ(row, colB) ((row) * KROW + (colB))
#define KPSWZ(row, ch) ((row) * KPROW + ((ch) << 4))
#define SBAR() __builtin_amdgcn_sched_barrier(0)
__device__ __forceinline__ int v_st(int k, int c) { const int kk = (k & ~0xC) | ((k & 4) << 1) | ((k & 8) >> 1); return ((kk >> 3) * 4 + (c >> 5)) * 512 + ((kk & 7) * 32 + (c & 31)) * 2; }
__device__ __forceinline__ int v_rd_base(int lane) { return ((lane & 3) << 3) | (((lane >> 2) & 3) << 6) | (((lane >> 4) & 1) << 5) | (((lane >> 5) & 1) << 8); }
constexpr int v_rd_off(int d0, int ks, int half) { return d0 * 512 + ks * 4096 + half * 2048; }
__device__ __forceinline__ int crow(int r, int hi) { return (r & 3) + 8 * (r >> 2) + 4 * hi; }
__device__ __forceinline__ bf16x8 load8(const bf16* p) { return *reinterpret_cast<const bf16x8*>(p); }
__device__ __forceinline__ unsigned long long gld_u64(const unsigned long long* ubase, unsigned voff) {
    const unsigned long long b_ = (unsigned long long)ubase;
    const unsigned lo_ = __builtin_amdgcn_readfirstlane((unsigned)b_), hi_ = __builtin_amdgcn_readfirstlane((unsigned)(b_ >> 32));
    __amdgpu_buffer_rsrc_t r_ = __builtin_amdgcn_make_buffer_rsrc((void*)(((unsigned long long)hi_ << 32) | lo_), (short)0, 0x7fffffff, 0x00020000);
    typedef unsigned u32x2_ __attribute__((ext_vector_type(2)));
    const u32x2_ w_ = __builtin_amdgcn_raw_buffer_load_b64(r_, (int)voff, 0, 0); return ((unsigned long long)w_.y << 32) | w_.x; }
__device__ __forceinline__ bf16x8 gld8(const bf16* ubase, unsigned voff) {
    const unsigned long long b_ = (unsigned long long)ubase;
    const unsigned lo_ = __builtin_amdgcn_readfirstlane((unsigned)b_), hi_ = __builtin_amdgcn_readfirstlane((unsigned)(b_ >> 32));
    __amdgpu_buffer_rsrc_t r_ = __builtin_amdgcn_make_buffer_rsrc((void*)(((unsigned long long)hi_ << 32) | lo_), (short)0, 0x7fffffff, 0x00020000);
    const v4u w_ = __builtin_amdgcn_raw_buffer_load_b128(r_, (int)voff, 0, 0); return __builtin_bit_cast(bf16x8, w_); }

__device__ __forceinline__ unsigned selbits(unsigned m, int c) { unsigned t; asm("v_bfe_i32 %0, %1, %2, 1" : "=v"(t) : "v"(m), "n"(c)); return t; }
__device__ __forceinline__ void mask_tile(f32x16& p0, f32x16& p1, int dq) {
    const float NEG = -__builtin_inff();
#pragma unroll
    for (int r = 0; r < 16; ++r) {
        const int c = (r & 3) + 8 * (r >> 2);
        if (dq - c < 0) p0[r] = NEG;
        if (dq - c - 32 < 0) p1[r] = NEG;
    }
}
template <bool MASKED>
__device__ __forceinline__ void partialSM(f32x16& p0, f32x16& p1, float& m_reg, float& mn, float& alpha, const float SCALE, unsigned mlo) {
    float pmax = p0[0]; for (int r = 1; r < 16; ++r) pmax = fmaxf(pmax, p0[r]); for (int r = 0; r < 16; ++r) pmax = fmaxf(pmax, p1[r]);
    { auto rr = __builtin_amdgcn_permlane32_swap(__float_as_uint(pmax), __float_as_uint(pmax), false, false);
      pmax = fmaxf(__uint_as_float(rr[0]), __uint_as_float(rr[1])); }
    const float C2 = 1.4426950408889634f * SCALE;
    if (__builtin_expect(__all((pmax - m_reg) * SCALE <= THR), 1)) { mn = m_reg; alpha = 1.f; }
    else { mn = fmaxf(m_reg, pmax); alpha = __builtin_amdgcn_exp2f((m_reg - mn) * C2); m_reg = mn; }
    const float mnL = -mn * C2;
    for (int r = 0; r < 16; ++r) p0[r] = fmaf(p0[r], C2, mnL); for (int r = 0; r < 16; ++r) p1[r] = fmaf(p1[r], C2, mnL);
    for (int r = 0; r < 16; ++r) p0[r] = __builtin_amdgcn_exp2f(p0[r]);
    if (MASKED) {
#pragma unroll
        for (int r = 0; r < 16; ++r) { const int c = (r & 3) + 8 * (r >> 2); p0[r] = __uint_as_float(__float_as_uint(p0[r]) & selbits(mlo, c)); }
    }
}
template <bool MASKED>
__device__ __forceinline__ void finishSM(f32x16& p0, f32x16& p1, float alpha, float& l_reg, bf16x8& pa0, bf16x8& pa1, bf16x8& pa2, bf16x8& pa3, unsigned mhi) {
    for (int r = 0; r < 16; ++r) p1[r] = __builtin_amdgcn_exp2f(p1[r]);
    if (MASKED) {
#pragma unroll
        for (int r = 0; r < 16; ++r) { const int c = (r & 3) + 8 * (r >> 2); p1[r] = __uint_as_float(__float_as_uint(p1[r]) & selbits(mhi, c)); }
    }
    float ps = 0; for (int r = 0; r < 16; ++r) ps += p0[r]; for (int r = 0; r < 16; ++r) ps += p1[r];
    { auto rr = __builtin_amdgcn_permlane32_swap(__float_as_uint(ps), __float_as_uint(ps), false, false);
      ps = __uint_as_float(rr[0]) + __uint_as_float(rr[1]); }
    l_reg = l_reg * alpha + ps;
#define PK4(P, B_, OUT) do { unsigned a0 = cvtpk(P[B_+0], P[B_+1]), a1 = cvtpk(P[B_+2], P[B_+3]);                          \
        unsigned b0 = cvtpk(P[B_+4], P[B_+5]), b1 = cvtpk(P[B_+6], P[B_+7]);                                             \
        auto r0 = __builtin_amdgcn_permlane32_swap(a0, b0, false, false); auto r1 = __builtin_amdgcn_permlane32_swap(a1, b1, false, false); \
        v4u w = {r0[0], r1[0], r0[1], r1[1]}; OUT = *reinterpret_cast<bf16x8*>(&w); } while (0)
    PK4(p0, 0, pa0); PK4(p0, 8, pa1); PK4(p1, 0, pa2); PK4(p1, 8, pa3);
#undef PK4
}
template <int KB, bool PE>
__device__ __forceinline__ void qkt(f32x16& p0, f32x16& p1, const char* lds, int r32, int hi, const bf16x8* qr, int kpb, int qpb) {
    p0 = f32x16{}; p1 = f32x16{};
    const char* kb[4];
#pragma unroll
    for (int dd = 0; dd < 4; ++dd) kb[dd] = lds + OFF_K + KB * SHM_K + KSWZ(r32, (dd * 16 + hi * 8) * 2);
    const char* qp_ = lds + qpb;
#pragma unroll
    for (int d0 = 0; d0 < 8; ++d0) { const char* a = kb[d0 & 3] + (d0 >> 2) * 128;
        bf16x8 b0 = *reinterpret_cast<const bf16x8*>(a);
        bf16x8 b1 = *reinterpret_cast<const bf16x8*>(a + 32 * KROW);
        bf16x8 qf; if (d0 >= 4) qf = *reinterpret_cast<const bf16x8*>(qp_ + (d0 - 4) * 32); else qf = qr[d0];
        p0 = __builtin_amdgcn_mfma_f32_32x32x16_bf16(b0, qf, p0, 0, 0, 0);
        p1 = __builtin_amdgcn_mfma_f32_32x32x16_bf16(b1, qf, p1, 0, 0, 0); }
    if (PE) {
        const char* kp_ = lds + kpb;
#pragma unroll
        for (int d0 = 0; d0 < 4; ++d0) {
            bf16x8 b0 = *reinterpret_cast<const bf16x8*>(kp_ + (KB * SHM_KP + d0 * 32));
            bf16x8 b1 = *reinterpret_cast<const bf16x8*>(kp_ + (KB * SHM_KP + d0 * 32 + 32 * KPROW));
            const bf16x8 qf = *reinterpret_cast<const bf16x8*>(qp_ + 128 + d0 * 32);
            p0 = __builtin_amdgcn_mfma_f32_32x32x16_bf16(b0, qf, p0, 0, 0, 0);
            p1 = __builtin_amdgcn_mfma_f32_32x32x16_bf16(b1, qf, p1, 0, 0, 0); }
    }
}
template <int VB>
__device__ __forceinline__ void pv_tile(f32x16* o, int vb0, bf16x8 pa0, bf16x8 pa1, bf16x8 pa2, bf16x8 pa3) {
#define TRRD(dst, off) asm volatile("ds_read_b64_tr_b16 %0, %1 offset:%2" : "=&v"(dst) : "v"(vb0), "i"(off) : "memory")
#define PV_D0(d0) do { s16x4 l0, l1, l2, l3, h0, h1, h2, h3; constexpr int b_ = OFF_V + VB * SHM_V + v_rd_off(d0, 0, 0); \
        TRRD(l0, b_); TRRD(h0, b_ + 2048); TRRD(l1, b_ + 4096); TRRD(h1, b_ + 6144); TRRD(l2, b_ + 8192); TRRD(h2, b_ + 10240); TRRD(l3, b_ + 12288); TRRD(h3, b_ + 14336); \
        asm volatile("s_waitcnt lgkmcnt(0)" ::: "memory"); SBAR();   \
        o[d0] = __builtin_amdgcn_mfma_f32_32x32x16_bf16(pa0, (bf16x8){l0[0], l0[1], l0[2], l0[3], h0[0], h0[1], h0[2], h0[3]}, o[d0], 0, 0, 0);   \
        o[d0] = __builtin_amdgcn_mfma_f32_32x32x16_bf16(pa1, (bf16x8){l1[0], l1[1], l1[2], l1[3], h1[0], h1[1], h1[2], h1[3]}, o[d0], 0, 0, 0);   \
        o[d0] = __builtin_amdgcn_mfma_f32_32x32x16_bf16(pa2, (bf16x8){l2[0], l2[1], l2[2], l2[3], h2[0], h2[1], h2[2], h2[3]}, o[d0], 0, 0, 0);   \
        o[d0] = __builtin_amdgcn_mfma_f32_32x32x16_bf16(pa3, (bf16x8){l3[0], l3[1], l3[2], l3[3], h3[0], h3[1], h3[2], h3[3]}, o[d0], 0, 0, 0); } while (0)
    PV_D0(0); PV_D0(1); PV_D0(2); PV_D0(3);
#undef PV_D0
#undef TRRD
}

template <int VB, bool MASKED>
__device__ __forceinline__ void pv_sm(f32x16* o, int vb0, bf16x8 pa0, bf16x8 pa1, bf16x8 pa2, bf16x8 pa3,
                                      f32x16& p0, f32x16& p1, float& m_reg, float& mn, float& alpha, const float SCALE, unsigned mlo) {
#define TRRD(dst, off) asm volatile("ds_read_b64_tr_b16 %0, %1 offset:%2" : "=&v"(dst) : "v"(vb0), "i"(off) : "memory")
#define PVS_LD(d0) s16x4 l0, l1, l2, l3, h0, h1, h2, h3; { constexpr int b_ = OFF_V + VB * SHM_V + v_rd_off(d0, 0, 0); \
        TRRD(l0, b_); TRRD(h0, b_ + 2048); TRRD(l1, b_ + 4096); TRRD(h1, b_ + 6144); TRRD(l2, b_ + 8192); TRRD(h2, b_ + 10240); TRRD(l3, b_ + 12288); TRRD(h3, b_ + 14336); \
        asm volatile("s_waitcnt lgkmcnt(0)" ::: "memory"); SBAR(); }
#define PVS_MM(d0) do { \
        o[d0] = __builtin_amdgcn_mfma_f32_32x32x16_bf16(pa0, (bf16x8){l0[0], l0[1], l0[2], l0[3], h0[0], h0[1], h0[2], h0[3]}, o[d0], 0, 0, 0);   \
        o[d0] = __builtin_amdgcn_mfma_f32_32x32x16_bf16(pa1, (bf16x8){l1[0], l1[1], l1[2], l1[3], h1[0], h1[1], h1[2], h1[3]}, o[d0], 0, 0, 0);   \
        o[d0] = __builtin_amdgcn_mfma_f32_32x32x16_bf16(pa2, (bf16x8){l2[0], l2[1], l2[2], l2[3], h2[0], h2[1], h2[2], h2[3]}, o[d0], 0, 0, 0);   \
        o[d0] = __builtin_amdgcn_mfma_f32_32x32x16_bf16(pa3, (bf16x8){l3[0], l3[1], l3[2], l3[3], h3[0], h3[1], h3[2], h3[3]}, o[d0], 0, 0, 0); } while (0)
#define PVS_SGB(nv) do { _Pragma("unroll") for (int g_ = 0; g_ < 4; ++g_) { __builtin_amdgcn_sched_group_barrier(0x008, 1, 0); __builtin_amdgcn_sched_group_barrier(0x402, nv, 0); } } while (0)
    const float C2 = 1.4426950408889634f * SCALE;
    float pmax, mnL;
    { PVS_LD(0); PVS_MM(0);
      float pm0 = p0[0], pm1 = p1[0];
#pragma unroll
      for (int r = 1; r < 16; ++r) { pm0 = fmaxf(pm0, p0[r]); pm1 = fmaxf(pm1, p1[r]); }
      pmax = fmaxf(pm0, pm1);
      { auto rr = __builtin_amdgcn_permlane32_swap(__float_as_uint(pmax), __float_as_uint(pmax), false, false);
        pmax = fmaxf(__uint_as_float(rr[0]), __uint_as_float(rr[1])); }
      PVS_SGB(5); }
    { PVS_LD(1); PVS_MM(1);
      const bool keep = __all((pmax - m_reg) * SCALE <= THR);
      mn = keep ? m_reg : fmaxf(m_reg, pmax); alpha = keep ? 1.f : __builtin_amdgcn_exp2f((m_reg - mn) * C2); m_reg = mn;
      mnL = -mn * C2;
#pragma unroll
      for (int r = 0; r < 16; ++r) p0[r] = fmaf(p0[r], C2, mnL);
      PVS_SGB(7); }
    { PVS_LD(2); PVS_MM(2);
#pragma unroll
      for (int r = 0; r < 16; ++r) p1[r] = fmaf(p1[r], C2, mnL);
#pragma unroll
      for (int r = 0; r < 6; ++r) p0[r] = __builtin_amdgcn_exp2f(p0[r]);
      PVS_SGB(6); }
    { PVS_LD(3); PVS_MM(3);
#pragma unroll
      for (int r = 6; r < 16; ++r) p0[r] = __builtin_amdgcn_exp2f(p0[r]);
      if (MASKED) {
#pragma unroll
          for (int r = 0; r < 16; ++r) { const int c = (r & 3) + 8 * (r >> 2); p0[r] = __uint_as_float(__float_as_uint(p0[r]) & selbits(mlo, c)); }
      }
      asm volatile("" : "+v"(p0), "+v"(p1));
      PVS_SGB(MASKED ? 8 : 3); }
#undef PVS_LD
#undef PVS_MM
#undef PVS_SGB
#undef TRRD
}

struct BlockRef { const bf16* Q; const bf16* K; const bf16* V; const bf16* KP; bf16* O; const unsigned long long* M; int P0; };
template <bool PE> struct Seam { bf16x8 qr[4]; bf16x8 qx[PE ? 8 : 4]; bf16x8 st_v0, st_v1, st_k0, st_k1, st_kp; };

#define VMW() asm volatile("s_waitcnt vmcnt(0)" ::: "memory")
#define VMWN(n) asm volatile("s_waitcnt vmcnt(%0)" :: "i"(n) : "memory")
#define SLOAD_H(Kp, Vp, KPp, k0) do { S.st_v0 = gld8((Vp) + (size_t)(k0) * LDV, voffkv); S.st_v1 = gld8((Vp) + (size_t)((k0) + 32) * LDV, voffkv);     \
                         S.st_k0 = gld8((Kp) + (size_t)(k0) * LDK, voffkv); S.st_k1 = gld8((Kp) + (size_t)((k0) + 32) * LDK, voffkv);                       \
                         if (PE) S.st_kp = gld8((KPp) + (size_t)(k0) * 64, voffkp); } while (0)
#define SWRITE_HK(bf) do { *(bf16x8*)(lds + OFF_K + (bf) * SHM_K + kws) = S.st_k0; *(bf16x8*)(lds + OFF_K + (bf) * SHM_K + kws + 32 * KROW) = S.st_k1;   \
                           if (PE) *(bf16x8*)(lds + kpws + (bf) * SHM_KP) = S.st_kp; } while (0)
#define SWRITE_HV(bf) do { *(bf16x8*)(lds + OFF_V + (bf) * SHM_V + vst0) = S.st_v0; *(bf16x8*)(lds + OFF_V + (bf) * SHM_V + vst1) = S.st_v1; } while (0)
#define SWRITE_H(bf) do { SWRITE_HV(bf); SWRITE_HK(bf); } while (0)
#define QLOAD(ref) do { _Pragma("unroll") for (int d0 = 0; d0 < 4; ++d0) S.qr[d0] = gld8((ref).Q + d0 * 16, voffq); } while (0)
#define QXLOAD(ref) do { _Pragma("unroll") for (int c_ = 0; c_ < QX / 16; ++c_) S.qx[c_] = gld8((ref).Q + (size_t)(c_ * (512 / QX)) * LDQ, voffqx); } while (0)
#define QXWRITE() do { _Pragma("unroll") for (int c_ = 0; c_ < QX / 16; ++c_) *(bf16x8*)(lds + qxw + c_ * (512 / QX) * QXROW) = S.qx[c_]; } while (0)

#define ATT_LANE_CONSTS \
    constexpr int QX = PE ? 128 : 64, QXROW = 2 * QX + 16, SHM_QP = QBLK * QXROW, CPR = QX / 8;                                                  \
    const int tid = threadIdx.x, wid = __builtin_amdgcn_readfirstlane(tid >> 6), lane = tid & 63, r32 = lane & 31, hi = lane >> 5;             \
    const int sr = tid >> 4, sc = (tid & 15) * 8, kws = KSWZ(sr, sc * 2), kpws = OFF_KP + KPSWZ(tid >> 3, tid & 7);                            \
    const unsigned voffkv = (unsigned)(sr * LDK + sc) * 2u, voffkp = (unsigned)((tid >> 3) * 64 + (tid & 7) * 8) * 2u;                          \
    const unsigned voffq = (unsigned)((wid * QBLK + r32) * LDQ + hi * 8) * 2u, voffqx = (unsigned)((wid * QBLK + lane / CPR) * LDQ + 64 + (lane % CPR) * 8) * 2u; \
    const int qxw = OFF_QP + wid * SHM_QP + (lane / CPR) * QXROW + (lane % CPR) * 16;
template <bool PE, bool MASKED, int LDQ, int LDK, int LDV>
__device__ __forceinline__ void attn_prime(const BlockRef& cur, char* lds, Seam<PE>& S) {
    static_assert(LDK == LDV, "k and v share the staging offset");
    ATT_LANE_CONSTS
    (void)kws; (void)kpws; (void)qxw; (void)r32; (void)hi;
    QLOAD(cur); QXLOAD(cur);
    SLOAD_H(cur.K, cur.V, cur.KP, 0); VMW(); SWRITE_HK(0);
    __syncthreads();
}
template <bool PE, bool MASKED, int LDQ, int LDK, int LDV, bool DRY>
__device__ __forceinline__ void attn_block(const BlockRef& cur, const BlockRef& nxt, char* lds, Seam<PE>& S, const float SCALE, const bool rdry, const float* psrc, bf16* pdst, const int kblk) {
    ATT_LANE_CONSTS
    const int NT = (cur.P0 + QB - 1) / KVBLK + 1;
    const int qlo = cur.P0 + wid * QBLK, qm = qlo + r32 - 4 * hi;
    float* ws = (float*)(lds + OFF_WS) + wid * 64; float* li_l = ws, * al_l = ws + 32;
    float m_reg = -1e30f, l_reg = 0; f32x16 o[4] = {};
    const int vst0 = v_st(sr, sc), vst1 = v_st(32 + sr, sc);
    const int vb0 = (int)(uintptr_t)lds + v_rd_base(lane);
    const int kpb = OFF_KP + r32 * KPROW + hi * 16, qpb = OFF_QP + wid * SHM_QP + r32 * QXROW + hi * 16 - (PE ? 0 : 0);
    const bf16* Kh = cur.K; const bf16* Vh = cur.V; const bf16* KPh = cur.KP;
    const unsigned voffm = (unsigned)(wid * QBLK + r32) * 512u;
#define RESC(a) do { if (__any((a) < 1.f)) { if (hi == 0) al_l[r32] = (a); asm volatile("s_waitcnt lgkmcnt(0)" ::: "memory");              \
                     for (int d_ = 0; d_ < 4; ++d_) for (int r = 0; r < 16; ++r) o[d_][r] *= al_l[crow(r, hi)]; } } while (0)
#define KBASE(t) ((t) * KVBLK)
#define MASKT(P0_, P1_, t) do { if (!MASKED) { const int kb_ = KBASE(t); if (kb_ + KVBLK - 1 > qlo) mask_tile(P0_, P1_, qm - kb_); } } while (0)
#define MLOAD(mw, t) do { if (MASKED) mw = gld_u64(cur.M + (t), voffm); } while (0)
#define MLO(mw) ((unsigned)(mw) >> (4 * hi))
#define MHI(mw) ((unsigned)((mw) >> 32) >> (4 * hi))
    constexpr int NQL = 4;
#define SEAM_K0() do { VMWN(NQL); SWRITE_HK(0); SBAR(); } while (0)
    f32x16 pA0, pA1, pB0, pB1; float mnA, mnB, alA, alB; bf16x8 pa0, pa1, pa2, pa3; unsigned long long mwA = 0, mwB = 0;
    QXWRITE(); SWRITE_HV(0); SBAR();
    if (NT > 1) SLOAD_H(Kh, Vh, KPh, KBASE(1));
    MLOAD(mwA, 0);
    SBAR(); qkt<0, PE>(pA0, pA1, lds, r32, hi, S.qr, kpb, qpb);
    MASKT(pA0, pA1, 0); partialSM<MASKED>(pA0, pA1, m_reg, mnA, alA, SCALE, MLO(mwA));
    if (NT > 1) { VMW(); SWRITE_H(1); }
    __syncthreads();
#define SGB_(mask, n) __builtin_amdgcn_sched_group_barrier(mask, n, 0)
#define SGB_STEP(nrd, nva) do { SGB_(0x100, nrd); SGB_(0x008, 1); SGB_(0x402, nva); SGB_(0x008, 1); SGB_(0x402, nva); } while (0)
#define SGB_QK_FIN() do { constexpr int NV_ = MASKED ? 6 : 3; SGB_(0x100, 2);                                              \
        SGB_STEP(2, NV_); SGB_STEP(2, NV_); SGB_STEP(2, NV_); SGB_STEP(3, NV_); SGB_STEP(3, NV_); SGB_STEP(3, NV_); SGB_STEP(3, NV_);                      \
        if (PE) { SGB_STEP(3, NV_); SGB_STEP(3, NV_); SGB_STEP(3, NV_); SGB_STEP(3, NV_); SGB_STEP(0, NV_); } else SGB_STEP(0, NV_); } while (0)
#define HALF_STEP(PX0, PX1, mnX, alX, mwX, PY0, PY1, alY, mwY, t, KB, VB, SB) do {                                            \
        SBAR(); MLOAD(mwX, t); qkt<KB, PE>(PX0, PX1, lds, r32, hi, S.qr, kpb, qpb);                                                \
        finishSM<MASKED>(PY0, PY1, alY, l_reg, pa0, pa1, pa2, pa3, MHI(mwY)); SGB_QK_FIN(); SBAR();                            \
        if ((t) + 1 < NT) { SLOAD_H(Kh, Vh, KPh, KBASE((t) + 1)); SBAR(); }                                                    \
        MASKT(PX0, PX1, (t)); SBAR(); pv_sm<VB, MASKED>(o, vb0, pa0, pa1, pa2, pa3, PX0, PX1, m_reg, mnX, alX, SCALE, MLO(mwX));                   \
        __syncthreads();                                                                                                      \
        if ((t) + 1 < NT) { VMW(); SWRITE_H(SB); }                                                                            \
        RESC(alX); __syncthreads(); } while (0)
    for (int t = 1; t + 1 < NT; t += 2) {
        HALF_STEP(pB0, pB1, mnB, alB, mwB, pA0, pA1, alA, mwA, t, 1, 0, 0);
        HALF_STEP(pA0, pA1, mnA, alA, mwA, pB0, pB1, alB, mwB, t + 1, 0, 1, 1);
    }
    const bool even = (NT & 1) == 0;
    (void)even;
    MLOAD(mwB, NT - 1);
    SBAR();
    const unsigned voffg = (unsigned)((wid * QBLK + (lane >> 4)) * 1024 + (lane & 15) * 8) * 2u;
    bf16x8 szq[8];
#pragma unroll
    for (int j = 0; j < 8; ++j) szq[j] = gld8(cur.O + (size_t)(4 * j) * 1024, voffg);
    constexpr size_t PNCH = (size_t)NB * 4096 * 256 / 8;
    f32x4 pcv[2][2]; size_t pcc[2];
    { const size_t gth_ = (size_t)gridDim.x * (NW * 64), gid_ = (size_t)blockIdx.x * (NW * 64) + tid;
#pragma unroll
      for (int u = 0; u < 2; ++u) { const size_t c_ = (size_t)(kblk * 2 + u) * gth_ + gid_; pcc[u] = c_; const size_t cl_ = c_ < PNCH ? c_ : PNCH - 1;
          pcv[u][0] = *(const f32x4*)(psrc + cl_ * 8); pcv[u][1] = *(const f32x4*)(psrc + cl_ * 8 + 4); } }
    SBAR(); qkt<1, PE>(pB0, pB1, lds, r32, hi, S.qr, kpb, qpb);
    finishSM<MASKED>(pA0, pA1, alA, l_reg, pa0, pa1, pa2, pa3, MHI(mwA)); SGB_QK_FIN(); SBAR();
    MASKT(pB0, pB1, NT - 1); SBAR(); pv_sm<0, MASKED>(o, vb0, pa0, pa1, pa2, pa3, pB0, pB1, m_reg, mnB, alB, SCALE, MLO(mwB));
    SBAR(); SLOAD_H(nxt.K, nxt.V, nxt.KP, 0); SBAR();
    QLOAD(nxt);
    SBAR();
    __syncthreads(); RESC(alB);
    finishSM<MASKED>(pB0, pB1, alB, l_reg, pa0, pa1, pa2, pa3, MHI(mwB)); SBAR();
    pv_tile<1>(o, vb0, pa0, pa1, pa2, pa3);
    SBAR(); SEAM_K0(); QXLOAD(nxt); SBAR();
    if (hi == 0) li_l[r32] = l_reg; asm volatile("s_waitcnt lgkmcnt(0)" ::: "memory");
    float rli[16];
#pragma unroll
    for (int r = 0; r < 16; ++r) rli[r] = __builtin_amdgcn_rcpf(li_l[crow(r, hi)]);
    char* stg = lds + OFF_QP + wid * (QBLK * 272) + (4 * hi) * 272 + r32 * 2;
#pragma unroll
    for (int d0 = 0; d0 < 4; ++d0)
#pragma unroll
        for (int r = 0; r < 16; r += 2) { const unsigned w = cvtpk(o[d0][r] * rli[r], o[d0][r + 1] * rli[r + 1]);
            *(unsigned short*)(stg + ((r & 3) + 8 * (r >> 2)) * 272 + d0 * 64) = (unsigned short)w;
            *(unsigned short*)(stg + (((r + 1) & 3) + 8 * ((r + 1) >> 2)) * 272 + d0 * 64) = (unsigned short)(w >> 16); }
    asm volatile("s_waitcnt lgkmcnt(0)" ::: "memory");
    const char* strd = lds + OFF_QP + wid * (QBLK * 272) + (lane >> 4) * 272 + (lane & 15) * 16;
#pragma unroll
    for (int j = 0; j < 8; ++j) { const v4u ow = *(const v4u*)(strd + (4 * j) * 272); const v4u zw = __builtin_bit_cast(v4u, szq[j]); v4u gw;
#pragma unroll
        for (int e = 0; e < 4; ++e) gw[e] = cvtpk(__uint_as_float(ow[e] << 16) * __uint_as_float(zw[e] << 16), __uint_as_float(ow[e] & 0xffff0000u) * __uint_as_float(zw[e] & 0xffff0000u));
        v4u* gp = (v4u*)((char*)(cur.O + (size_t)(4 * j) * 1024) + voffg);
        if (!DRY && !rdry) *gp = gw; else asm volatile("" :: "v"(gw)); }
#pragma unroll
    for (int u = 0; u < 2; ++u) { const v4u pw = pack8(pcv[u][0], pcv[u][1]); if (pcc[u] < PNCH) *(v4u*)(pdst + pcc[u] * 8) = pw; }
    __syncthreads();
#undef RESC
#undef KBASE
#undef MASKT
#undef MLOAD
#undef MLO
#undef MHI
#undef SEAM_K0
#undef HALF_STEP
}
#undef VMW
#undef VMWN
#undef SLOAD_H
#undef SWRITE_HK
#undef SWRITE_HV
#undef SWRITE_H
#undef QLOAD
#undef QXLOAD
#undef QXWRITE

struct Item { int bh, qb0, qb1; };
__device__ __forceinline__ Item decode(int L, int nhkv) {
    const int Gq = 8 / nhkv, xcd = L & 7, k = L >> 3, per = Gq * 8, gi = k / per, r = k - gi * per;
    Item it; it.bh = (gi * 8 + xcd) * Gq + r / 8; const int x = r % 8; it.qb0 = x; it.qb1 = 15 - x; return it;
}
template <bool PE, bool MASKED, int LDQ, int QH, int LDK, int LDV, int NHKV>
__device__ __forceinline__ BlockRef make_ref(const Item& it, int pass, const bf16* Q, const bf16* K, const bf16* V, const bf16* KP, bf16* O, const unsigned long long* M) {
    const int qb = pass ? it.qb1 : it.qb0, b = it.bh >> 3, h = it.bh & 7, hk = h / (8 / NHKV); const size_t tok0 = (size_t)b * SEQ + (size_t)qb * QB;
    BlockRef r; r.Q = Q + tok0 * LDQ + h * QH; r.K = K + (size_t)b * SEQ * LDK + hk * 128; r.V = V + (size_t)b * SEQ * LDV + hk * 128; r.KP = PE ? KP + (size_t)b * SEQ * 64 : nullptr;
    r.O = O + tok0 * 1024 + h * 128; r.M = MASKED ? M + tok0 * 64 : nullptr; r.P0 = qb * QB; return r;
}
template <bool PE, bool MASKED, int LDQ, int QH, int LDK, int LDV, int NHKV, bool DRY = false>
__device__ __forceinline__ void attn_phase(char* lds, const bf16* Q, const bf16* K, const bf16* V, const bf16* KP, bf16* O, const unsigned long long* M, const float SCALE, const float* psrc, bf16* pdst, const bool rdry = false) {
    const int total = 8 * NB * 8, stride = gridDim.x;
    int L = blockIdx.x; if (L >= total) return;
    if (__builtin_amdgcn_readfirstlane((int)threadIdx.x) >= 256) __builtin_amdgcn_s_setprio(1);
    Item it = decode(L, NHKV); int pass = 0, kblk = 0;
    BlockRef cur = make_ref<PE, MASKED, LDQ, QH, LDK, LDV, NHKV>(it, 0, Q, K, V, KP, O, M);
    Seam<PE> S;
    attn_prime<PE, MASKED, LDQ, LDK, LDV>(cur, lds, S);
    for (;;) {
        const bool more_pass = pass == 0, more_item = L + stride < total, last = !more_pass && !more_item;
        Item itn = it; int passn = pass + 1, Ln = L;
        if (!more_pass) { passn = 0; Ln = more_item ? L + stride : L; itn = decode(Ln, NHKV); }
        const BlockRef nxt = last ? cur : make_ref<PE, MASKED, LDQ, QH, LDK, LDV, NHKV>(itn, passn, Q, K, V, KP, O, M);
        attn_block<PE, MASKED, LDQ, LDK, LDV, DRY>(cur, nxt, lds, S, SCALE, rdry, psrc, pdst, kblk); ++kblk;
        if (last) break;
        cur = nxt; it = itn; pass = passn; L = Ln;
    }
    __builtin_amdgcn_s_setprio(0);
    { constexpr size_t PNCH = (size_t)NB * 4096 * 256 / 8; const size_t gth_ = (size_t)gridDim.x * (NW * 64);
      for (size_t c_ = (size_t)kblk * 2 * gth_ + (size_t)blockIdx.x * (NW * 64) + threadIdx.x; c_ < PNCH; c_ += gth_) {
          const f32x4 a_ = *(const f32x4*)(psrc + c_ * 8), b_ = *(const f32x4*)(psrc + c_ * 8 + 4); *(v4u*)(pdst + c_ * 8) = pack8(a_, b_); } }
}
#undef KSWZ
#undef KPSWZ
#undef SBAR
}
#define EPI_ROWS _Pragma("unroll") for (int ai = 0; ai < 2; ++ai) _Pragma("unroll") for (int m = 0; m < 4; ++m)
#define EPI_ROW (u.pm * 256 + ai * 128 + wr * 64 + m * 16 + fr)
#define EPI_FENCE() __builtin_amdgcn_sched_barrier(0)
typedef const f32x4 (&AccRef)[2][2][4][2];
template <int NP>
__device__ __forceinline__ void wave_rstd(const float* rs, int pm, int wr, int fr, int fq, float invn, float (&out)[2][4]) {
    const int l = fq * 16 + fr; float r2[2];
#pragma unroll
    for (int ai = 0; ai < 2; ++ai) { const int row = pm * 256 + ai * 128 + wr * 64 + l; float s;
        if (NP == 16) { const f32x4* p = (const f32x4*)(rs + (size_t)row * 16); const f32x4 a = p[0], b = p[1], c = p[2], d = p[3];
            s = ((a[0] + a[1]) + (a[2] + a[3])) + ((b[0] + b[1]) + (b[2] + b[3])) + ((c[0] + c[1]) + (c[2] + c[3])) + ((d[0] + d[1]) + (d[2] + d[3])); }
        else { const f32x4 a = *(const f32x4*)(rs + (size_t)row * 4); s = (a[0] + a[1]) + (a[2] + a[3]); }
        r2[ai] = rsqrtf(s * invn + NORM_EPS); }
#pragma unroll
    for (int ai = 0; ai < 2; ++ai)
#pragma unroll
        for (int m = 0; m < 4; ++m) out[ai][m] = __shfl(r2[ai], m * 16 + fr);
}

struct EpiMlaIn {
    static constexpr bool PERM = true, AFTER_DRAIN = false;
    const float* rsx; bf16* cq; bf16* ckv; bf16* sz; bf16* kpe; float* rsq; float* rskv; const unsigned* rope32;
    __device__ __forceinline__ void operator()(AccRef acc, const pg8::Unit& u, int wr, int wc, int fr, int fq) const {
        const int pn = u.pn; float rst[2][4]; wave_rstd<16>(rsx, u.pm, wr, fr, fq, 1.f / 1024.f, rst);
        if (pn < 2) { bf16* dst = pn == 0 ? cq : ckv; float* rs = pn == 0 ? rsq : rskv;
            EPI_ROWS { const int row = EPI_ROW; const float rstd = rst[ai][m]; float ss = 0.f;
#pragma unroll
                for (int bj = 0; bj < 2; ++bj) { const f32x4 v0 = acc[ai][bj][m][0] * rstd, v1 = acc[ai][bj][m][1] * rstd; ss += sq4(v0) + sq4(v1);
                    *(v4u*)(dst + (size_t)row * 256 + bj * 128 + wc * 32 + fq * 8) = pack8(v0, v1); }
                ss += __shfl_xor(ss, 16); ss += __shfl_xor(ss, 32);
                if (fq == 0) rs[(size_t)row * 4 + wc] = ss; }
        } else if (pn < 6) {
            EPI_ROWS { const int row = EPI_ROW; const float rstd = rst[ai][m];
#pragma unroll
                for (int bj = 0; bj < 2; ++bj) { f32x4 v0 = acc[ai][bj][m][0] * rstd, v1 = acc[ai][bj][m][1] * rstd;
#pragma unroll
                    for (int e = 0; e < 4; ++e) { v0[e] = silu_f(v0[e]); v1[e] = silu_f(v1[e]); }
                    *(v4u*)(sz + (size_t)row * 1024 + (pn - 2) * 256 + bj * 128 + wc * 32 + fq * 8) = pack8(v0, v1); } }
        } else if (wc < 2) {
            const int c = wc * 32 + fq * 8;
#pragma unroll
            for (int ai = 0; ai < 2; ++ai)
            { v4u cs[4];
#pragma unroll
                for (int m = 0; m < 4; ++m) cs[m] = *(const v4u*)(rope32 + (size_t)EPI_ROW * 32 + (c >> 1));
                EPI_FENCE();
#pragma unroll
                for (int m = 0; m < 4; ++m) { const int row = EPI_ROW; const float rstd = rst[ai][m]; f32x4 v0 = acc[ai][0][m][0] * rstd, v1 = acc[ai][0][m][1] * rstd;
                    rope8h(v0, v1, cs[m]);
                    *(v4u*)(kpe + (size_t)row * 64 + c) = pack8(v0, v1); } }
        }
    }
};
struct EpiMlaQ {
    static constexpr bool PERM = true, AFTER_DRAIN = false;
    const float* rsq; bf16* q; const unsigned* rope32;
    __device__ __forceinline__ void operator()(AccRef acc, const pg8::Unit& u, int wr, int wc, int fr, int fq) const {
        int col[2], cin[2];
#pragma unroll
        for (int bj = 0; bj < 2; ++bj) { col[bj] = u.pn * 256 + bj * 128 + wc * 32 + fq * 8; const int h = col[bj] / 192; cin[bj] = col[bj] - h * 192; }
        v4u cs0[4][2];
        { const int ai = 0;
#pragma unroll
            for (int m = 0; m < 4; ++m) {
#pragma unroll
                for (int bj = 0; bj < 2; ++bj) if (cin[bj] >= 128) cs0[m][bj] = *(const v4u*)(rope32 + (size_t)EPI_ROW * 32 + ((cin[bj] - 128) >> 1)); } }
        float rst[2][4]; wave_rstd<4>(rsq, u.pm, wr, fr, fq, 1.f / 256.f, rst);
#pragma unroll
        for (int ai = 0; ai < 2; ++ai)
        { v4u cs[4][2];
#pragma unroll
            for (int m = 0; m < 4; ++m) {
#pragma unroll
                for (int bj = 0; bj < 2; ++bj) { if (ai == 0) cs[m][bj] = cs0[m][bj]; else if (cin[bj] >= 128) cs[m][bj] = *(const v4u*)(rope32 + (size_t)EPI_ROW * 32 + ((cin[bj] - 128) >> 1)); } }
            EPI_FENCE();
#pragma unroll
            for (int m = 0; m < 4; ++m) { const int row = EPI_ROW; const float rstd = rst[ai][m];
#pragma unroll
                for (int bj = 0; bj < 2; ++bj) { f32x4 v0 = acc[ai][bj][m][0] * rstd, v1 = acc[ai][bj][m][1] * rstd;
                    if (cin[bj] >= 128) rope8h(v0, v1, cs[m][bj]);
                    *(v4u*)(q + (size_t)row * 1536 + col[bj]) = pack8(v0, v1); } } }
    }
};
struct EpiMlaKV {
    static constexpr bool PERM = true, AFTER_DRAIN = false;
    const float* rskv; bf16* dst;
    __device__ __forceinline__ void operator()(AccRef acc, const pg8::Unit& u, int wr, int wc, int fr, int fq) const {
        float rst[2][4]; wave_rstd<4>(rskv, u.pm, wr, fr, fq, 1.f / 256.f, rst);
        EPI_ROWS { const int row = EPI_ROW; const float rstd = rst[ai][m];
#pragma unroll
            for (int bj = 0; bj < 2; ++bj) { const int col = u.pn * 256 + bj * 128 + wc * 32 + fq * 8;
                *(v4u*)(dst + (size_t)row * 1024 + col) = pack8(acc[ai][bj][m][0] * rstd, acc[ai][bj][m][1] * rstd); }
        }
    }
};
struct EpiPlain {
    static constexpr bool PERM = true, AFTER_DRAIN = false;
    bf16* dst;
    __device__ __forceinline__ void operator()(AccRef acc, const pg8::Unit& u, int wr, int wc, int fr, int fq) const {
        EPI_ROWS { const int row = EPI_ROW;
#pragma unroll
            for (int bj = 0; bj < 2; ++bj) { const int col = u.pn * 256 + bj * 128 + wc * 32 + fq * 8;
                *(v4u*)(dst + (size_t)row * 1024 + col) = pack8(acc[ai][bj][m][0], acc[ai][bj][m][1]); }
        }
    }
};
#define SS8(ow) ({ const float r0 = bf2f((ow).x & 0xffffu), r1 = bf2f((ow).x >> 16), r2 = bf2f((ow).y & 0xffffu), r3 = bf2f((ow).y >> 16), r4 = bf2f((ow).z & 0xffffu), r5 = bf2f((ow).z >> 16), r6 = bf2f((ow).w & 0xffffu), r7 = bf2f((ow).w >> 16); \
                   ((r0 * r0 + r1 * r1) + (r2 * r2 + r3 * r3)) + ((r4 * r4 + r5 * r5) + (r6 * r6 + r7 * r7)); })
struct EpiOut {
    static constexpr bool PERM = true, AFTER_DRAIN = false;
    const bf16* xin; bf16* xb; float* rs1; bool dry;
    __device__ __forceinline__ void operator()(AccRef acc, const pg8::Unit& u, int wr, int wc, int fr, int fq) const {
        const size_t c0 = (size_t)u.pn * 256 + wc * 32 + fq * 8;
        v4u xw[2][4][2];
#pragma unroll
        for (int ai = 0; ai < 2; ++ai)
#pragma unroll
        for (int m = 0; m < 4; ++m) {
#pragma unroll
            for (int bj = 0; bj < 2; ++bj) xw[ai][m][bj] = *(const v4u*)(xin + (size_t)EPI_ROW * 1024 + c0 + bj * 128); }
        EPI_FENCE();
#pragma unroll
        for (int ai = 0; ai < 2; ++ai) {
#pragma unroll
        for (int m = 0; m < 4; ++m) { const int row = EPI_ROW; float ss = 0.f;
#pragma unroll
            for (int bj = 0; bj < 2; ++bj) { const v4u w = xw[ai][m][bj]; f32x4 a0 = acc[ai][bj][m][0], a1 = acc[ai][bj][m][1];
                a0[0] += bf2f(w.x & 0xffffu); a0[1] += bf2f(w.x >> 16); a0[2] += bf2f(w.y & 0xffffu); a0[3] += bf2f(w.y >> 16);
                a1[0] += bf2f(w.z & 0xffffu); a1[1] += bf2f(w.z >> 16); a1[2] += bf2f(w.w & 0xffffu); a1[3] += bf2f(w.w >> 16);
                const v4u ow = pack8(a0, a1); if (!dry) *(v4u*)(xb + (size_t)row * 1024 + c0 + bj * 128) = ow; ss += SS8(ow); }
            ss += __shfl_xor(ss, 16); ss += __shfl_xor(ss, 32);
            if (fq == 0 && !dry) rs1[(size_t)row * 16 + u.pn * 4 + wc] = ss; else asm volatile("" :: "v"(ss));
        } }
    }
};
struct EpiGate {
    static constexpr bool PERM = true, AFTER_DRAIN = false;
    const float* rs1; const bf16* x1; const bf16* pp; bf16* xb; float* rsx; bool dry;
    __device__ __forceinline__ void operator()(AccRef acc, const pg8::Unit& u, int wr, int wc, int fr, int fq) const {
        float rst[2][4]; wave_rstd<16>(rs1, u.pm, wr, fr, fq, 1.f / 1024.f, rst);
        const size_t c0 = (size_t)u.pn * 256 + wc * 32 + fq * 8;
#pragma unroll
        for (int ai = 0; ai < 2; ++ai) { v4u xw[4][2], pw[4][2];
#pragma unroll
            for (int m = 0; m < 4; ++m)
#pragma unroll
                for (int bj = 0; bj < 2; ++bj) { xw[m][bj] = *(const v4u*)(x1 + (size_t)EPI_ROW * 1024 + c0 + bj * 128); pw[m][bj] = *(const v4u*)(pp + (size_t)EPI_ROW * 1024 + c0 + bj * 128); }
            EPI_FENCE();
#pragma unroll
            for (int m = 0; m < 4; ++m) { const int row = EPI_ROW; const float rstd = rst[ai][m]; float ss = 0.f;
#pragma unroll
                for (int bj = 0; bj < 2; ++bj) { const v4u xv = xw[m][bj], pv = pw[m][bj];
                    const f32x4 g0 = acc[ai][bj][m][0] * rstd, g1 = acc[ai][bj][m][1] * rstd; f32x4 a0, a1;
                    a0[0] = bf2f(xv.x & 0xffffu) + bf2f(pv.x & 0xffffu) * sigmoid_f(g0[0]); a0[1] = bf2f(xv.x >> 16) + bf2f(pv.x >> 16) * sigmoid_f(g0[1]);
                    a0[2] = bf2f(xv.y & 0xffffu) + bf2f(pv.y & 0xffffu) * sigmoid_f(g0[2]); a0[3] = bf2f(xv.y >> 16) + bf2f(pv.y >> 16) * sigmoid_f(g0[3]);
                    a1[0] = bf2f(xv.z & 0xffffu) + bf2f(pv.z & 0xffffu) * sigmoid_f(g1[0]); a1[1] = bf2f(xv.z >> 16) + bf2f(pv.z >> 16) * sigmoid_f(g1[1]);
                    a1[2] = bf2f(xv.w & 0xffffu) + bf2f(pv.w & 0xffffu) * sigmoid_f(g1[2]); a1[3] = bf2f(xv.w >> 16) + bf2f(pv.w >> 16) * sigmoid_f(g1[3]);
                    const v4u ow = pack8(a0, a1); if (!dry) *(v4u*)(xb + (size_t)row * 1024 + c0 + bj * 128) = ow; ss += SS8(ow); }
                ss += __shfl_xor(ss, 16); ss += __shfl_xor(ss, 32);
                if (fq == 0 && !dry) rsx[(size_t)row * 16 + u.pn * 4 + wc] = ss; else asm volatile("" :: "v"(ss)); } }
    }
};
struct EpiDsaIn {
    static constexpr bool PERM = true, AFTER_DRAIN = false;
    const float* rsx; bf16* q; bf16* k; bf16* v; bf16* qi; bf16* sz; bf16* ki; float* wi; const unsigned* rope64; const unsigned* rope32;
    __device__ __forceinline__ void operator()(AccRef acc, const pg8::Unit& u, int wr, int wc, int fr, int fq) const {
        const int pn = u.pn;
        const int cb = wc * 32 + fq * 8;
        const bool rope_tile = pn < 5 || pn == 6 || pn == 7 || pn == 12;
        const unsigned* tab = (pn < 5) ? rope64 : rope32; const int tw = (pn < 5) ? 64 : 32, cm = (pn < 5) ? 127 : 63;
        v4u cs0[4][2];
        if (rope_tile) { const int ai = 0;
#pragma unroll
            for (int m = 0; m < 4; ++m) {
#pragma unroll
                for (int bj = 0; bj < 2; ++bj) { const int c = bj * 128 + cb; if (pn != 12 || c < 64) cs0[m][bj] = *(const v4u*)(tab + (size_t)EPI_ROW * tw + ((c & cm) >> 1)); } } }
        float rst[2][4]; wave_rstd<16>(rsx, u.pm, wr, fr, fq, 1.f / 1024.f, rst);
#pragma unroll
        for (int ai = 0; ai < 2; ++ai)
        { v4u cs[4][2];
            if (ai == 0) {
#pragma unroll
                for (int m = 0; m < 4; ++m) { cs[m][0] = cs0[m][0]; cs[m][1] = cs0[m][1]; }
            } else if (rope_tile) {
#pragma unroll
                for (int m = 0; m < 4; ++m) {
#pragma unroll
                    for (int bj = 0; bj < 2; ++bj) { const int c = bj * 128 + cb; if (pn != 12 || c < 64) cs[m][bj] = *(const v4u*)(tab + (size_t)EPI_ROW * tw + ((c & cm) >> 1)); } }
            }
            EPI_FENCE();
#pragma unroll
            for (int m = 0; m < 4; ++m) { const int row = EPI_ROW; const float rstd = rst[ai][m];
#pragma unroll
                for (int bj = 0; bj < 2; ++bj) { const int c = bj * 128 + cb;
                    f32x4 v0 = acc[ai][bj][m][0] * rstd, v1 = acc[ai][bj][m][1] * rstd;
                    if (pn < 4) { rope8h(v0, v1, cs[m][bj]); *(v4u*)(q + (size_t)row * 1024 + pn * 256 + c) = pack8(v0, v1); }
                    else if (pn == 4) { rope8h(v0, v1, cs[m][bj]); *(v4u*)(k + (size_t)row * 256 + c) = pack8(v0, v1); }
                    else if (pn == 5) { *(v4u*)(v + (size_t)row * 256 + c) = pack8(v0, v1); }
                    else if (pn < 8) { rope8h(v0, v1, cs[m][bj]); *(v4u*)(qi + (size_t)row * 512 + (pn - 6) * 256 + c) = pack8(v0, v1); }
                    else if (pn < 12) {
#pragma unroll
                        for (int e = 0; e < 4; ++e) { v0[e] = silu_f(v0[e]); v1[e] = silu_f(v1[e]); }
                        *(v4u*)(sz + (size_t)row * 1024 + (pn - 8) * 256 + c) = pack8(v0, v1); }
                    else if (c < 64) { rope8h(v0, v1, cs[m][bj]); *(v4u*)(ki + (size_t)row * 64 + c) = pack8(v0, v1); }
                    else if (c == 64) { *(f32x4*)(wi + (size_t)row * 8) = v0; *(f32x4*)(wi + (size_t)row * 8 + 4) = v1; }
                } } }
    }
};

__device__ __forceinline__ int src_col(int map, int n) {
    switch (map) {
    case 1:
        if (n < 512) return n; if (n < 1536) return n + 64; if (n < 1600) { const int c = n - 1536; return 512 + (c >> 1) + 32 * (c & 1); } return -1;
    case 2: {
        const int h = n / 192, c = n - h * 192; if (c < 128) return n; const int c2 = c - 128; return h * 192 + 128 + (c2 >> 1) + 32 * (c2 & 1); }
    case 3:
        if (n < 1280) { const int h = n >> 7, c = n & 127; return h * 128 + (c >> 1) + 64 * (c & 1); }
        if (n < 1536) return n;
        if (n < 2048) { const int c = n - 1536, h = c >> 6, cc = c & 63; return 1536 + h * 64 + (cc >> 1) + 32 * (cc & 1); }
        if (n < 3072) return 2120 + (n - 2048);
        if (n < 3136) { const int c = n - 3072; return 2048 + (c >> 1) + 32 * (c & 1); }
        if (n < 3144) return 2112 + (n - 3136);
        return -1;
    default: return n;
    }
}
__device__ __forceinline__ void tr_item(const float* W, int K, int N, bf16* WT, int Nout, const float* gain, int map, LAS float* scr, int item, int lane) {
    const int nblk = Nout / 32, kb = item / nblk, nb = item % nblk, k0 = 64 * kb, n0 = 32 * nb;
    const int src = src_col(map, n0 + (lane & 31));
    const int srcc = src >= 0 ? src : 0; float wv_[32], gv_[32];
#pragma unroll
    for (int i = 0; i < 32; ++i) { const int kk = 2 * i + (lane >> 5); wv_[i] = W[(size_t)(k0 + kk) * N + srcc]; gv_[i] = gain ? gain[k0 + kk] : 1.f; }
#pragma unroll
    for (int i = 0; i < 32; ++i) { const int kk = 2 * i + (lane >> 5); scr[kk * 33 + (lane & 31)] = src >= 0 ? wv_[i] * gv_[i] : 0.f; }
    LDS_WAIT(); asm volatile("" ::: "memory");
    const int c = lane & 7;
#pragma unroll
    for (int j = 0; j < 4; ++j) { const int n = (lane >> 3) + 8 * j; const LAS float* s = scr + (8 * c) * 33 + n;
        v4u o; o.x = cvtpk(s[0 * 33], s[1 * 33]); o.y = cvtpk(s[2 * 33], s[3 * 33]); o.z = cvtpk(s[4 * 33], s[5 * 33]); o.w = cvtpk(s[6 * 33], s[7 * 33]);
        *(v4u*)(WT + (size_t)(n0 + n) * K + k0 + 8 * c) = o; }
    LDS_WAIT(); asm volatile("" ::: "memory");
}

struct Args { const float* in[17]; float* out; unsigned char* ws; int ph_lo, ph_hi, pmode, pad; };

__device__ __forceinline__ void prologue(const Args& a, LAS unsigned char* lds, int gw, int ngw, int wave, int lane) {
    bf16* Wb = (bf16*)(a.ws + WS_W);
    LAS float* scr = (LAS float*)(lds + wave * 16384);
    for (int mi = 0; mi < 22; ++mi) {
        const float* W; int K, N, Nout, map = 0; const float* gain = nullptr; bf16* WT;
        if (mi < 2)       { const int j = mi;      W = a.in[4] + (size_t)j * 1024 * 1600;  K = 1024; N = 1600; Nout = MLA_N; map = 1; gain = a.in[3] + (size_t)(2 * j) * 1024; WT = Wb + W_WINM + (size_t)j * MLA_N * 1024; }
        else if (mi < 4)  { const int j = mi - 2;  W = a.in[7] + (size_t)j * 256 * 1536;   K = 256;  N = 1536; Nout = 1536;  map = 2; gain = a.in[5] + (size_t)j * 256; WT = Wb + W_WUQ + (size_t)j * 1536 * 256; }
        else if (mi < 6)  { const int j = mi - 4;  W = a.in[8] + (size_t)j * 256 * 1024;   K = 256;  N = 1024; Nout = 1024;  gain = a.in[6] + (size_t)j * 256; WT = Wb + W_WUK + (size_t)j * 1024 * 256; }
        else if (mi < 8)  { const int j = mi - 6;  W = a.in[9] + (size_t)j * 256 * 1024;   K = 256;  N = 1024; Nout = 1024;  gain = a.in[6] + (size_t)j * 256; WT = Wb + W_WUV + (size_t)j * 1024 * 256; }
        else if (mi < 10) { const int j = mi - 8;  W = a.in[10] + (size_t)j * 1024 * 1024; K = 1024; N = 1024; Nout = 1024;  WT = Wb + W_WOM + (size_t)j * 1024 * 1024; }
        else if (mi < 12) { const int j = mi - 10; W = a.in[11] + (size_t)j * 1024 * 3144; K = 1024; N = 3144; Nout = DSA_N; map = 3; gain = a.in[3] + (size_t)(2 * j + 1) * 1024; WT = Wb + W_WIND + (size_t)j * DSA_N * 1024; }
        else if (mi < 14) { const int j = mi - 12; W = a.in[12] + (size_t)j * 1024 * 1024; K = 1024; N = 1024; Nout = 1024;  WT = Wb + W_WOD + (size_t)j * 1024 * 1024; }
        else if (mi < 18) { const int i = mi - 14; W = a.in[13] + (size_t)i * 256 * 1024;  K = 256;  N = 1024; Nout = 1024;  WT = Wb + W_WP + (size_t)i * 1024 * 256; }
        else              { const int i = mi - 18; W = a.in[15] + (size_t)i * 1024 * 1024; K = 1024; N = 1024; Nout = 1024;  gain = a.in[14] + (size_t)i * 1024; WT = Wb + W_WG + (size_t)i * 1024 * 1024; }
        const int nitems = (K / 64) * (Nout / 32);
        for (int it = gw; it < nitems; it += ngw) tr_item(W, K, N, WT, Nout, gain, map, scr, it, lane);
    }
    {
        const int* pos = (const int*)a.in[2]; unsigned* r64 = (unsigned*)(a.ws + WS_ROPE64); unsigned* r32 = (unsigned*)(a.ws + WS_ROPE32);
        const float inv64 = 1.0f / powf(10000.0f, (float)lane / 64.0f);
        const float inv32 = 1.0f / powf(10000.0f, (float)(lane & 31) / 32.0f);
        for (int t0 = gw * 4; t0 < T; t0 += ngw * 4) { int pi[4];
#pragma unroll
          for (int a = 0; a < 4; ++a) pi[a] = pos[t0 + a];
#pragma unroll
          for (int a = 0; a < 4; ++a) { const int t = t0 + a; const float pf = (float)pi[a];
            { const float ang = pf * inv64; float sn, cs; sincosf(ang, &sn, &cs); r64[(size_t)t * 64 + lane] = pack_cs(cs, sn); }
            if (lane < 32) { const float ang = pf * inv32; float sn, cs; sincosf(ang, &sn, &cs); r32[(size_t)t * 32 + lane] = pack_cs(cs, sn); }
          } }
    }
    {
        const float* x = a.in[0]; bf16* xb = (bf16*)(a.ws + WS_XB0); float* rsx = (float*)(a.ws + WS_RSX);
        for (int r0 = gw * 4; r0 < T; r0 += ngw * 4) {
            f32x4 v[4][4];
#pragma unroll
            for (int a = 0; a < 4; ++a) { const f32x4* xr = (const f32x4*)(x + (size_t)(r0 + a) * 1024) + lane;
#pragma unroll
                for (int j = 0; j < 4; ++j) v[a][j] = xr[64 * j]; }
#pragma unroll
            for (int a = 0; a < 4; ++a) { float s = 0.f;
#pragma unroll
                for (int j = 0; j < 4; ++j) s += sq4(v[a][j]);
                s = wave_sum(s);
                u32x2* o8 = (u32x2*)(xb + (size_t)(r0 + a) * 1024) + lane;
#pragma unroll
                for (int j = 0; j < 4; ++j) { u32x2 w; w.x = cvtpk(v[a][j][0], v[a][j][1]); w.y = cvtpk(v[a][j][2], v[a][j][3]); o8[64 * j] = w; }
                if (lane < 16) rsx[(size_t)(r0 + a) * 16 + lane] = lane == 0 ? s : 0.f; }
        }
    }
}
__device__ __forceinline__ void convert_p(const float* p, bf16* pb, int gtid_in, int gthreads) {
    const int gtid = gtid_in;
    constexpr size_t NCH = (size_t)T * 256 / 8;
    size_t i = gtid;
    for (; i + 3 * (size_t)gthreads < NCH; i += 4 * (size_t)gthreads) { f32x4 a[4], b[4];
#pragma unroll
        for (int u = 0; u < 4; ++u) { const size_t c = i + u * (size_t)gthreads; a[u] = *(const f32x4*)(p + c * 8); b[u] = *(const f32x4*)(p + c * 8 + 4); }
#pragma unroll
        for (int u = 0; u < 4; ++u) { const size_t c = i + u * (size_t)gthreads; *(v4u*)(pb + c * 8) = pack8(a[u], b[u]); } }
    for (; i < NCH; i += gthreads) { const f32x4 a = *(const f32x4*)(p + i * 8), b = *(const f32x4*)(p + i * 8 + 4); *(v4u*)(pb + i * 8) = pack8(a, b); }
}

__device__ __forceinline__ unsigned f2key(float s) { const unsigned u = __builtin_bit_cast(unsigned, s); return (u & 0x80000000u) ? ~u : (u | 0x80000000u); }
__device__ __forceinline__ float relu_bits(float x) { const int i = __float_as_int(x); return __int_as_float(i > 0 ? i : 0); }
struct TkUnit { int b, q0; };
__device__ __forceinline__ TkUnit tk_unit(int i, int blk, int nblk, int per) {
    const int pass = i / (NB * per), rem = i - pass * NB * per, b = rem / per, w0 = blk + (rem - b * per) * nblk; TkUnit u; u.b = b; u.q0 = (pass ? 511 - w0 : w0) * 8; return u;
}
constexpr int TK_H1 = 131072, TK_HW = 131072 + 16384, TK_HWS = 576;
struct TkPre { bf16x8 aX[4], aY[4]; f32x4 w[4][2]; bf16x8 kA[4], kB[4], kC[4]; };
__device__ __forceinline__ void tk_preload(TkPre& P, const TkUnit u, int aw, int lane, const bf16* QI, const bf16* KI, const float* WI) {
    const int r = lane & 31, hb = lane >> 5;
    const int a_q = ((r >> 2) & 1) * 2 + (r >> 4), a_h = (r & 3) + 4 * ((r >> 3) & 1);
    const size_t tok0 = (size_t)u.b * SEQ + u.q0; const int ntile = (u.q0 + 8 + 31) >> 5;
#pragma unroll
    for (int s = 0; s < 4; ++s) { P.aX[s] = *(const bf16x8*)(QI + (tok0 + a_q) * 512 + a_h * 64 + 16 * s + 8 * hb); P.aY[s] = *(const bf16x8*)(QI + (tok0 + 4 + a_q) * 512 + a_h * 64 + 16 * s + 8 * hb); }
#pragma unroll
    for (int i = 0; i < 4; ++i) { const int qc = (i >> 1) * 4 + 2 * hb + (i & 1); P.w[i][0] = *(const f32x4*)(WI + (tok0 + qc) * 8); P.w[i][1] = *(const f32x4*)(WI + (tok0 + qc) * 8 + 4); }
    const bf16* kbase = KI + ((size_t)u.b * SEQ + r) * 64 + 8 * hb;
#pragma unroll
    for (int j = 0; j < 3; ++j) { const int t = aw + 4 * j, tt = t < ntile ? t : ntile - 1;
#pragma unroll
        for (int s = 0; s < 4; ++s) { const bf16x8 v = *(const bf16x8*)(kbase + (size_t)tt * 32 * 64 + 16 * s); if (j == 0) P.kA[s] = v; else if (j == 1) P.kB[s] = v; else P.kC[s] = v; } }
}
__device__ __forceinline__ void tk_stepA(TkPre& P, const TkUnit u, const TkUnit nxt, bool has_next, int aw, int lane, LAS unsigned char* lds, const bf16* QI, const bf16* KI, const float* WI) {
    typedef float f32x16 __attribute__((ext_vector_type(16)));
    LAS unsigned* ky = (LAS unsigned*)lds; LAS unsigned* h1 = (LAS unsigned*)(lds + TK_H1) + (lane & 3) * 1024;
    const int r = lane & 31, hb = lane >> 5;
    const int q0 = u.q0;
    float wv[4][8];
#pragma unroll
    for (int i = 0; i < 4; ++i) {
#pragma unroll
        for (int e = 0; e < 4; ++e) { wv[i][e] = P.w[i][0][e] * (0.125f * 0.35355339059327373f); wv[i][4 + e] = P.w[i][1][e] * (0.125f * 0.35355339059327373f); } }
    const int ntile = (q0 + 8 + 31) >> 5;
    const unsigned kvoff = (unsigned)(r * 64 + 8 * hb) * 2u;
    __amdgpu_buffer_rsrc_t krs; { const unsigned long long b_ = (unsigned long long)(KI + (size_t)u.b * SEQ * 64);
        const unsigned lo_ = __builtin_amdgcn_readfirstlane((unsigned)b_), hi_ = __builtin_amdgcn_readfirstlane((unsigned)(b_ >> 32));
        krs = __builtin_amdgcn_make_buffer_rsrc((void*)(((unsigned long long)hi_ << 32) | lo_), (short)0, 0x7fffffff, 0x00020000); }
    bf16x8 kD[4];
#define TK_KLOAD(buf, t) do { const int tt_ = (t) < ntile ? (t) : ntile - 1;     \
        _Pragma("unroll") for (int s = 0; s < 4; ++s) buf[s] = __builtin_bit_cast(bf16x8, __builtin_amdgcn_raw_buffer_load_b128(krs, (int)(kvoff + 32u * s), tt_ * 4096, 0)); } while (0)
#define TK_TILE(buf, t) do { if ((t) < ntile) { const int key = (t) * 32 + r; f32x16 cX = {}, cY = {};                                                            \
        _Pragma("unroll") for (int s = 0; s < 4; ++s) { cX = __builtin_amdgcn_mfma_f32_32x32x16_bf16(P.aX[s], buf[s], cX, 0, 0, 0); cY = __builtin_amdgcn_mfma_f32_32x32x16_bf16(P.aY[s], buf[s], cY, 0, 0, 0); } \
        float sc[4] = {0.f, 0.f, 0.f, 0.f};                                                                                                                      \
        _Pragma("unroll") for (int e = 0; e < 8; ++e) { sc[0] = __builtin_fmaf(relu_bits(cX[e]), wv[0][e], sc[0]); sc[1] = __builtin_fmaf(relu_bits(cX[8 + e]), wv[1][e], sc[1]); \
                                                        sc[2] = __builtin_fmaf(relu_bits(cY[e]), wv[2][e], sc[2]); sc[3] = __builtin_fmaf(relu_bits(cY[8 + e]), wv[3][e], sc[3]); } \
        _Pragma("unroll") for (int i = 0; i < 4; ++i) { const int qc = (i >> 1) * 4 + 2 * hb + (i & 1); const unsigned ub = __builtin_bit_cast(unsigned, sc[i] + 0.0f);        \
            const unsigned kf = ub ^ ((unsigned)((int)ub >> 31) | 0x80000000u);                                      \
            const unsigned kk = (key <= q0 + qc) ? kf : 0u; ky[qc * 4096 + key] = kk;                                                                            \
            __hip_atomic_fetch_add(h1 + qc * 128 + (kk >> 25), 1u << ((kk >> 20) & 16u), __ATOMIC_RELAXED, __HIP_MEMORY_SCOPE_WORKGROUP); } } } while (0)
    for (int tile = aw; tile < ntile; tile += 16) {
        TK_KLOAD(kD, tile + 12); TK_TILE(P.kA, tile);
        TK_KLOAD(P.kA, tile + 16); TK_TILE(P.kB, tile + 4);
        TK_KLOAD(P.kB, tile + 20); TK_TILE(P.kC, tile + 8);
        TK_KLOAD(P.kC, tile + 24); TK_TILE(kD, tile + 12);
    }
#undef TK_KLOAD
#undef TK_TILE
    const int kend = ((q0 + 8 + 511) >> 9) << 9;
    for (int key = ntile * 32 + aw * 64 + lane; key < kend; key += 256) {
#pragma unroll
        for (int i = 0; i < 8; ++i) ky[i * 4096 + key] = 0u; }
    if (has_next) tk_preload(P, nxt, aw, lane, QI, KI, WI);
}
__device__ __forceinline__ void tk_stepB(const unsigned (&k)[64], int q, size_t tok, int ngrp, int lane, const int (&c0)[4], LAS unsigned* hw, unsigned long long* mask) {
    unsigned thr = 0u; int need = 0;
    if (q >= 256) {
        unsigned prefix = 0u; int rem = 256; bool done = false;
#pragma unroll
        for (int p = 0; p < 4; ++p) {
            constexpr int SH[4] = {24, 15, 6, 0}, NBITS[4] = {8, 9, 9, 6};
            const int sh = SH[p], nb = NBITS[p];
            int c[8];
            if (p == 0) { c[0] = c0[0]; c[1] = c0[1]; c[2] = c0[2]; c[3] = c0[3]; c[4] = 0; c[5] = 0; c[6] = 0; c[7] = 0; }
            else {
                *(LAS v4u*)(hw + lane * 8) = (v4u){0u, 0u, 0u, 0u}; *(LAS v4u*)(hw + lane * 8 + 4) = (v4u){0u, 0u, 0u, 0u};
                const unsigned pfx = prefix >> (sh + nb), dummy = 512u + (unsigned)lane;
#pragma unroll
                for (int g = 0; g < 8; ++g) if (g < ngrp) {
#pragma unroll
                    for (int e = 0; e < 8; ++e) { const unsigned kk = k[g * 8 + e]; const bool cand = (kk >> (sh + nb)) == pfx; const unsigned bin = (kk >> sh) & ((1u << nb) - 1u);
                        if (p == 1) __hip_atomic_fetch_add(hw + (cand ? bin : dummy), 1u, __ATOMIC_RELAXED, __HIP_MEMORY_SCOPE_WORKGROUP);
                        else if (__ballot(cand) != 0ull) { if (cand) __hip_atomic_fetch_add(hw + bin, 1u, __ATOMIC_RELAXED, __HIP_MEMORY_SCOPE_WORKGROUP); } }
                    __builtin_amdgcn_sched_barrier(0); }
                LDS_WAIT(); asm volatile("" ::: "memory");
                const v4u h0 = *(const LAS v4u*)(hw + lane * 8), h1v = *(const LAS v4u*)(hw + lane * 8 + 4);
                c[0] = (int)h0.x; c[1] = (int)h0.y; c[2] = (int)h0.z; c[3] = (int)h0.w; c[4] = (int)h1v.x; c[5] = (int)h1v.y; c[6] = (int)h1v.z; c[7] = (int)h1v.w; }
            const int tot = ((c[0] + c[1]) + (c[2] + c[3])) + ((c[4] + c[5]) + (c[6] + c[7]));
            int P = tot;
            P += __builtin_amdgcn_update_dpp(0, P, 0x111, 0xf, 0xf, false); P += __builtin_amdgcn_update_dpp(0, P, 0x112, 0xf, 0xf, false);
            P += __builtin_amdgcn_update_dpp(0, P, 0x114, 0xf, 0xf, false); P += __builtin_amdgcn_update_dpp(0, P, 0x118, 0xf, 0xf, false);
            P += __builtin_amdgcn_update_dpp(0, P, 0x142, 0xa, 0xf, false); P += __builtin_amdgcn_update_dpp(0, P, 0x143, 0xc, 0xf, false);
            const int total = __builtin_amdgcn_readlane(P, 63);
            const int snext = total - P;
            const int L = __popcll(__ballot(snext + tot >= rem)) - 1;
            int s = snext, dl = 0, cgl = 0, cel = 0;
#pragma unroll
            for (int e = 7; e >= 0; --e) { const int s2 = s + c[e]; const bool hit = (s < rem) && (s2 >= rem); dl = hit ? e : dl; cgl = hit ? s : cgl; cel = hit ? c[e] : cel; s = s2; }
            const int d = L * (p == 0 ? 4 : 8) + __builtin_amdgcn_readlane(dl, L), cgt = __builtin_amdgcn_readlane(cgl, L), ceq = __builtin_amdgcn_readlane(cel, L);
            rem -= cgt; prefix |= (unsigned)d << sh;
            if (ceq == rem) { done = true; break; }
        }
        if (done) { thr = prefix - 1u; need = 0; } else { thr = prefix; need = rem; }
    }
    unsigned wlo = 0u, whi = 0u;
#define WL(J, w) do { const unsigned lo_ = (unsigned)(w), hi_ = (unsigned)((w) >> 32);                                                                      \
                asm volatile("s_nop 3\n\tv_writelane_b32 %0, %2, " #J "\n\tv_writelane_b32 %1, %3, " #J : "+v"(wlo), "+v"(whi) : "s"(lo_), "s"(hi_)); } while (0)
#define REP64(M) M(0); M(1); M(2); M(3); M(4); M(5); M(6); M(7); __builtin_amdgcn_sched_barrier(0); M(8); M(9); M(10); M(11); M(12); M(13); M(14); M(15); __builtin_amdgcn_sched_barrier(0); \
                 M(16); M(17); M(18); M(19); M(20); M(21); M(22); M(23); __builtin_amdgcn_sched_barrier(0); M(24); M(25); M(26); M(27); M(28); M(29); M(30); M(31); __builtin_amdgcn_sched_barrier(0); \
                 M(32); M(33); M(34); M(35); M(36); M(37); M(38); M(39); __builtin_amdgcn_sched_barrier(0); M(40); M(41); M(42); M(43); M(44); M(45); M(46); M(47); __builtin_amdgcn_sched_barrier(0); \
                 M(48); M(49); M(50); M(51); M(52); M(53); M(54); M(55); __builtin_amdgcn_sched_barrier(0); M(56); M(57); M(58); M(59); M(60); M(61); M(62); M(63); __builtin_amdgcn_sched_barrier(0)
    if (need == 0) {
#define SEL_GT8(J0, J1, J2, J3, J4, J5, J6, J7) do { const unsigned long long w0_ = __ballot(k[J0] > thr); const unsigned long long w1_ = __ballot(k[J1] > thr); const unsigned long long w2_ = __ballot(k[J2] > thr); const unsigned long long w3_ = __ballot(k[J3] > thr); const unsigned long long w4_ = __ballot(k[J4] > thr); const unsigned long long w5_ = __ballot(k[J5] > thr); const unsigned long long w6_ = __ballot(k[J6] > thr); const unsigned long long w7_ = __ballot(k[J7] > thr);                                     \
                asm volatile("s_nop 3\n\t" "v_writelane_b32 %0, %2, " #J0 "\n\tv_writelane_b32 %1, %3, " #J0 "\n\t" "v_writelane_b32 %0, %4, " #J1 "\n\tv_writelane_b32 %1, %5, " #J1 "\n\t" "v_writelane_b32 %0, %6, " #J2 "\n\tv_writelane_b32 %1, %7, " #J2 "\n\t" "v_writelane_b32 %0, %8, " #J3 "\n\tv_writelane_b32 %1, %9, " #J3 "\n\t" "v_writelane_b32 %0, %10, " #J4 "\n\tv_writelane_b32 %1, %11, " #J4 "\n\t" "v_writelane_b32 %0, %12, " #J5 "\n\tv_writelane_b32 %1, %13, " #J5 "\n\t" "v_writelane_b32 %0, %14, " #J6 "\n\tv_writelane_b32 %1, %15, " #J6 "\n\t" "v_writelane_b32 %0, %16, " #J7 "\n\tv_writelane_b32 %1, %17, " #J7 "\n\t" : "+v"(wlo), "+v"(whi) : "s"((unsigned)(w0_)), "s"((unsigned)((w0_) >> 32)), "s"((unsigned)(w1_)), "s"((unsigned)((w1_) >> 32)), "s"((unsigned)(w2_)), "s"((unsigned)((w2_) >> 32)), "s"((unsigned)(w3_)), "s"((unsigned)((w3_) >> 32)), "s"((unsigned)(w4_)), "s"((unsigned)((w4_) >> 32)), "s"((unsigned)(w5_)), "s"((unsigned)((w5_) >> 32)), "s"((unsigned)(w6_)), "s"((unsigned)((w6_) >> 32)), "s"((unsigned)(w7_)), "s"((unsigned)((w7_) >> 32))); __builtin_amdgcn_sched_barrier(0); } while (0)
        SEL_GT8(0, 1, 2, 3, 4, 5, 6, 7); SEL_GT8(8, 9, 10, 11, 12, 13, 14, 15); SEL_GT8(16, 17, 18, 19, 20, 21, 22, 23); SEL_GT8(24, 25, 26, 27, 28, 29, 30, 31);
        SEL_GT8(32, 33, 34, 35, 36, 37, 38, 39); SEL_GT8(40, 41, 42, 43, 44, 45, 46, 47); SEL_GT8(48, 49, 50, 51, 52, 53, 54, 55); SEL_GT8(56, 57, 58, 59, 60, 61, 62, 63);
#undef SEL_GT8
    } else {
        int run = 0; const unsigned long long ltmask = (1ull << lane) - 1ull;
#define SEL_TIE(J) do { const unsigned kk = k[J]; const bool eq = kk == thr; const unsigned long long beq = __ballot(eq);                                   \
                const int rank = run + __popcll(beq & ltmask); const bool sel = (kk > thr) || (eq && rank < need);                                          \
                const unsigned long long w = __ballot(sel); WL(J, w); run += __popcll(beq); } while (0)
        REP64(SEL_TIE);
#undef SEL_TIE
    }
#undef REP64
#undef WL
    mask[tok * 64 + lane] = ((unsigned long long)whi << 32) | wlo;
}
#define TK_LOADK(kk, rowi, ngrp_) do { const LAS unsigned* row_ = (const LAS unsigned*)lds + (rowi) * 4096;                                      \
        _Pragma("unroll") for (int g = 0; g < 8; ++g) { if (g < (ngrp_)) { _Pragma("unroll") for (int e = 0; e < 8; ++e) kk[g * 8 + e] = row_[(g * 8 + e) * 64 + lane]; } \
            else { _Pragma("unroll") for (int e = 0; e < 8; ++e) kk[g * 8 + e] = 0u; } } } while (0)
__device__ __forceinline__ void topk_phase(int blk, int nblk, int wave, int lane, LAS unsigned char* lds, const bf16* QI, const bf16* KI, const float* WI, unsigned long long* mask) {
    const bool isA = wave < 4; const int aw = wave, bw = wave - 4;
    const int per = (256 - blk + nblk - 1) / nblk, n = NB * 2 * per;
    if (per <= 0) return;
    { LAS unsigned* z = (LAS unsigned*)(lds + TK_H1); for (int i = wave * 64 + lane; i < 4096; i += 512) z[i] = 0u; }
    LDS_WAIT(); __syncthreads();
    if (isA) {
        TkPre P; tk_preload(P, tk_unit(0, blk, nblk, per), aw, lane, QI, KI, WI);
        tk_stepA(P, tk_unit(0, blk, nblk, per), tk_unit(n > 1 ? 1 : 0, blk, nblk, per), n > 1, aw, lane, lds, QI, KI, WI);
        LDS_WAIT(); __builtin_amdgcn_s_barrier();
        for (int s = 1; s <= n; ++s) {
            LDS_WAIT(); __builtin_amdgcn_s_barrier();
            if (s < n) tk_stepA(P, tk_unit(s, blk, nblk, per), tk_unit(s + 1 < n ? s + 1 : s, blk, nblk, per), s + 1 < n, aw, lane, lds, QI, KI, WI);
            LDS_WAIT(); __builtin_amdgcn_s_barrier();
        }
    } else {
        LDS_WAIT(); __builtin_amdgcn_s_barrier();
        for (int s = 1; s <= n; ++s) {
            const TkUnit up = tk_unit(s - 1, blk, nblk, per);
            const int ngrp = (((up.q0 + 8 + 511) >> 9) << 9) >> 9;
            unsigned k0[64], k1[64];
            TK_LOADK(k0, 2 * bw, ngrp); TK_LOADK(k1, 2 * bw + 1, ngrp);
            int c00[4] = {0, 0, 0, 0}, c01[4] = {0, 0, 0, 0};
            { LAS unsigned* hb0 = (LAS unsigned*)(lds + TK_H1) + (2 * bw) * 128 + lane * 2;
#pragma unroll
              for (int cp = 0; cp < 4; ++cp) { const u32x2 a = *(const LAS u32x2*)(hb0 + cp * 1024), b = *(const LAS u32x2*)(hb0 + cp * 1024 + 128);
                  c00[0] += (int)(a.x & 0xffffu); c00[1] += (int)(a.x >> 16); c00[2] += (int)(a.y & 0xffffu); c00[3] += (int)(a.y >> 16);
                  c01[0] += (int)(b.x & 0xffffu); c01[1] += (int)(b.x >> 16); c01[2] += (int)(b.y & 0xffffu); c01[3] += (int)(b.y >> 16);
                  *(LAS u32x2*)(hb0 + cp * 1024) = (u32x2){0u, 0u}; *(LAS u32x2*)(hb0 + cp * 1024 + 128) = (u32x2){0u, 0u}; } }
            LDS_WAIT(); __builtin_amdgcn_s_barrier();
            LAS unsigned* hw = (LAS unsigned*)(lds + TK_HW) + bw * TK_HWS;
            const size_t tok0 = (size_t)up.b * SEQ + up.q0;
            tk_stepB(k0, up.q0 + 2 * bw, tok0 + 2 * bw, ngrp, lane, c00, hw, mask);
            tk_stepB(k1, up.q0 + 2 * bw + 1, tok0 + 2 * bw + 1, ngrp, lane, c01, hw, mask);
            LDS_WAIT(); __builtin_amdgcn_s_barrier();
        }
    }
    __syncthreads();
}
#undef TK_LOADK

#define PROBE 0
#define IN(k) (lo <= (k) && (k) < hi)
#define SEAM(k) do { if (IN(k) && IN((k) + 1)) { xcd_barrier(bar); if (PROBE == 50) xcd_barrier(bar); } } while (0)
#define WSP(T_, off) ((T_*)(args.ws + (off)))
__device__ __forceinline__ int opaque_tid() { int t = threadIdx.x; asm volatile("" : "+v"(t)); return t; }
#define PROBE 0
template <int I>
__device__ __forceinline__ void layer(const Args& args, LAS unsigned char* lds, const XcdBarrier& bar, const int lo, const int hi, const int G, const int bx) {
    constexpr int k0 = 1 + 5 * I, j = I >> 1;
    extern __shared__ __attribute__((aligned(16))) unsigned char lds_dyn[];
#define ldsg ((char*)lds_dyn)
#define TID_ (opaque_tid())
#define LANE_ ((int)threadIdx.x & 63)
#define WAVE_ (__builtin_amdgcn_readfirstlane((int)threadIdx.x >> 6))
    if constexpr ((I & 1) == 0) {
        if (IN(k0)) {
            pg8::Gemm g{WSP(bf16, WS_XB0), WSP(bf16, WS_W) + W_WINM + (size_t)j * MLA_N * 1024, T, MLA_N, 1024}; pg8::StaticOrder S; S.init(T, MLA_N, G, bx);
            EpiMlaIn E{WSP(float, WS_RSX), WSP(bf16, WS_CQ), WSP(bf16, WS_CKV), WSP(bf16, WS_SZ), WSP(bf16, WS_KPE), WSP(float, WS_RSQ), WSP(float, WS_RSKV), WSP(unsigned, WS_ROPE32)};
            if (PROBE == 5 && I == 0) pg8::gemm_phase<EpiMlaIn, pg8::StaticOrder, true, true>(lds, g, S, E);
            pg8::gemm_phase<EpiMlaIn, pg8::StaticOrder, true, true>(lds, g, S, E);
        }
        SEAM(k0);
        if (IN(k0 + 1)) for (int rep = 0; rep < ((PROBE == 4 && I < 2) ? 2 : 1); ++rep) {
            { pg8::Gemm g{WSP(bf16, WS_CQ), WSP(bf16, WS_W) + W_WUQ + (size_t)j * 1536 * 256, T, 1536, 256}; pg8::StaticOrder S; S.init(T, 1536, G, bx); EpiMlaQ E{WSP(float, WS_RSQ), WSP(bf16, WS_Q), WSP(unsigned, WS_ROPE32)};
              pg8::gemm_phase<EpiMlaQ, pg8::StaticOrder, true, true>(lds, g, S, E); }
            { pg8::Gemm g{WSP(bf16, WS_CKV), WSP(bf16, WS_W) + W_WUK + (size_t)j * 1024 * 256, T, 1024, 256}; pg8::StaticOrder S; S.init(T, 1024, G, bx); EpiMlaKV E{WSP(float, WS_RSKV), WSP(bf16, WS_KN)};
              pg8::gemm_phase<EpiMlaKV, pg8::StaticOrder, true, true>(lds, g, S, E); }
            { pg8::Gemm g{WSP(bf16, WS_CKV), WSP(bf16, WS_W) + W_WUV + (size_t)j * 1024 * 256, T, 1024, 256}; pg8::StaticOrder S; S.init(T, 1024, G, bx); EpiMlaKV E{WSP(float, WS_RSKV), WSP(bf16, WS_V)};
              pg8::gemm_phase<EpiMlaKV, pg8::StaticOrder, true, true>(lds, g, S, E); }
        }
        SEAM(k0 + 1);
        if (IN(k0 + 2)) {
            for (int rep = (PROBE == 11 && I == 0) ? 0 : 1; rep < 2; ++rep)
            att::attn_phase<true, false, 1536, 192, 1024, 1024, 8>(ldsg, WSP(bf16, WS_Q), WSP(bf16, WS_KN), WSP(bf16, WS_V), WSP(bf16, WS_KPE), WSP(bf16, WS_SZ), nullptr, 0.07216878364870323f, args.in[1] + (size_t)I * T * 256, WSP(bf16, WS_PB), rep == 0);
        }
        SEAM(k0 + 2);
    } else {
        if (IN(k0)) {
            pg8::Gemm g{WSP(bf16, WS_XB0), WSP(bf16, WS_W) + W_WIND + (size_t)j * DSA_N * 1024, T, DSA_N, 1024}; pg8::StaticOrder S; S.init(T, DSA_N, G, bx);
            EpiDsaIn E{WSP(float, WS_RSX), WSP(bf16, WS_Q), WSP(bf16, WS_KD), WSP(bf16, WS_VD), WSP(bf16, WS_QI), WSP(bf16, WS_SZ), WSP(bf16, WS_KI), WSP(float, WS_WI), WSP(unsigned, WS_ROPE64), WSP(unsigned, WS_ROPE32)};
            for (int rep = 0; rep < ((PROBE == 4 && I < 2) ? 2 : 1); ++rep) pg8::gemm_phase<EpiDsaIn, pg8::StaticOrder, true, true>(lds, g, S, E);
        }
        SEAM(k0);
        if (IN(k0 + 1)) {
            topk_phase(bx, G, WAVE_, LANE_, lds, WSP(bf16, WS_QI), WSP(bf16, WS_KI), WSP(float, WS_WI), WSP(unsigned long long, WS_MASK)); }
        SEAM(k0 + 1);
        if (IN(k0 + 2)) {
            if (PROBE == 2 && I == 1) att::attn_phase<false, true, 1024, 128, 256, 256, 2, true>(ldsg, WSP(bf16, WS_Q), WSP(bf16, WS_KD), WSP(bf16, WS_VD), nullptr, WSP(bf16, WS_SZ), WSP(unsigned long long, WS_MASK), 0.08838834764831845f, args.in[1] + (size_t)I * T * 256, WSP(bf16, WS_PB));
            att::attn_phase<false, true, 1024, 128, 256, 256, 2>(ldsg, WSP(bf16, WS_Q), WSP(bf16, WS_KD), WSP(bf16, WS_VD), nullptr, WSP(bf16, WS_SZ), WSP(unsigned long long, WS_MASK), 0.08838834764831845f, args.in[1] + (size_t)I * T * 256, WSP(bf16, WS_PB));
        }
        SEAM(k0 + 2);
    }
    if (IN(k0 + 3)) for (int rep = ((PROBE == 4 && I < 2) ? 0 : 1); rep < 2; ++rep) {
        { pg8::Gemm g{WSP(bf16, WS_PB), WSP(bf16, WS_W) + W_WP + (size_t)I * 1024 * 256, T, 1024, 256}; pg8::StaticOrder S; S.init(T, 1024, G, bx); EpiPlain E{WSP(bf16, WS_PP)};
          pg8::gemm_phase<EpiPlain, pg8::StaticOrder, true, true>(lds, g, S, E); }
        { pg8::Gemm g{WSP(bf16, WS_SZ), WSP(bf16, WS_W) + ((I & 1) ? W_WOD : W_WOM) + (size_t)j * 1024 * 1024, T, 1024, 1024}; pg8::StaticOrder S; S.init(T, 1024, G, bx);
          EpiOut E{WSP(bf16, WS_XB0), WSP(bf16, WS_XB1), WSP(float, WS_RS1), rep == 0};
          pg8::gemm_phase<EpiOut, pg8::StaticOrder, true, true>(lds, g, S, E); }
    }
    SEAM(k0 + 3);
    if (IN(k0 + 4)) for (int rep = ((PROBE == 4 && I < 2) ? 0 : 1); rep < 2; ++rep) {
        pg8::Gemm g{WSP(bf16, WS_XB1), WSP(bf16, WS_W) + W_WG + (size_t)I * 1024 * 1024, T, 1024, 1024}; pg8::StaticOrder S; S.init(T, 1024, G, bx);
        EpiGate E{WSP(float, WS_RS1), WSP(bf16, WS_XB1), WSP(bf16, WS_PP), WSP(bf16, WS_XB0), WSP(float, WS_RSX), rep == 0};
        pg8::gemm_phase<EpiGate, pg8::StaticOrder, true, true>(lds, g, S, E);
    }
    SEAM(k0 + 4);
#undef TID_
#undef LANE_
#undef WAVE_
#undef ldsg
}

__global__ void __launch_bounds__(NWAVES * 64, 2) fwd(Args args) {
    extern __shared__ __attribute__((aligned(16))) unsigned char lds_raw[];
    LAS unsigned char* lds = (LAS unsigned char*)lds_raw;
    volatile LAS unsigned* MISC = (volatile LAS unsigned*)(lds + MISC_OFF);
    const int G = gridDim.x, bx = blockIdx.x;
    for (int u = threadIdx.x; u < (LDS_BYTES - MISC_OFF) / 4; u += NWAVES * 64) ((LAS unsigned*)(lds + MISC_OFF))[u] = 0u;
    __syncthreads();
    const int lo = args.ph_lo, hi = args.ph_hi;
    XcdBarrier bar; bar.bar = (unsigned*)(args.ws + WS_CTL) + CW_BAR; bar.x = 0; bar.st = nullptr;
    if (hi - lo > 1) bar = xcd_barrier_post((unsigned*)(args.ws + WS_CTL) + CW_BAR, MISC + 8);

    if (IN(0)) { const int lane = threadIdx.x & 63, wave = __builtin_amdgcn_readfirstlane((int)threadIdx.x >> 6);
        if (PROBE == 8) prologue(args, lds, bx * NWAVES + wave, G * NWAVES, wave, lane); prologue(args, lds, bx * NWAVES + wave, G * NWAVES, wave, lane); }
    SEAM(0);
    layer<0>(args, lds, bar, lo, hi, G, bx);
    layer<1>(args, lds, bar, lo, hi, G, bx);
    layer<2>(args, lds, bar, lo, hi, G, bx);
    layer<3>(args, lds, bar, lo, hi, G, bx);
    if (IN(21)) {
        const int lane = threadIdx.x & 63, wave = __builtin_amdgcn_readfirstlane((int)threadIdx.x >> 6);
        const int gw = bx * NWAVES + wave, ngw = G * NWAVES;
        const float* fg = args.in[16]; f32x4 gv[4];
#pragma unroll
        for (int jj = 0; jj < 4; ++jj) gv[jj] = ((const f32x4*)fg)[lane + 64 * jj];
        const bf16* xbf = (const bf16*)(args.ws + WS_XB0);
        for (int r0 = gw * 4; r0 < T; r0 += ngw * 4) { u32x2 w[4][4];
#pragma unroll
            for (int a = 0; a < 4; ++a) { const u32x2* xr = (const u32x2*)(xbf + (size_t)(r0 + a) * 1024) + lane;
#pragma unroll
                for (int jj = 0; jj < 4; ++jj) w[a][jj] = xr[64 * jj]; }
#pragma unroll
            for (int a = 0; a < 4; ++a) { f32x4 v[4]; float s = 0.f;
#pragma unroll
                for (int jj = 0; jj < 4; ++jj) { v[jj][0] = bf2f(w[a][jj].x & 0xffffu); v[jj][1] = bf2f(w[a][jj].x >> 16); v[jj][2] = bf2f(w[a][jj].y & 0xffffu); v[jj][3] = bf2f(w[a][jj].y >> 16); s += sq4(v[jj]); }
                const float rstd = rsqrtf(wave_sum(s) * (1.f / 1024.f) + NORM_EPS);
                f32x4* orow = (f32x4*)(args.out + (size_t)(r0 + a) * 1024) + lane;
#pragma unroll
                for (int jj = 0; jj < 4; ++jj) orow[64 * jj] = v[jj] * rstd * gv[jj]; } }
    }
}
#undef IN
#undef SEAM

#if PROBE == 12 || PROBE == 13
__global__ void __launch_bounds__(NWAVES * 64, 2) probe_attn(Args args) {
    extern __shared__ __attribute__((aligned(16))) unsigned char lds_raw[];
#if PROBE == 12
    att::attn_phase<true, false, 1536, 192, 1024, 1024, 8, true>((char*)lds_raw, WSP(bf16, WS_Q), WSP(bf16, WS_KN), WSP(bf16, WS_V), WSP(bf16, WS_KPE), WSP(bf16, WS_SZ), nullptr, 0.07216878364870323f, args.in[1], WSP(bf16, WS_PB));
#else
    att::attn_phase<false, true, 1024, 128, 256, 256, 2, true>((char*)lds_raw, WSP(bf16, WS_Q), WSP(bf16, WS_KD), WSP(bf16, WS_VD), nullptr, WSP(bf16, WS_SZ), WSP(unsigned long long, WS_MASK), 0.08838834764831845f, args.in[1], WSP(bf16, WS_PB));
#endif
}
#endif
#ifndef ONE_LAUNCH
#define ONE_LAUNCH 1
#endif
extern "C" void kernel_launch(void* const* d_in, const int* in_sizes, int n_in, void* d_out, int out_size, void* d_ws, size_t ws_size, hipStream_t stream) {
    static int grid = 0;
    if (grid == 0) {
        if (n_in != 17 || out_size != T * DM || ws_size < WS_END) { fprintf(stderr, "kernel_launch: unexpected shapes (n_in %d, out %d, ws %zu)\n", n_in, out_size, ws_size); grid = -1; return; }
        int dev = 0, cus = 0, per_cu = 0;
        if (hipGetDevice(&dev) != hipSuccess || hipDeviceGetAttribute(&cus, hipDeviceAttributeMultiprocessorCount, dev) != hipSuccess) { grid = -1; return; }
        if (hipFuncSetAttribute((const void*)fwd, hipFuncAttributeMaxDynamicSharedMemorySize, LDS_BYTES) != hipSuccess) { fprintf(stderr, "kernel_launch: hipFuncSetAttribute failed\n"); grid = -1; return; }
        if (hipOccupancyMaxActiveBlocksPerMultiprocessor(&per_cu, (const void*)fwd, NWAVES * 64, LDS_BYTES) != hipSuccess || per_cu < 1) fprintf(stderr, "kernel_launch: occupancy query says %d\n", per_cu);
        (void)hipGetLastError();
        grid = cus;
    }
    if (grid < 0) return;
    (void)hipMemsetAsync((char*)d_ws + WS_CTL, 0, CTL_ZERO_BYTES, stream);
    Args a{};
    for (int i = 0; i < 17; ++i) a.in[i] = (const float*)d_in[i];
    a.out = (float*)d_out; a.ws = (unsigned char*)d_ws;
    if (ONE_LAUNCH) { a.ph_lo = 0; a.ph_hi = NPHASE; hipLaunchKernelGGL(fwd, dim3(grid), dim3(NWAVES * 64), LDS_BYTES, stream, a); }
    else for (int ph = 0; ph < NPHASE; ++ph) { a.ph_lo = ph; a.ph_hi = ph + 1; hipLaunchKernelGGL(fwd, dim3(grid), dim3(NWAVES * 64), LDS_BYTES, stream, a); }
#if PROBE >= 100
    a.pmode = (PROBE / 100) - 1; a.ph_lo = PROBE % 100; a.ph_hi = PROBE % 100 + 1; hipLaunchKernelGGL(fwd, dim3(grid), dim3(NWAVES * 64), LDS_BYTES, stream, a);
#endif
#if PROBE == 12 || PROBE == 13
    { static bool attr2 = false; if (!attr2) { attr2 = true; (void)hipFuncSetAttribute((const void*)probe_attn, hipFuncAttributeMaxDynamicSharedMemorySize, LDS_BYTES); }
      hipLaunchKernelGGL(probe_attn, dim3(grid), dim3(NWAVES * 64), LDS_BYTES, stream, a); }
#endif
}
```

```cpp
#include <hip/hip_runtime.h>
#include <cstdio>
#include <cstdint>
namespace pg8 {
#define PG8_LAS __attribute__((address_space(3)))
typedef unsigned short bf16_t;
typedef short bf16x8 __attribute__((ext_vector_type(8)));
typedef float f32x4 __attribute__((ext_vector_type(4)));
typedef unsigned u32x4 __attribute__((ext_vector_type(4)));
constexpr int BM = 256, BK = 64, HALF = 128, HTB = HALF * BK * 2  , STAGE_BYTES = 8 * HTB, NXCD = 8, WGM = 8;

__host__ __device__ __forceinline__ int lds_byte(int r, int c) { const int st = (r >> 4) * 2 + (c >> 5), rr = r & 15, cc = c & 31, ob = rr * 64 + cc * 2; return st * 1024 + (ob ^ (((ob >> 9) & 1) << 5)); }
__host__ __device__ __forceinline__ void stage_rc(int b, int& R, int& C) { const int st = b / 1024, sb = b % 1024, swz = sb ^ (((sb >> 9) & 1) << 5); R = (st >> 1) * 16 + swz / 64; C = (st & 1) * 32 + (swz % 64) / 2; }
__host__ __device__ __forceinline__ int perm32(int rho) { const int n = rho >> 4, i = rho & 15; return 8 * (i >> 2) + 4 * n + (i & 3); }

struct Unit { int pm, pn; };
struct Gemm { const bf16_t* A; const bf16_t* Bt; int M, N, K; };

struct StaticOrder {
    int nM, nN, nwg, G, c;
    __host__ __device__ void init(int M, int N, int G_, int c_) { nM = M / BM; nN = N / BM; nwg = nM * nN; G = G_; c = c_; }
    __host__ __device__ bool next(int i, Unit& u) const {
        const long L = (long)i * G + c; if (L >= nwg) return false;
        int wgid = (int)L; { const int q = nwg / NXCD, r = nwg % NXCD, xcd = wgid % NXCD, off = wgid / NXCD; wgid = (xcd < r ? xcd * (q + 1) : r * (q + 1) + (xcd - r) * q) + off; }
        const int nig = WGM * nN, gid = wgid / nig, fm = gid * WGM, gsz = (nM - fm) < WGM ? (nM - fm) : WGM;
        u.pm = fm + ((wgid % nig) % gsz); u.pn = (wgid % nig) / gsz; return true;
    }
    __device__ __forceinline__ void a_ready(const Unit&) const {}
    __device__ __forceinline__ void done(const Unit&) const {}
};

__device__ __forceinline__ unsigned cvt_pk_bf16(float lo, float hi) { unsigned r; asm volatile("v_cvt_pk_bf16_f32 %0, %1, %2" : "=v"(r) : "v"(lo), "v"(hi)); return r; }
typedef float f32x2 __attribute__((ext_vector_type(2)));
template <class Epi, class Sched, bool ALIGN_EPI = false, bool SP2 = false>
__device__ __forceinline__ void gemm_phase(PG8_LAS unsigned char* lds, const Gemm g, const Sched& S, const Epi& E) {
    const int tid = threadIdx.x, wid = __builtin_amdgcn_readfirstlane(tid >> 6), lane = tid & 63, wr = wid >> 2, wc = wid & 3, fr = lane & 15, fq = lane >> 4;
    const int K = g.K, nt = K / BK;
    unsigned voffA[2], voffB[2];
#pragma unroll
    for (int i = 0; i < 2; ++i) { int R, C; stage_rc(tid * 16 + i * 8192, R, C); const int Rb = Epi::PERM ? ((R & ~31) + perm32(R & 31)) : R;
        voffA[i] = (unsigned)(R * K + C) * 2u; voffB[i] = (unsigned)(Rb * K + C) * 2u; }
    const size_t kstep = (size_t)(BK * 2);
    const size_t hstep = (size_t)HALF * K * 2;
    const size_t tstep = 2 * hstep;
    const unsigned ldsw = (unsigned)wid * 1024u;
    const int aoff = lds_byte(wr * 64 + fr, fq * 8), boff = lds_byte(wc * 32 + fr, fq * 8);
#define PG8_SA(b, h) (((b) * 2 + (h)) * HTB)
#define PG8_SB(b, h) ((4 + (b) * 2 + (h)) * HTB)
#define PG8_STAGE(bufoff, gbase, voff) do { _Pragma("unroll") for (int _i = 0; _i < 2; ++_i) \
        __builtin_amdgcn_global_load_lds((const unsigned*)((const char*)(gbase) + (voff)[_i]), (PG8_LAS unsigned*)(lds + (bufoff) + ldsw + _i * 8192), 16, 0, 0); } while (0)
#define PG8_LDA(dst, b, h) do { _Pragma("unroll") for (int m = 0; m < 4; ++m) _Pragma("unroll") for (int k = 0; k < 2; ++k) dst[m][k] = *(const PG8_LAS bf16x8*)(lds + PG8_SA(b, h) + aoff + m * 2048 + k * 1024); } while (0)
#define PG8_LDB(dst, b, h) do { _Pragma("unroll") for (int n = 0; n < 2; ++n) _Pragma("unroll") for (int k = 0; k < 2; ++k) dst[n][k] = *(const PG8_LAS bf16x8*)(lds + PG8_SB(b, h) + boff + n * 2048 + k * 1024); } while (0)
#define PG8_MMA(ai, bj, At, Bt) do { __builtin_amdgcn_s_setprio(1); _Pragma("unroll") for (int m = 0; m < 4; ++m) _Pragma("unroll") for (int n = 0; n < 2; ++n) _Pragma("unroll") for (int k = 0; k < 2; ++k) \
        acc[ai][bj][m][n] = __builtin_amdgcn_mfma_f32_16x16x32_bf16(Bt[n][k], At[m][k], acc[ai][bj][m][n], 0, 0, 0); __builtin_amdgcn_s_setprio(0); } while (0)
#define PG8_WAIT_V(n) asm volatile("s_waitcnt vmcnt(" #n ")" ::: "memory")
#define PG8_WAIT_L(n) asm volatile("s_waitcnt lgkmcnt(" #n ")" ::: "memory")
#define PG8_BAR __builtin_amdgcn_s_barrier()
#define PG8_SCHED __builtin_amdgcn_sched_barrier(0)
    Unit cur, nxt; int ui = 0;
    if (!S.next(0, cur)) return;
    f32x4 acc[2][2][4][2];
#pragma unroll
    for (int a = 0; a < 2; ++a)
#pragma unroll
        for (int b = 0; b < 2; ++b)
#pragma unroll
            for (int m = 0; m < 4; ++m)
#pragma unroll
                for (int n = 0; n < 2; ++n) acc[a][b][m][n] = (f32x4){0.f, 0.f, 0.f, 0.f};
    bf16x8 At[4][2], B0[2][2], B1[2][2];
    const char* cA = (const char*)g.A + (size_t)cur.pm * tstep; const char* cB = (const char*)g.Bt + (size_t)cur.pn * tstep;
    S.a_ready(cur);
    if constexpr (SP2) {
        PG8_STAGE(PG8_SB(0, 0), cB, voffB); PG8_STAGE(PG8_SB(0, 1), cB + hstep, voffB); PG8_STAGE(PG8_SA(0, 0), cA, voffA); PG8_STAGE(PG8_SA(0, 1), cA + hstep, voffA);
        if (wr == 1) PG8_BAR;
        PG8_WAIT_V(2); PG8_BAR;
        PG8_STAGE(PG8_SB(1, 0), cB + kstep, voffB); PG8_STAGE(PG8_SA(1, 0), cA + kstep, voffA); PG8_STAGE(PG8_SB(1, 1), cB + hstep + kstep, voffB);
        PG8_WAIT_V(6); PG8_BAR;
    } else {
        PG8_STAGE(PG8_SB(0, 0), cB, voffB); PG8_STAGE(PG8_SA(0, 0), cA, voffA); PG8_STAGE(PG8_SB(0, 1), cB + hstep, voffB); PG8_STAGE(PG8_SA(0, 1), cA + hstep, voffA);
        if (wr == 1) PG8_BAR;
        PG8_WAIT_V(4); PG8_BAR;
        PG8_STAGE(PG8_SB(1, 0), cB + kstep, voffB); PG8_STAGE(PG8_SA(1, 0), cA + kstep, voffA); PG8_STAGE(PG8_SB(1, 1), cB + hstep + kstep, voffB);
        PG8_WAIT_V(6); PG8_BAR;
    }
    for (;;) {
        const bool has_next = S.next(ui + 1, nxt);
        const char* nA = has_next ? (const char*)g.A + (size_t)nxt.pm * tstep : cA; const char* nB = has_next ? (const char*)g.Bt + (size_t)nxt.pn * tstep : cB;
        _Pragma("nounroll") for (int t = 0; t < nt; t += 2) {
            const bool last = (t == nt - 2);
            const char* a1 = cA + (size_t)(t + 1) * kstep;
            const char* a2 = last ? nA : cA + (size_t)(t + 2) * kstep; const char* b2 = last ? nB : cB + (size_t)(t + 2) * kstep;
            const char* a3 = a2 + kstep; const char* b3 = b2 + kstep;
            if (last && has_next) S.a_ready(nxt);
            if constexpr (SP2) {
            PG8_LDB(B0, 0, 0); PG8_LDB(B1, 0, 1); PG8_SCHED; PG8_LDA(At, 0, 0); PG8_STAGE(PG8_SA(1, 1), a1 + hstep, voffA);
            PG8_WAIT_V(8); PG8_WAIT_L(0); PG8_BAR; PG8_MMA(0, 0, At, B0); PG8_MMA(0, 1, At, B1); PG8_BAR; PG8_SCHED;
            PG8_LDA(At, 0, 1); PG8_STAGE(PG8_SB(0, 0), b2, voffB); PG8_STAGE(PG8_SB(0, 1), b2 + hstep, voffB); PG8_STAGE(PG8_SA(0, 0), a2, voffA);
            PG8_WAIT_V(8); PG8_WAIT_L(0); PG8_BAR; PG8_MMA(1, 0, At, B0); PG8_MMA(1, 1, At, B1); PG8_BAR; PG8_SCHED;
            PG8_LDB(B0, 1, 0); PG8_LDB(B1, 1, 1); PG8_SCHED; PG8_LDA(At, 1, 0); PG8_STAGE(PG8_SA(0, 1), a2 + hstep, voffA);
            PG8_WAIT_V(8); PG8_WAIT_L(0); PG8_BAR; PG8_MMA(0, 0, At, B0); PG8_MMA(0, 1, At, B1); PG8_BAR; PG8_SCHED;
            PG8_LDA(At, 1, 1); PG8_STAGE(PG8_SB(1, 0), b3, voffB); PG8_STAGE(PG8_SB(1, 1), b3 + hstep, voffB); PG8_STAGE(PG8_SA(1, 0), a3, voffA);
            PG8_WAIT_V(8); PG8_WAIT_L(0); PG8_BAR; PG8_MMA(1, 0, At, B0); PG8_MMA(1, 1, At, B1); PG8_BAR; PG8_SCHED;
            } else {
            PG8_LDB(B0, 0, 0); PG8_SCHED; PG8_LDA(At, 0, 0); PG8_STAGE(PG8_SA(1, 1), a1 + hstep, voffA);
            PG8_WAIT_L(8); PG8_BAR; PG8_WAIT_L(0); PG8_MMA(0, 0, At, B0); PG8_BAR; PG8_SCHED;
            PG8_LDB(B1, 0, 1); PG8_STAGE(PG8_SB(0, 0), b2, voffB);
            PG8_BAR; PG8_WAIT_L(0); PG8_MMA(0, 1, At, B1); PG8_BAR;
            PG8_LDA(At, 0, 1); PG8_STAGE(PG8_SA(0, 0), a2, voffA);
            PG8_BAR; PG8_WAIT_L(0); PG8_MMA(1, 0, At, B0); PG8_BAR; PG8_SCHED;
            PG8_STAGE(PG8_SB(0, 1), b2 + hstep, voffB);
            PG8_WAIT_V(6); PG8_BAR; PG8_MMA(1, 1, At, B1); PG8_BAR;
            PG8_LDB(B0, 1, 0); PG8_SCHED; PG8_LDA(At, 1, 0); PG8_STAGE(PG8_SA(0, 1), a2 + hstep, voffA);
            PG8_WAIT_L(8); PG8_BAR; PG8_WAIT_L(0); PG8_MMA(0, 0, At, B0); PG8_BAR; PG8_SCHED;
            PG8_LDB(B1, 1, 1); PG8_STAGE(PG8_SB(1, 0), b3, voffB);
            PG8_BAR; PG8_WAIT_L(0); PG8_MMA(0, 1, At, B1); PG8_BAR;
            PG8_LDA(At, 1, 1); PG8_STAGE(PG8_SA(1, 0), a3, voffA);
            PG8_BAR; PG8_WAIT_L(0); PG8_MMA(1, 0, At, B0); PG8_BAR; PG8_SCHED;
            PG8_STAGE(PG8_SB(1, 1), b3 + hstep, voffB);
            PG8_WAIT_V(6); PG8_BAR; PG8_MMA(1, 1, At, B1); PG8_BAR;
            }
        }
        if constexpr (ALIGN_EPI) { if (wr == 0) PG8_BAR; }
        if constexpr (!Epi::AFTER_DRAIN) { E(acc, cur, wr, wc, fr, fq); S.done(cur); }
        if (!has_next) break;
#pragma unroll
        for (int a = 0; a < 2; ++a)
#pragma unroll
            for (int b = 0; b < 2; ++b)
#pragma unroll
                for (int m = 0; m < 4; ++m)
#pragma unroll
                    for (int n = 0; n < 2; ++n) acc[a][b][m][n] = (f32x4){0.f, 0.f, 0.f, 0.f};
        cur = nxt; cA = nA; cB = nB; ++ui;
        if constexpr (ALIGN_EPI) { if (wr == 1) PG8_BAR; }
    }
    PG8_WAIT_V(0);
    if constexpr (!ALIGN_EPI) { if (wr == 0) PG8_BAR; }
    PG8_BAR;
    if constexpr (Epi::AFTER_DRAIN) { E.fused(acc, cur, wr, wc, fr, fq, lds, wid, lane); S.done(cur); }
#undef PG8_SA
#undef PG8_SB
#undef PG8_STAGE
#undef PG8_LDA
#undef PG8_LDB
#undef PG8_MMA
#undef PG8_WAIT_V
#undef PG8_WAIT_L
#undef PG8_BAR
#undef PG8_SCHED
}
}
constexpr int NB = 16, SEQ = 4096, T = NB * SEQ, DM = 1024, DEPTH = 4;
constexpr int MLA_N = 1792;
constexpr int DSA_N = 3328;
constexpr float NORM_EPS = 1e-6f;
constexpr int NPHASE = 22;

constexpr size_t MiB = 1u << 20;
constexpr size_t WS_CTL = 0, CTL_ZERO_BYTES = 1 * MiB;
constexpr size_t WS_W = 2 * MiB;
constexpr size_t W_WINM = 0, W_WUQ = W_WINM + 2ull * MLA_N * 1024, W_WUK = W_WUQ + 2ull * 1536 * 256, W_WUV = W_WUK + 2ull * 1024 * 256,
                 W_WOM = W_WUV + 2ull * 1024 * 256, W_WIND = W_WOM + 2ull * 1024 * 1024, W_WOD = W_WIND + 2ull * DSA_N * 1024,
                 W_WP = W_WOD + 2ull * 1024 * 1024, W_WG = W_WP + 4ull * 1024 * 256, W_END = W_WG + 4ull * 1024 * 1024;
static_assert(WS_W + W_END * 2 <= 46 * MiB, "weights");
constexpr size_t WS_ROPE64 = 48 * MiB, WS_ROPE32 = 80 * MiB;
constexpr size_t WS_RSX = 96 * MiB, WS_RS1 = 100 * MiB, WS_RSQ = 104 * MiB, WS_RSKV = 105 * MiB;
constexpr size_t WS_PB = 112 * MiB;
constexpr size_t WS_XB0 = 144 * MiB;
constexpr size_t WS_SZ = 272 * MiB;
constexpr size_t WS_CQ = 400 * MiB, WS_CKV = 432 * MiB, WS_KPE = 464 * MiB;
constexpr size_t WS_QI = 400 * MiB, WS_KI = 464 * MiB, WS_WI = 472 * MiB;
constexpr size_t WS_Q = 480 * MiB;
constexpr size_t WS_PP = 480 * MiB;
constexpr size_t WS_KN = 672 * MiB, WS_V = 800 * MiB;
constexpr size_t WS_KD = 672 * MiB, WS_VD = 704 * MiB, WS_MASK = 736 * MiB;
constexpr size_t WS_XB1 = 672 * MiB;
constexpr size_t WS_END = 928 * MiB;
constexpr int CW_BAR = 4096;

constexpr int RING_BYTES = 131072;
constexpr int LDS_QIS = 131072;
constexpr int MISC_OFF = 159744;
constexpr int LDS_BYTES = 159744 + 512;
constexpr int NWAVES = 8;

#define GAS __attribute__((address_space(1)))
#define LAS __attribute__((address_space(3)))
typedef unsigned short bf16;
typedef unsigned v4u __attribute__((ext_vector_type(4)));
typedef float f32x4 __attribute__((ext_vector_type(4)));
typedef short bf16x8 __attribute__((ext_vector_type(8)));
typedef GAS unsigned gu32;
#define LDS_WAIT() asm volatile("s_waitcnt lgkmcnt(0)" ::: "memory")
#define VM_WAIT() asm volatile("s_waitcnt vmcnt(0)" ::: "memory")
__device__ __forceinline__ unsigned f2bf(float f) { unsigned u = __builtin_bit_cast(unsigned, f); return (u + 0x7fffu + ((u >> 16) & 1u)) >> 16; }
#define XB_TMO      128
#define XB_XCNT(j)  (256  + 64 * (j))
#define XB_XSUB(j)  (1280 + 64 * (j))
#define XB_XGEN(j)  (2304 + 64 * (j))
#define XB_TOP      3328
#define XB_TOPGEN   3392
#define XCD_BAR_WORDS 3456
#define XB_SPIN_CAP (1u << 25)

__device__ __forceinline__ unsigned xb_ld(unsigned* p)              { return __hip_atomic_load(p, __ATOMIC_RELAXED, __HIP_MEMORY_SCOPE_AGENT); }
__device__ __forceinline__ unsigned xb_add(unsigned* p, unsigned v) { return __hip_atomic_fetch_add(p, v, __ATOMIC_RELAXED, __HIP_MEMORY_SCOPE_AGENT); }
__device__ __forceinline__ unsigned xb_xcc_id() { return (unsigned)__builtin_amdgcn_s_getreg((3 << 11) | 20) & 0xFu; }
#define XB_SPIN(cond, bar) do { unsigned _sp = 0; while (cond) { __builtin_amdgcn_s_sleep(1); \
    if ((++_sp & 255u) == 0u) { if (xb_ld(&(bar)[XB_TMO])) break; if (_sp > XB_SPIN_CAP) { atomicAdd(&(bar)[XB_TMO], 1u); break; } } } } while (0)

struct XcdBarrier {
    unsigned* bar; unsigned x;
    volatile LAS unsigned* st;
};

__device__ __forceinline__ XcdBarrier xcd_barrier_post(unsigned* bar, volatile LAS unsigned* st) {
    XcdBarrier b; b.bar = bar; b.x = xb_xcc_id(); b.st = st;
    if (threadIdx.x == 0) (void)xb_add(&bar[XB_XCNT(b.x)], 1u);
    return b;
}
__device__ __forceinline__ void xcd_barrier_complete(unsigned* bar, unsigned x, unsigned& nloc, unsigned& nx) {
    const unsigned G = gridDim.x * gridDim.y * gridDim.z;
    unsigned sum, cnt, mine, sp = 0u;
    for (;;) {
        sum = 0u; cnt = 0u; mine = 0u;
#pragma unroll
        for (unsigned j = 0; j < 16; ++j) { const unsigned c = xb_ld(&bar[XB_XCNT(j)]); sum += c; cnt += (c > 0u) ? 1u : 0u; mine = (j == x) ? c : mine; }
        if (sum == G) break;
        __builtin_amdgcn_s_sleep(1);
        if ((++sp & 255u) == 0u) { if (xb_ld(&bar[XB_TMO])) break; if (sp > XB_SPIN_CAP) { atomicAdd(&bar[XB_TMO], 1u); break; } }
    }
    nloc = mine > 0u ? mine : 1u; nx = cnt > 0u ? cnt : 1u;
}

__device__ __forceinline__ void xcd_barrier(const XcdBarrier& b) {
    asm volatile("s_waitcnt vmcnt(0)" ::: "memory");
    __syncthreads();
    if (threadIdx.x == 0) {
        unsigned* bar = b.bar;
        __builtin_amdgcn_s_waitcnt(0);
        unsigned nloc = b.st[0], nx = b.st[1];
        if (nloc == 0u) { xcd_barrier_complete(bar, b.x, nloc, nx); b.st[0] = nloc; b.st[1] = nx; }
        const unsigned old = xb_add(&bar[XB_XSUB(b.x)], 1u);
        const unsigned gen = old / nloc;
        if (old + 1u == (gen + 1u) * nloc) {
            __builtin_amdgcn_fence(__ATOMIC_RELEASE, "agent");
            asm volatile("s_waitcnt vmcnt(0)" ::: "memory");
            const unsigned og = xb_add(&bar[XB_TOP], 1u);
            const unsigned tg = og / nx;
            if (og + 1u == (tg + 1u) * nx) xb_add(&bar[XB_TOPGEN], 1u);
            else XB_SPIN(xb_ld(&bar[XB_TOPGEN]) == tg, bar);
            __builtin_amdgcn_fence(__ATOMIC_ACQUIRE, "agent");
            xb_add(&bar[XB_XGEN(b.x)], 1u);
            asm volatile("s_waitcnt vmcnt(0)" ::: "memory");
        } else {
            XB_SPIN(xb_ld(&bar[XB_XGEN(b.x)]) == gen, bar);
            __builtin_amdgcn_fence(__ATOMIC_ACQUIRE, "agent");
            asm volatile("s_waitcnt vmcnt(0)" ::: "memory");
        }
    }
    __syncthreads();
}


typedef unsigned u32x2 __attribute__((ext_vector_type(2)));
__device__ __forceinline__ float bf2f(unsigned h) { return __builtin_bit_cast(float, h << 16); }
typedef __bf16 bf16x2_t __attribute__((ext_vector_type(2)));
typedef float f32x2_t __attribute__((ext_vector_type(2)));
__device__ __forceinline__ unsigned cvtpk(float lo, float hi) { const f32x2_t v = {lo, hi}; return __builtin_bit_cast(unsigned, __builtin_convertvector(v, bf16x2_t)); }
__device__ __forceinline__ v4u pack8(f32x4 a, f32x4 b) { v4u w; w.x = cvtpk(a[0], a[1]); w.y = cvtpk(a[2], a[3]); w.z = cvtpk(b[0], b[1]); w.w = cvtpk(b[2], b[3]); return w; }
__device__ __forceinline__ float wave_sum(float v) {
#pragma unroll
    for (int o = 1; o < 64; o <<= 1) v += __shfl_xor(v, o);
    return v;
}
__device__ __forceinline__ float wave_max(float v) {
#pragma unroll
    for (int o = 1; o < 64; o <<= 1) v = fmaxf(v, __shfl_xor(v, o));
    return v;
}
__device__ __forceinline__ int wave_sum_i(int v) {
#pragma unroll
    for (int o = 1; o < 64; o <<= 1) v += __shfl_xor(v, o);
    return v;
}
__device__ __forceinline__ float sum16_rstd(const float* rs, int row, float invn) {
    const f32x4* p = (const f32x4*)(rs + (size_t)row * 16); const f32x4 a = p[0], b = p[1], c = p[2], d = p[3];
    const float s = ((a[0] + a[1]) + (a[2] + a[3])) + ((b[0] + b[1]) + (b[2] + b[3])) + ((c[0] + c[1]) + (c[2] + c[3])) + ((d[0] + d[1]) + (d[2] + d[3]));
    return rsqrtf(s * invn + NORM_EPS);
}
__device__ __forceinline__ float sum4_rstd(const float* rs, int row, float invn) {
    const f32x4 a = *(const f32x4*)(rs + (size_t)row * 4); return rsqrtf(((a[0] + a[1]) + (a[2] + a[3])) * invn + NORM_EPS);
}
__device__ __forceinline__ float silu_f(float v) { return v * __builtin_amdgcn_rcpf(1.f + __expf(-v)); }
__device__ __forceinline__ float sigmoid_f(float v) { return __builtin_amdgcn_rcpf(1.f + __expf(-v)); }
__device__ __forceinline__ float sq4(f32x4 v) { return (v[0] * v[0] + v[1] * v[1]) + (v[2] * v[2] + v[3] * v[3]); }
__device__ __forceinline__ void rope8(f32x4& v0, f32x4& v1, const f32x4 c0, const f32x4 c1) {
    f32x4 o0, o1;
    o0[0] = v0[0] * c0[0] - v0[1] * c0[1]; o0[1] = v0[1] * c0[0] + v0[0] * c0[1];
    o0[2] = v0[2] * c0[2] - v0[3] * c0[3]; o0[3] = v0[3] * c0[2] + v0[2] * c0[3];
    o1[0] = v1[0] * c1[0] - v1[1] * c1[1]; o1[1] = v1[1] * c1[0] + v1[0] * c1[1];
    o1[2] = v1[2] * c1[2] - v1[3] * c1[3]; o1[3] = v1[3] * c1[2] + v1[2] * c1[3];
    v0 = o0; v1 = o1;
}
typedef _Float16 f16x2_t __attribute__((ext_vector_type(2)));
__device__ __forceinline__ unsigned pack_cs(float c, float sn) { const f16x2_t h = {(_Float16)c, (_Float16)sn}; return __builtin_bit_cast(unsigned, h); }
__device__ __forceinline__ f16x2_t as_h2(unsigned u) { return __builtin_bit_cast(f16x2_t, u); }
__device__ __forceinline__ void rope8h(f32x4& v0, f32x4& v1, const v4u w) {
    f32x4 c0, c1;
#pragma unroll
    for (int e = 0; e < 2; ++e) { const f16x2_t a = as_h2(w[e]), b = as_h2(w[2 + e]);
        c0[2 * e] = (float)a[0]; c0[2 * e + 1] = (float)a[1]; c1[2 * e] = (float)b[0]; c1[2 * e + 1] = (float)b[1]; }
    rope8(v0, v1, c0, c1);
}


namespace att {
constexpr int NW = 8, QBLK = 32, KVBLK = 64, QB = NW * QBLK, D = 128;
constexpr int KROW = D * 2 + 16, SHM_V = KVBLK * D * 2, SHM_K = KVBLK * KROW, KPROW = 144, SHM_KP = KVBLK * KPROW;
constexpr int OFF_V = 0, OFF_K = 2 * SHM_V, OFF_WS = OFF_K + 2 * SHM_K, OFF_KP = OFF_WS + NW * 64 * 4, OFF_QP = OFF_KP + 2 * SHM_KP, LDS_NEED = OFF_QP + NW * QBLK * 272;
constexpr float THR = 8.f;
typedef short s16x4 __attribute__((ext_vector_type(4)));
typedef float f32x16 __attribute__((ext_vector_type(16)));

#define KSWZ(row, colB) ((row) * KROW + (colB))
#define KPSWZ(row, ch) ((row) * KPROW + ((ch) << 4))
#define SBAR() __builtin_amdgcn_sched_barrier(0)
__device__ __forceinline__ int v_st(int k, int c) { const int kk = (k & ~0xC) | ((k & 4) << 1) | ((k & 8) >> 1); return ((kk >> 3) * 4 + (c >> 5)) * 512 + ((kk & 7) * 32 + (c & 31)) * 2; }
__device__ __forceinline__ int v_rd_base(int lane) { return ((lane & 3) << 3) | (((lane >> 2) & 3) << 6) | (((lane >> 4) & 1) << 5) | (((lane >> 5) & 1) << 8); }
constexpr int v_rd_off(int d0, int ks, int half) { return d0 * 512 + ks * 4096 + half * 2048; }
__device__ __forceinline__ int crow(int r, int hi) { return (r & 3) + 8 * (r >> 2) + 4 * hi; }
__device__ __forceinline__ bf16x8 load8(const bf16* p) { return *reinterpret_cast<const bf16x8*>(p); }
__device__ __forceinline__ unsigned long long gld_u64(const unsigned long long* ubase, unsigned voff) {
    const unsigned long long b_ = (unsigned long long)ubase;
    const unsigned lo_ = __builtin_amdgcn_readfirstlane((unsigned)b_), hi_ = __builtin_amdgcn_readfirstlane((unsigned)(b_ >> 32));
    __amdgpu_buffer_rsrc_t r_ = __builtin_amdgcn_make_buffer_rsrc((void*)(((unsigned long long)hi_ << 32) | lo_), (short)0, 0x7fffffff, 0x00020000);
    typedef unsigned u32x2_ __attribute__((ext_vector_type(2)));
    const u32x2_ w_ = __builtin_amdgcn_raw_buffer_load_b64(r_, (int)voff, 0, 0); return ((unsigned long long)w_.y << 32) | w_.x; }
__device__ __forceinline__ bf16x8 gld8(const bf16* ubase, unsigned voff) {
    const unsigned long long b_ = (unsigned long long)ubase;
    const unsigned lo_ = __builtin_amdgcn_readfirstlane((unsigned)b_), hi_ = __builtin_amdgcn_readfirstlane((unsigned)(b_ >> 32));
    __amdgpu_buffer_rsrc_t r_ = __builtin_amdgcn_make_buffer_rsrc((void*)(((unsigned long long)hi_ << 32) | lo_), (short)0, 0x7fffffff, 0x00020000);
    const v4u w_ = __builtin_amdgcn_raw_buffer_load_b128(r_, (int)voff, 0, 0); return __builtin_bit_cast(bf16x8, w_); }

__device__ __forceinline__ unsigned selbits(unsigned m, int c) { unsigned t; asm("v_bfe_i32 %0, %1, %2, 1" : "=v"(t) : "v"(m), "n"(c)); return t; }
__device__ __forceinline__ void mask_tile(f32x16& p0, f32x16& p1, int dq) {
    const float NEG = -__builtin_inff();
#pragma unroll
    for (int r = 0; r < 16; ++r) {
        const int c = (r & 3) + 8 * (r >> 2);
        if (dq - c < 0) p0[r] = NEG;
        if (dq - c - 32 < 0) p1[r] = NEG;
    }
}
template <bool MASKED>
__device__ __forceinline__ void partialSM(f32x16& p0, f32x16& p1, float& m_reg, float& mn, float& alpha, const float SCALE, unsigned mlo) {
    float pmax = p0[0]; for (int r = 1; r < 16; ++r) pmax = fmaxf(pmax, p0[r]); for (int r = 0; r < 16; ++r) pmax = fmaxf(pmax, p1[r]);
    { auto rr = __builtin_amdgcn_permlane32_swap(__float_as_uint(pmax), __float_as_uint(pmax), false, false);
      pmax = fmaxf(__uint_as_float(rr[0]), __uint_as_float(rr[1])); }
    const float C2 = 1.4426950408889634f * SCALE;
    if (__builtin_expect(__all((pmax - m_reg) * SCALE <= THR), 1)) { mn = m_reg; alpha = 1.f; }
    else { mn = fmaxf(m_reg, pmax); alpha = __builtin_amdgcn_exp2f((m_reg - mn) * C2); m_reg = mn; }
    const float mnL = -mn * C2;
    for (int r = 0; r < 16; ++r) p0[r] = fmaf(p0[r], C2, mnL); for (int r = 0; r < 16; ++r) p1[r] = fmaf(p1[r], C2, mnL);
    for (int r = 0; r < 16; ++r) p0[r] = __builtin_amdgcn_exp2f(p0[r]);
    if (MASKED) {
#pragma unroll
        for (int r = 0; r < 16; ++r) { const int c = (r & 3) + 8 * (r >> 2); p0[r] = __uint_as_float(__float_as_uint(p0[r]) & selbits(mlo, c)); }
    }
}
template <bool MASKED>
__device__ __forceinline__ void finishSM(f32x16& p0, f32x16& p1, float alpha, float& l_reg, bf16x8& pa0, bf16x8& pa1, bf16x8& pa2, bf16x8& pa3, unsigned mhi) {
    for (int r = 0; r < 16; ++r) p1[r] = __builtin_amdgcn_exp2f(p1[r]);
    if (MASKED) {
#pragma unroll
        for (int r = 0; r < 16; ++r) { const int c = (r & 3) + 8 * (r >> 2); p1[r] = __uint_as_float(__float_as_uint(p1[r]) & selbits(mhi, c)); }
    }
    float ps = 0; for (int r = 0; r < 16; ++r) ps += p0[r]; for (int r = 0; r < 16; ++r) ps += p1[r];
    { auto rr = __builtin_amdgcn_permlane32_swap(__float_as_uint(ps), __float_as_uint(ps), false, false);
      ps = __uint_as_float(rr[0]) + __uint_as_float(rr[1]); }
    l_reg = l_reg * alpha + ps;
#define PK4(P, B_, OUT) do { unsigned a0 = cvtpk(P[B_+0], P[B_+1]), a1 = cvtpk(P[B_+2], P[B_+3]);                          \
        unsigned b0 = cvtpk(P[B_+4], P[B_+5]), b1 = cvtpk(P[B_+6], P[B_+7]);                                             \
        auto r0 = __builtin_amdgcn_permlane32_swap(a0, b0, false, false); auto r1 = __builtin_amdgcn_permlane32_swap(a1, b1, false, false); \
        v4u w = {r0[0], r1[0], r0[1], r1[1]}; OUT = *reinterpret_cast<bf16x8*>(&w); } while (0)
    PK4(p0, 0, pa0); PK4(p0, 8, pa1); PK4(p1, 0, pa2); PK4(p1, 8, pa3);
#undef PK4
}
template <int KB, bool PE>
__device__ __forceinline__ void qkt(f32x16& p0, f32x16& p1, const char* lds, int r32, int hi, const bf16x8* qr, int kpb, int qpb) {
    p0 = f32x16{}; p1 = f32x16{};
    const char* kb[4];
#pragma unroll
    for (int dd = 0; dd < 4; ++dd) kb[dd] = lds + OFF_K + KB * SHM_K + KSWZ(r32, (dd * 16 + hi * 8) * 2);
    const char* qp_ = lds + qpb;
#pragma unroll
    for (int d0 = 0; d0 < 8; ++d0) { const char* a = kb[d0 & 3] + (d0 >> 2) * 128;
        bf16x8 b0 = *reinterpret_cast<const bf16x8*>(a);
        bf16x8 b1 = *reinterpret_cast<const bf16x8*>(a + 32 * KROW);
        bf16x8 qf; if (d0 >= 4) qf = *reinterpret_cast<const bf16x8*>(qp_ + (d0 - 4) * 32); else qf = qr[d0];
        p0 = __builtin_amdgcn_mfma_f32_32x32x16_bf16(b0, qf, p0, 0, 0, 0);
        p1 = __builtin_amdgcn_mfma_f32_32x32x16_bf16(b1, qf, p1, 0, 0, 0); }
    if (PE) {
        const char* kp_ = lds + kpb;
#pragma unroll
        for (int d0 = 0; d0 < 4; ++d0) {
            bf16x8 b0 = *reinterpret_cast<const bf16x8*>(kp_ + (KB * SHM_KP + d0 * 32));
            bf16x8 b1 = *reinterpret_cast<const bf16x8*>(kp_ + (KB * SHM_KP + d0 * 32 + 32 * KPROW));
            const bf16x8 qf = *reinterpret_cast<const bf16x8*>(qp_ + 128 + d0 * 32);
            p0 = __builtin_amdgcn_mfma_f32_32x32x16_bf16(b0, qf, p0, 0, 0, 0);
            p1 = __builtin_amdgcn_mfma_f32_32x32x16_bf16(b1, qf, p1, 0, 0, 0); }
    }
}
template <int VB>
__device__ __forceinline__ void pv_tile(f32x16* o, int vb0, bf16x8 pa0, bf16x8 pa1, bf16x8 pa2, bf16x8 pa3) {
#define TRRD(dst, off) asm volatile("ds_read_b64_tr_b16 %0, %1 offset:%2" : "=&v"(dst) : "v"(vb0), "i"(off) : "memory")
#define PV_D0(d0) do { s16x4 l0, l1, l2, l3, h0, h1, h2, h3; constexpr int b_ = OFF_V + VB * SHM_V + v_rd_off(d0, 0, 0); \
        TRRD(l0, b_); TRRD(h0, b_ + 2048); TRRD(l1, b_ + 4096); TRRD(h1, b_ + 6144); TRRD(l2, b_ + 8192); TRRD(h2, b_ + 10240); TRRD(l3, b_ + 12288); TRRD(h3, b_ + 14336); \
        asm volatile("s_waitcnt lgkmcnt(0)" ::: "memory"); SBAR();   \
        o[d0] = __builtin_amdgcn_mfma_f32_32x32x16_bf16(pa0, (bf16x8){l0[0], l0[1], l0[2], l0[3], h0[0], h0[1], h0[2], h0[3]}, o[d0], 0, 0, 0);   \
        o[d0] = __builtin_amdgcn_mfma_f32_32x32x16_bf16(pa1, (bf16x8){l1[0], l1[1], l1[2], l1[3], h1[0], h1[1], h1[2], h1[3]}, o[d0], 0, 0, 0);   \
        o[d0] = __builtin_amdgcn_mfma_f32_32x32x16_bf16(pa2, (bf16x8){l2[0], l2[1], l2[2], l2[3], h2[0], h2[1], h2[2], h2[3]}, o[d0], 0, 0, 0);   \
        o[d0] = __builtin_amdgcn_mfma_f32_32x32x16_bf16(pa3, (bf16x8){l3[0], l3[1], l3[2], l3[3], h3[0], h3[1], h3[2], h3[3]}, o[d0], 0, 0, 0); } while (0)
    PV_D0(0); PV_D0(1); PV_D0(2); PV_D0(3);
#undef PV_D0
#undef TRRD
}

template <int VB, bool MASKED>
__device__ __forceinline__ void pv_sm(f32x16* o, int vb0, bf16x8 pa0, bf16x8 pa1, bf16x8 pa2, bf16x8 pa3,
                                      f32x16& p0, f32x16& p1, float& m_reg, float& mn, float& alpha, const float SCALE, unsigned mlo) {
#define TRRD(dst, off) asm volatile("ds_read_b64_tr_b16 %0, %1 offset:%2" : "=&v"(dst) : "v"(vb0), "i"(off) : "memory")
#define PVS_LD(d0) s16x4 l0, l1, l2, l3, h0, h1, h2, h3; { constexpr int b_ = OFF_V + VB * SHM_V + v_rd_off(d0, 0, 0); \
        TRRD(l0, b_); TRRD(h0, b_ + 2048); TRRD(l1, b_ + 4096); TRRD(h1, b_ + 6144); TRRD(l2, b_ + 8192); TRRD(h2, b_ + 10240); TRRD(l3, b_ + 12288); TRRD(h3, b_ + 14336); \
        asm volatile("s_waitcnt lgkmcnt(0)" ::: "memory"); SBAR(); }
#define PVS_MM(d0) do { \
        o[d0] = __builtin_amdgcn_mfma_f32_32x32x16_bf16(pa0, (bf16x8){l0[0], l0[1], l0[2], l0[3], h0[0], h0[1], h0[2], h0[3]}, o[d0], 0, 0, 0);   \
        o[d0] = __builtin_amdgcn_mfma_f32_32x32x16_bf16(pa1, (bf16x8){l1[0], l1[1], l1[2], l1[3], h1[0], h1[1], h1[2], h1[3]}, o[d0], 0, 0, 0);   \
        o[d0] = __builtin_amdgcn_mfma_f32_32x32x16_bf16(pa2, (bf16x8){l2[0], l2[1], l2[2], l2[3], h2[0], h2[1], h2[2], h2[3]}, o[d0], 0, 0, 0);   \
        o[d0] = __builtin_amdgcn_mfma_f32_32x32x16_bf16(pa3, (bf16x8){l3[0], l3[1], l3[2], l3[3], h3[0], h3[1], h3[2], h3[3]}, o[d0], 0, 0, 0); } while (0)
#define PVS_SGB(nv) do { _Pragma("unroll") for (int g_ = 0; g_ < 4; ++g_) { __builtin_amdgcn_sched_group_barrier(0x008, 1, 0); __builtin_amdgcn_sched_group_barrier(0x402, nv, 0); } } while (0)
    const float C2 = 1.4426950408889634f * SCALE;
    float pmax, mnL;
    { PVS_LD(0); PVS_MM(0);
      float pm0 = p0[0], pm1 = p1[0];
#pragma unroll
      for (int r = 1; r < 16; ++r) { pm0 = fmaxf(pm0, p0[r]); pm1 = fmaxf(pm1, p1[r]); }
      pmax = fmaxf(pm0, pm1);
      { auto rr = __builtin_amdgcn_permlane32_swap(__float_as_uint(pmax), __float_as_uint(pmax), false, false);
        pmax = fmaxf(__uint_as_float(rr[0]), __uint_as_float(rr[1])); }
      PVS_SGB(5); }
    { PVS_LD(1); PVS_MM(1);
      const bool keep = __all((pmax - m_reg) * SCALE <= THR);
      mn = keep ? m_reg : fmaxf(m_reg, pmax); alpha = keep ? 1.f : __builtin_amdgcn_exp2f((m_reg - mn) * C2); m_reg = mn;
      mnL = -mn * C2;
#pragma unroll
      for (int r = 0; r < 16; ++r) p0[r] = fmaf(p0[r], C2, mnL);
      PVS_SGB(7); }
    { PVS_LD(2); PVS_MM(2);
#pragma unroll
      for (int r = 0; r < 16; ++r) p1[r] = fmaf(p1[r], C2, mnL);
#pragma unroll
      for (int r = 0; r < 6; ++r) p0[r] = __builtin_amdgcn_exp2f(p0[r]);
      PVS_SGB(6); }
    { PVS_LD(3); PVS_MM(3);
#pragma unroll
      for (int r = 6; r < 16; ++r) p0[r] = __builtin_amdgcn_exp2f(p0[r]);
      if (MASKED) {
#pragma unroll
          for (int r = 0; r < 16; ++r) { const int c = (r & 3) + 8 * (r >> 2); p0[r] = __uint_as_float(__float_as_uint(p0[r]) & selbits(mlo, c)); }
      }
      asm volatile("" : "+v"(p0), "+v"(p1));
      PVS_SGB(MASKED ? 8 : 3); }
#undef PVS_LD
#undef PVS_MM
#undef PVS_SGB
#undef TRRD
}

struct BlockRef { const bf16* Q; const bf16* K; const bf16* V; const bf16* KP; bf16* O; const unsigned long long* M; int P0; };
template <bool PE> struct Seam { bf16x8 qr[4]; bf16x8 qx[PE ? 8 : 4]; bf16x8 st_v0, st_v1, st_k0, st_k1, st_kp; };

#define VMW() asm volatile("s_waitcnt vmcnt(0)" ::: "memory")
#define VMWN(n) asm volatile("s_waitcnt vmcnt(%0)" :: "i"(n) : "memory")
#define SLOAD_H(Kp, Vp, KPp, k0) do { S.st_v0 = gld8((Vp) + (size_t)(k0) * LDV, voffkv); S.st_v1 = gld8((Vp) + (size_t)((k0) + 32) * LDV, voffkv);     \
                         S.st_k0 = gld8((Kp) + (size_t)(k0) * LDK, voffkv); S.st_k1 = gld8((Kp) + (size_t)((k0) + 32) * LDK, voffkv);                       \
                         if (PE) S.st_kp = gld8((KPp) + (size_t)(k0) * 64, voffkp); } while (0)
#define SWRITE_HK(bf) do { *(bf16x8*)(lds + OFF_K + (bf) * SHM_K + kws) = S.st_k0; *(bf16x8*)(lds + OFF_K + (bf) * SHM_K + kws + 32 * KROW) = S.st_k1;   \
                           if (PE) *(bf16x8*)(lds + kpws + (bf) * SHM_KP) = S.st_kp; } while (0)
#define SWRITE_HV(bf) do { *(bf16x8*)(lds + OFF_V + (bf) * SHM_V + vst0) = S.st_v0; *(bf16x8*)(lds + OFF_V + (bf) * SHM_V + vst1) = S.st_v1; } while (0)
#define SWRITE_H(bf) do { SWRITE_HV(bf); SWRITE_HK(bf); } while (0)
#define QLOAD(ref) do { _Pragma("unroll") for (int d0 = 0; d0 < 4; ++d0) S.qr[d0] = gld8((ref).Q + d0 * 16, voffq); } while (0)
#define QXLOAD(ref) do { _Pragma("unroll") for (int c_ = 0; c_ < QX / 16; ++c_) S.qx[c_] = gld8((ref).Q + (size_t)(c_ * (512 / QX)) * LDQ, voffqx); } while (0)
#define QXWRITE() do { _Pragma("unroll") for (int c_ = 0; c_ < QX / 16; ++c_) *(bf16x8*)(lds + qxw + c_ * (512 / QX) * QXROW) = S.qx[c_]; } while (0)

#define ATT_LANE_CONSTS \
    constexpr int QX = PE ? 128 : 64, QXROW = 2 * QX + 16, SHM_QP = QBLK * QXROW, CPR = QX / 8;                                                  \
    const int tid = threadIdx.x, wid = __builtin_amdgcn_readfirstlane(tid >> 6), lane = tid & 63, r32 = lane & 31, hi = lane >> 5;             \
    const int sr = tid >> 4, sc = (tid & 15) * 8, kws = KSWZ(sr, sc * 2), kpws = OFF_KP + KPSWZ(tid >> 3, tid & 7);                            \
    const unsigned voffkv = (unsigned)(sr * LDK + sc) * 2u, voffkp = (unsigned)((tid >> 3) * 64 + (tid & 7) * 8) * 2u;                          \
    const unsigned voffq = (unsigned)((wid * QBLK + r32) * LDQ + hi * 8) * 2u, voffqx = (unsigned)((wid * QBLK + lane / CPR) * LDQ + 64 + (lane % CPR) * 8) * 2u; \
    const int qxw = OFF_QP + wid * SHM_QP + (lane / CPR) * QXROW + (lane % CPR) * 16;
template <bool PE, bool MASKED, int LDQ, int LDK, int LDV>
__device__ __forceinline__ void attn_prime(const BlockRef& cur, char* lds, Seam<PE>& S) {
    static_assert(LDK == LDV, "k and v share the staging offset");
    ATT_LANE_CONSTS
    (void)kws; (void)kpws; (void)qxw; (void)r32; (void)hi;
    QLOAD(cur); QXLOAD(cur);
    SLOAD_H(cur.K, cur.V, cur.KP, 0); VMW(); SWRITE_HK(0);
    __syncthreads();
}
template <bool PE, bool MASKED, int LDQ, int LDK, int LDV, bool DRY>
__device__ __forceinline__ void attn_block(const BlockRef& cur, const BlockRef& nxt, char* lds, Seam<PE>& S, const float SCALE, const bool rdry, const float* psrc, bf16* pdst, const int kblk) {
    ATT_LANE_CONSTS
    const int NT = (cur.P0 + QB - 1) / KVBLK + 1;
    const int qlo = cur.P0 + wid * QBLK, qm = qlo + r32 - 4 * hi;
    float* ws = (float*)(lds + OFF_WS) + wid * 64; float* li_l = ws, * al_l = ws + 32;
    float m_reg = -1e30f, l_reg = 0; f32x16 o[4] = {};
    const int vst0 = v_st(sr, sc), vst1 = v_st(32 + sr, sc);
    const int vb0 = (int)(uintptr_t)lds + v_rd_base(lane);
    const int kpb = OFF_KP + r32 * KPROW + hi * 16, qpb = OFF_QP + wid * SHM_QP + r32 * QXROW + hi * 16 - (PE ? 0 : 0);
    const bf16* Kh = cur.K; const bf16* Vh = cur.V; const bf16* KPh = cur.KP;
    const unsigned voffm = (unsigned)(wid * QBLK + r32) * 512u;
#define RESC(a) do { if (__any((a) < 1.f)) { if (hi == 0) al_l[r32] = (a); asm volatile("s_waitcnt lgkmcnt(0)" ::: "memory");              \
                     for (int d_ = 0; d_ < 4; ++d_) for (int r = 0; r < 16; ++r) o[d_][r] *= al_l[crow(r, hi)]; } } while (0)
#define KBASE(t) ((t) * KVBLK)
#define MASKT(P0_, P1_, t) do { if (!MASKED) { const int kb_ = KBASE(t); if (kb_ + KVBLK - 1 > qlo) mask_tile(P0_, P1_, qm - kb_); } } while (0)
#define MLOAD(mw, t) do { if (MASKED) mw = gld_u64(cur.M + (t), voffm); } while (0)
#define MLO(mw) ((unsigned)(mw) >> (4 * hi))
#define MHI(mw) ((unsigned)((mw) >> 32) >> (4 * hi))
    constexpr int NQL = 4;
#define SEAM_K0() do { VMWN(NQL); SWRITE_HK(0); SBAR(); } while (0)
    f32x16 pA0, pA1, pB0, pB1; float mnA, mnB, alA, alB; bf16x8 pa0, pa1, pa2, pa3; unsigned long long mwA = 0, mwB = 0;
    QXWRITE(); SWRITE_HV(0); SBAR();
    if (NT > 1) SLOAD_H(Kh, Vh, KPh, KBASE(1));
    MLOAD(mwA, 0);
    SBAR(); qkt<0, PE>(pA0, pA1, lds, r32, hi, S.qr, kpb, qpb);
    MASKT(pA0, pA1, 0); partialSM<MASKED>(pA0, pA1, m_reg, mnA, alA, SCALE, MLO(mwA));
    if (NT > 1) { VMW(); SWRITE_H(1); }
    __syncthreads();
#define SGB_(mask, n) __builtin_amdgcn_sched_group_barrier(mask, n, 0)
#define SGB_STEP(nrd, nva) do { SGB_(0x100, nrd); SGB_(0x008, 1); SGB_(0x402, nva); SGB_(0x008, 1); SGB_(0x402, nva); } while (0)
#define SGB_QK_FIN() do { constexpr int NV_ = MASKED ? 6 : 3; SGB_(0x100, 2);                                              \
        SGB_STEP(2, NV_); SGB_STEP(2, NV_); SGB_STEP(2, NV_); SGB_STEP(3, NV_); SGB_STEP(3, NV_); SGB_STEP(3, NV_); SGB_STEP(3, NV_);                      \
        if (PE) { SGB_STEP(3, NV_); SGB_STEP(3, NV_); SGB_STEP(3, NV_); SGB_STEP(3, NV_); SGB_STEP(0, NV_); } else SGB_STEP(0, NV_); } while (0)
#define HALF_STEP(PX0, PX1, mnX, alX, mwX, PY0, PY1, alY, mwY, t, KB, VB, SB) do {                                            \
        SBAR(); MLOAD(mwX, t); qkt<KB, PE>(PX0, PX1, lds, r32, hi, S.qr, kpb, qpb);                                                \
        finishSM<MASKED>(PY0, PY1, alY, l_reg, pa0, pa1, pa2, pa3, MHI(mwY)); SGB_QK_FIN(); SBAR();                            \
        if ((t) + 1 < NT) { SLOAD_H(Kh, Vh, KPh, KBASE((t) + 1)); SBAR(); }                                                    \
        MASKT(PX0, PX1, (t)); SBAR(); pv_sm<VB, MASKED>(o, vb0, pa0, pa1, pa2, pa3, PX0, PX1, m_reg, mnX, alX, SCALE, MLO(mwX));                   \
        __syncthreads();                                                                                                      \
        if ((t) + 1 < NT) { VMW(); SWRITE_H(SB); }                                                                            \
        RESC(alX); __syncthreads(); } while (0)
    for (int t = 1; t + 1 < NT; t += 2) {
        HALF_STEP(pB0, pB1, mnB, alB, mwB, pA0, pA1, alA, mwA, t, 1, 0, 0);
        HALF_STEP(pA0, pA1, mnA, alA, mwA, pB0, pB1, alB, mwB, t + 1, 0, 1, 1);
    }
    const bool even = (NT & 1) == 0;
    (void)even;
    MLOAD(mwB, NT - 1);
    SBAR();
    const unsigned voffg = (unsigned)((wid * QBLK + (lane >> 4)) * 1024 + (lane & 15) * 8) * 2u;
    bf16x8 szq[8];
#pragma unroll
    for (int j = 0; j < 8; ++j) szq[j] = gld8(cur.O + (size_t)(4 * j) * 1024, voffg);
    constexpr size_t PNCH = (size_t)NB * 4096 * 256 / 8;
    f32x4 pcv[2][2]; size_t pcc[2];
    { const size_t gth_ = (size_t)gridDim.x * (NW * 64), gid_ = (size_t)blockIdx.x * (NW * 64) + tid;
#pragma unroll
      for (int u = 0; u < 2; ++u) { const size_t c_ = (size_t)(kblk * 2 + u) * gth_ + gid_; pcc[u] = c_; const size_t cl_ = c_ < PNCH ? c_ : PNCH - 1;
          pcv[u][0] = *(const f32x4*)(psrc + cl_ * 8); pcv[u][1] = *(const f32x4*)(psrc + cl_ * 8 + 4); } }
    SBAR(); qkt<1, PE>(pB0, pB1, lds, r32, hi, S.qr, kpb, qpb);
    finishSM<MASKED>(pA0, pA1, alA, l_reg, pa0, pa1, pa2, pa3, MHI(mwA)); SGB_QK_FIN(); SBAR();
    MASKT(pB0, pB1, NT - 1); SBAR(); pv_sm<0, MASKED>(o, vb0, pa0, pa1, pa2, pa3, pB0, pB1, m_reg, mnB, alB, SCALE, MLO(mwB));
    SBAR(); SLOAD_H(nxt.K, nxt.V, nxt.KP, 0); SBAR();
    QLOAD(nxt);
    SBAR();
    __syncthreads(); RESC(alB);
    finishSM<MASKED>(pB0, pB1, alB, l_reg, pa0, pa1, pa2, pa3, MHI(mwB)); SBAR();
    pv_tile<1>(o, vb0, pa0, pa1, pa2, pa3);
    SBAR(); SEAM_K0(); QXLOAD(nxt); SBAR();
    if (hi == 0) li_l[r32] = l_reg; asm volatile("s_waitcnt lgkmcnt(0)" ::: "memory");
    float rli[16];
#pragma unroll
    for (int r = 0; r < 16; ++r) rli[r] = __builtin_amdgcn_rcpf(li_l[crow(r, hi)]);
    char* stg = lds + OFF_QP + wid * (QBLK * 272) + (4 * hi) * 272 + r32 * 2;
#pragma unroll
    for (int d0 = 0; d0 < 4; ++d0)
#pragma unroll
        for (int r = 0; r < 16; r += 2) { const unsigned w = cvtpk(o[d0][r] * rli[r], o[d0][r + 1] * rli[r + 1]);
            *(unsigned short*)(stg + ((r & 3) + 8 * (r >> 2)) * 272 + d0 * 64) = (unsigned short)w;
            *(unsigned short*)(stg + (((r + 1) & 3) + 8 * ((r + 1) >> 2)) * 272 + d0 * 64) = (unsigned short)(w >> 16); }
    asm volatile("s_waitcnt lgkmcnt(0)" ::: "memory");
    const char* strd = lds + OFF_QP + wid * (QBLK * 272) + (lane >> 4) * 272 + (lane & 15) * 16;
#pragma unroll
    for (int j = 0; j < 8; ++j) { const v4u ow = *(const v4u*)(strd + (4 * j) * 272); const v4u zw = __builtin_bit_cast(v4u, szq[j]); v4u gw;
#pragma unroll
        for (int e = 0; e < 4; ++e) gw[e] = cvtpk(__uint_as_float(ow[e] << 16) * __uint_as_float(zw[e] << 16), __uint_as_float(ow[e] & 0xffff0000u) * __uint_as_float(zw[e] & 0xffff0000u));
        v4u* gp = (v4u*)((char*)(cur.O + (size_t)(4 * j) * 1024) + voffg);
        if (!DRY && !rdry) *gp = gw; else asm volatile("" :: "v"(gw)); }
#pragma unroll
    for (int u = 0; u < 2; ++u) { const v4u pw = pack8(pcv[u][0], pcv[u][1]); if (pcc[u] < PNCH) *(v4u*)(pdst + pcc[u] * 8) = pw; }
    __syncthreads();
#undef RESC
#undef KBASE
#undef MASKT
#undef MLOAD
#undef MLO
#undef MHI
#undef SEAM_K0
#undef HALF_STEP
}
#undef VMW
#undef VMWN
#undef SLOAD_H
#undef SWRITE_HK
#undef SWRITE_HV
#undef SWRITE_H
#undef QLOAD
#undef QXLOAD
#undef QXWRITE

struct Item { int bh, qb0, qb1; };
__device__ __forceinline__ Item decode(int L, int nhkv) {
    const int Gq = 8 / nhkv, xcd = L & 7, k = L >> 3, per = Gq * 8, gi = k / per, r = k - gi * per;
    Item it; it.bh = (gi * 8 + xcd) * Gq + r / 8; const int x = r % 8; it.qb0 = x; it.qb1 = 15 - x; return it;
}
template <bool PE, bool MASKED, int LDQ, int QH, int LDK, int LDV, int NHKV>
__device__ __forceinline__ BlockRef make_ref(const Item& it, int pass, const bf16* Q, const bf16* K, const bf16* V, const bf16* KP, bf16* O, const unsigned long long* M) {
    const int qb = pass ? it.qb1 : it.qb0, b = it.bh >> 3, h = it.bh & 7, hk = h / (8 / NHKV); const size_t tok0 = (size_t)b * SEQ + (size_t)qb * QB;
    BlockRef r; r.Q = Q + tok0 * LDQ + h * QH; r.K = K + (size_t)b * SEQ * LDK + hk * 128; r.V = V + (size_t)b * SEQ * LDV + hk * 128; r.KP = PE ? KP + (size_t)b * SEQ * 64 : nullptr;
    r.O = O + tok0 * 1024 + h * 128; r.M = MASKED ? M + tok0 * 64 : nullptr; r.P0 = qb * QB; return r;
}
template <bool PE, bool MASKED, int LDQ, int QH, int LDK, int LDV, int NHKV, bool DRY = false>
__device__ __forceinline__ void attn_phase(char* lds, const bf16* Q, const bf16* K, const bf16* V, const bf16* KP, bf16* O, const unsigned long long* M, const float SCALE, const float* psrc, bf16* pdst, const bool rdry = false) {
    const int total = 8 * NB * 8, stride = gridDim.x;
    int L = blockIdx.x; if (L >= total) return;
    if (__builtin_amdgcn_readfirstlane((int)threadIdx.x) >= 256) __builtin_amdgcn_s_setprio(1);
    Item it = decode(L, NHKV); int pass = 0, kblk = 0;
    BlockRef cur = make_ref<PE, MASKED, LDQ, QH, LDK, LDV, NHKV>(it, 0, Q, K, V, KP, O, M);
    Seam<PE> S;
    attn_prime<PE, MASKED, LDQ, LDK, LDV>(cur, lds, S);
    for (;;) {
        const bool more_pass = pass == 0, more_item = L + stride < total, last = !more_pass && !more_item;
        Item itn = it; int passn = pass + 1, Ln = L;
        if (!more_pass) { passn = 0; Ln = more_item ? L + stride : L; itn = decode(Ln, NHKV); }
        const BlockRef nxt = last ? cur : make_ref<PE, MASKED, LDQ, QH, LDK, LDV, NHKV>(itn, passn, Q, K, V, KP, O, M);
        attn_block<PE, MASKED, LDQ, LDK, LDV, DRY>(cur, nxt, lds, S, SCALE, rdry, psrc, pdst, kblk); ++kblk;
        if (last) break;
        cur = nxt; it = itn; pass = passn; L = Ln;
    }
    __builtin_amdgcn_s_setprio(0);
    { constexpr size_t PNCH = (size_t)NB * 4096 * 256 / 8; const size_t gth_ = (size_t)gridDim.x * (NW * 64);
      for (size_t c_ = (size_t)kblk * 2 * gth_ + (size_t)blockIdx.x * (NW * 64) + threadIdx.x; c_ < PNCH; c_ += gth_) {
          const f32x4 a_ = *(const f32x4*)(psrc + c_ * 8), b_ = *(const f32x4*)(psrc + c_ * 8 + 4); *(v4u*)(pdst + c_ * 8) = pack8(a_, b_); } }
}
#undef KSWZ
#undef KPSWZ
#undef SBAR
}
#define EPI_ROWS _Pragma("unroll") for (int ai = 0; ai < 2; ++ai) _Pragma("unroll") for (int m = 0; m < 4; ++m)
#define EPI_ROW (u.pm * 256 + ai * 128 + wr * 64 + m * 16 + fr)
#define EPI_FENCE() __builtin_amdgcn_sched_barrier(0)
__device__ __forceinline__ __amdgpu_buffer_rsrc_t epi_rsrc(const void* ubase) {
    const unsigned long long b_ = (unsigned long long)ubase;
    const unsigned lo_ = __builtin_amdgcn_readfirstlane((unsigned)b_), hi_ = __builtin_amdgcn_readfirstlane((unsigned)(b_ >> 32));
    return __builtin_amdgcn_make_buffer_rsrc((void*)(((unsigned long long)hi_ << 32) | lo_), (short)0, 0x7fffffff, 0x00020000); }
__device__ __forceinline__ v4u epi_ld16(__amdgpu_buffer_rsrc_t r, unsigned voff) { return __builtin_amdgcn_raw_buffer_load_b128(r, (int)voff, 0, 0); }
typedef const f32x4 (&AccRef)[2][2][4][2];
template <int NP>
__device__ __forceinline__ void wave_rstd(const float* rs, int pm, int wr, int fr, int fq, float invn, float (&out)[2][4]) {
    const int l = fq * 16 + fr; float r2[2];
#pragma unroll
    for (int ai = 0; ai < 2; ++ai) { const int row = pm * 256 + ai * 128 + wr * 64 + l; float s;
        if (NP == 16) { const f32x4* p = (const f32x4*)(rs + (size_t)row * 16); const f32x4 a = p[0], b = p[1], c = p[2], d = p[3];
            s = ((a[0] + a[1]) + (a[2] + a[3])) + ((b[0] + b[1]) + (b[2] + b[3])) + ((c[0] + c[1]) + (c[2] + c[3])) + ((d[0] + d[1]) + (d[2] + d[3])); }
        else { const f32x4 a = *(const f32x4*)(rs + (size_t)row * 4); s = (a[0] + a[1]) + (a[2] + a[3]); }
        r2[ai] = rsqrtf(s * invn + NORM_EPS); }
#pragma unroll
    for (int ai = 0; ai < 2; ++ai)
#pragma unroll
        for (int m = 0; m < 4; ++m) out[ai][m] = __shfl(r2[ai], m * 16 + fr);
}

struct RstdHalf { f32x4 a, b, c, d; };
__device__ __forceinline__ void rstd_half_issue(const float* rs, int pm, int wr, int fr, int fq, int ai, RstdHalf& h) {
    const int l = fq * 16 + fr; const f32x4* p = (const f32x4*)(rs + (size_t)(pm * 256 + ai * 128 + wr * 64 + l) * 16); h.a = p[0]; h.b = p[1]; h.c = p[2]; h.d = p[3]; }
__device__ __forceinline__ void rstd_half_finish(const RstdHalf& h, int fr, float invn, float (&out)[4]) {
    const float s_ = ((h.a[0] + h.a[1]) + (h.a[2] + h.a[3])) + ((h.b[0] + h.b[1]) + (h.b[2] + h.b[3])) + ((h.c[0] + h.c[1]) + (h.c[2] + h.c[3])) + ((h.d[0] + h.d[1]) + (h.d[2] + h.d[3]));
    const float r2 = rsqrtf(s_ * invn + NORM_EPS);
#pragma unroll
    for (int m = 0; m < 4; ++m) out[m] = __shfl(r2, m * 16 + fr); }

struct EpiMlaIn {
    static constexpr bool PERM = true, AFTER_DRAIN = false;
    const float* rsx; bf16* cq; bf16* ckv; bf16* sz; bf16* kpe; float* rsq; float* rskv; const unsigned* rope32;
    __device__ __forceinline__ void operator()(AccRef acc, const pg8::Unit& u, int wr, int wc, int fr, int fq) const {
        const int pn = u.pn; float rst[2][4]; wave_rstd<16>(rsx, u.pm, wr, fr, fq, 1.f / 1024.f, rst);
        if (pn < 2) { bf16* dst = pn == 0 ? cq : ckv; float* rs = pn == 0 ? rsq : rskv;
            EPI_ROWS { const int row = EPI_ROW; const float rstd = rst[ai][m]; float ss = 0.f;
#pragma unroll
                for (int bj = 0; bj < 2; ++bj) { const f32x4 v0 = acc[ai][bj][m][0] * rstd, v1 = acc[ai][bj][m][1] * rstd; ss += sq4(v0) + sq4(v1);
                    *(v4u*)(dst + (size_t)row * 256 + bj * 128 + wc * 32 + fq * 8) = pack8(v0, v1); }
                ss += __shfl_xor(ss, 16); ss += __shfl_xor(ss, 32);
                if (fq == 0) rs[(size_t)row * 4 + wc] = ss; }
        } else if (pn < 6) {
            EPI_ROWS { const int row = EPI_ROW; const float rstd = rst[ai][m];
#pragma unroll
                for (int bj = 0; bj < 2; ++bj) { f32x4 v0 = acc[ai][bj][m][0] * rstd, v1 = acc[ai][bj][m][1] * rstd;
#pragma unroll
                    for (int e = 0; e < 4; ++e) { v0[e] = silu_f(v0[e]); v1[e] = silu_f(v1[e]); }
                    *(v4u*)(sz + (size_t)row * 1024 + (pn - 2) * 256 + bj * 128 + wc * 32 + fq * 8) = pack8(v0, v1); } }
        } else if (wc < 2) {
            const int c = wc * 32 + fq * 8;
#pragma unroll
            for (int ai = 0; ai < 2; ++ai)
            { v4u cs[4];
#pragma unroll
                for (int m = 0; m < 4; ++m) cs[m] = *(const v4u*)(rope32 + (size_t)EPI_ROW * 32 + (c >> 1));
                EPI_FENCE();
#pragma unroll
                for (int m = 0; m < 4; ++m) { const int row = EPI_ROW; const float rstd = rst[ai][m]; f32x4 v0 = acc[ai][0][m][0] * rstd, v1 = acc[ai][0][m][1] * rstd;
                    rope8h(v0, v1, cs[m]);
                    *(v4u*)(kpe + (size_t)row * 64 + c) = pack8(v0, v1); } }
        }
    }
};
struct EpiMlaQ {
    static constexpr bool PERM = true, AFTER_DRAIN = false;
    const float* rsq; bf16* q; const unsigned* rope32;
    __device__ __forceinline__ void operator()(AccRef acc, const pg8::Unit& u, int wr, int wc, int fr, int fq) const {
        int col[2], cin[2];
#pragma unroll
        for (int bj = 0; bj < 2; ++bj) { col[bj] = u.pn * 256 + bj * 128 + wc * 32 + fq * 8; const int h = col[bj] / 192; cin[bj] = col[bj] - h * 192; }
        v4u cs0[4][2];
        { const int ai = 0;
#pragma unroll
            for (int m = 0; m < 4; ++m) {
#pragma unroll
                for (int bj = 0; bj < 2; ++bj) if (cin[bj] >= 128) cs0[m][bj] = *(const v4u*)(rope32 + (size_t)EPI_ROW * 32 + ((cin[bj] - 128) >> 1)); } }
        float rst[2][4]; wave_rstd<4>(rsq, u.pm, wr, fr, fq, 1.f / 256.f, rst);
#pragma unroll
        for (int ai = 0; ai < 2; ++ai)
        { v4u cs[4][2];
#pragma unroll
            for (int m = 0; m < 4; ++m) {
#pragma unroll
                for (int bj = 0; bj < 2; ++bj) { if (ai == 0) cs[m][bj] = cs0[m][bj]; else if (cin[bj] >= 128) cs[m][bj] = *(const v4u*)(rope32 + (size_t)EPI_ROW * 32 + ((cin[bj] - 128) >> 1)); } }
            EPI_FENCE();
#pragma unroll
            for (int m = 0; m < 4; ++m) { const int row = EPI_ROW; const float rstd = rst[ai][m];
#pragma unroll
                for (int bj = 0; bj < 2; ++bj) { f32x4 v0 = acc[ai][bj][m][0] * rstd, v1 = acc[ai][bj][m][1] * rstd;
                    if (cin[bj] >= 128) rope8h(v0, v1, cs[m][bj]);
                    *(v4u*)(q + (size_t)row * 1536 + col[bj]) = pack8(v0, v1); } } }
    }
};
struct EpiMlaKV {
    static constexpr bool PERM = true, AFTER_DRAIN = false;
    const float* rskv; bf16* dst;
    __device__ __forceinline__ void operator()(AccRef acc, const pg8::Unit& u, int wr, int wc, int fr, int fq) const {
        float rst[2][4]; wave_rstd<4>(rskv, u.pm, wr, fr, fq, 1.f / 256.f, rst);
        EPI_ROWS { const int row = EPI_ROW; const float rstd = rst[ai][m];
#pragma unroll
            for (int bj = 0; bj < 2; ++bj) { const int col = u.pn * 256 + bj * 128 + wc * 32 + fq * 8;
                *(v4u*)(dst + (size_t)row * 1024 + col) = pack8(acc[ai][bj][m][0] * rstd, acc[ai][bj][m][1] * rstd); }
        }
    }
};
struct EpiPlain {
    static constexpr bool PERM = true, AFTER_DRAIN = false;
    bf16* dst;
    __device__ __forceinline__ void operator()(AccRef acc, const pg8::Unit& u, int wr, int wc, int fr, int fq) const {
        EPI_ROWS { const int row = EPI_ROW;
#pragma unroll
            for (int bj = 0; bj < 2; ++bj) { const int col = u.pn * 256 + bj * 128 + wc * 32 + fq * 8;
                *(v4u*)(dst + (size_t)row * 1024 + col) = pack8(acc[ai][bj][m][0], acc[ai][bj][m][1]); }
        }
    }
};
#define SS8(ow) ({ const float r0 = bf2f((ow).x & 0xffffu), r1 = bf2f((ow).x >> 16), r2 = bf2f((ow).y & 0xffffu), r3 = bf2f((ow).y >> 16), r4 = bf2f((ow).z & 0xffffu), r5 = bf2f((ow).z >> 16), r6 = bf2f((ow).w & 0xffffu), r7 = bf2f((ow).w >> 16); \
                   ((r0 * r0 + r1 * r1) + (r2 * r2 + r3 * r3)) + ((r4 * r4 + r5 * r5) + (r6 * r6 + r7 * r7)); })
struct EpiOut {
    static constexpr bool PERM = true, AFTER_DRAIN = false;
    const bf16* xin; bf16* xb; float* rs1; bool dry;
    __device__ __forceinline__ void operator()(AccRef acc, const pg8::Unit& u, int wr, int wc, int fr, int fq) const {
        const size_t c0 = (size_t)u.pn * 256 + wc * 32 + fq * 8;
        v4u xw[2][4][2];
#pragma unroll
        for (int ai = 0; ai < 2; ++ai)
#pragma unroll
        for (int m = 0; m < 4; ++m) {
#pragma unroll
            for (int bj = 0; bj < 2; ++bj) xw[ai][m][bj] = *(const v4u*)(xin + (size_t)EPI_ROW * 1024 + c0 + bj * 128); }
        EPI_FENCE();
#pragma unroll
        for (int ai = 0; ai < 2; ++ai) {
#pragma unroll
        for (int m = 0; m < 4; ++m) { const int row = EPI_ROW; float ss = 0.f;
#pragma unroll
            for (int bj = 0; bj < 2; ++bj) { const v4u w = xw[ai][m][bj]; f32x4 a0 = acc[ai][bj][m][0], a1 = acc[ai][bj][m][1];
                a0[0] += bf2f(w.x & 0xffffu); a0[1] += bf2f(w.x >> 16); a0[2] += bf2f(w.y & 0xffffu); a0[3] += bf2f(w.y >> 16);
                a1[0] += bf2f(w.z & 0xffffu); a1[1] += bf2f(w.z >> 16); a1[2] += bf2f(w.w & 0xffffu); a1[3] += bf2f(w.w >> 16);
                const v4u ow = pack8(a0, a1); if (!dry) *(v4u*)(xb + (size_t)row * 1024 + c0 + bj * 128) = ow; ss += SS8(ow); }
            ss += __shfl_xor(ss, 16); ss += __shfl_xor(ss, 32);
            if (fq == 0 && !dry) rs1[(size_t)row * 16 + u.pn * 4 + wc] = ss; else asm volatile("" :: "v"(ss));
        } }
    }
};
struct EpiGate {
    static constexpr bool PERM = true, AFTER_DRAIN = false;
    const float* rs1; const bf16* x1; const bf16* pp; bf16* xb; float* rsx; bool dry;
    __device__ __forceinline__ void operator()(AccRef acc, const pg8::Unit& u, int wr, int wc, int fr, int fq) const {
        float rst[2][4]; RstdHalf rh; rstd_half_issue(rs1, u.pm, wr, fr, fq, 0, rh);
        const size_t c0 = (size_t)u.pn * 256 + wc * 32 + fq * 8;
        const __amdgpu_buffer_rsrc_t rx = epi_rsrc(x1 + (size_t)u.pm * 256 * 1024), rp = epi_rsrc(pp + (size_t)u.pm * 256 * 1024);
        const unsigned vo = (unsigned)((wr * 64 + fr) * 1024 + u.pn * 256 + wc * 32 + fq * 8) * 2u;
#pragma unroll
        for (int ai = 0; ai < 2; ++ai) { v4u xw[4][2], pw[4][2];
#pragma unroll
            for (int m = 0; m < 4; ++m)
#pragma unroll
                for (int bj = 0; bj < 2; ++bj) { const unsigned o_ = vo + (unsigned)((ai * 128 + m * 16) * 1024 + bj * 128) * 2u; xw[m][bj] = epi_ld16(rx, o_); pw[m][bj] = epi_ld16(rp, o_); }
            EPI_FENCE();
            rstd_half_finish(rh, fr, 1.f / 1024.f, rst[ai]);
            if (ai == 0) { rstd_half_issue(rs1, u.pm, wr, fr, fq, 1, rh); EPI_FENCE(); }
#pragma unroll
            for (int m = 0; m < 4; ++m) { const int row = EPI_ROW; const float rstd = rst[ai][m]; float ss = 0.f;
#pragma unroll
                for (int bj = 0; bj < 2; ++bj) { const v4u xv = xw[m][bj], pv = pw[m][bj];
                    const f32x4 g0 = acc[ai][bj][m][0] * rstd, g1 = acc[ai][bj][m][1] * rstd; f32x4 a0, a1;
                    a0[0] = bf2f(xv.x & 0xffffu) + bf2f(pv.x & 0xffffu) * sigmoid_f(g0[0]); a0[1] = bf2f(xv.x >> 16) + bf2f(pv.x >> 16) * sigmoid_f(g0[1]);
                    a0[2] = bf2f(xv.y & 0xffffu) + bf2f(pv.y & 0xffffu) * sigmoid_f(g0[2]); a0[3] = bf2f(xv.y >> 16) + bf2f(pv.y >> 16) * sigmoid_f(g0[3]);
                    a1[0] = bf2f(xv.z & 0xffffu) + bf2f(pv.z & 0xffffu) * sigmoid_f(g1[0]); a1[1] = bf2f(xv.z >> 16) + bf2f(pv.z >> 16) * sigmoid_f(g1[1]);
                    a1[2] = bf2f(xv.w & 0xffffu) + bf2f(pv.w & 0xffffu) * sigmoid_f(g1[2]); a1[3] = bf2f(xv.w >> 16) + bf2f(pv.w >> 16) * sigmoid_f(g1[3]);
                    const v4u ow = pack8(a0, a1); if (!dry) *(v4u*)(xb + (size_t)row * 1024 + c0 + bj * 128) = ow; ss += SS8(ow); }
                ss += __shfl_xor(ss, 16); ss += __shfl_xor(ss, 32);
                if (fq == 0 && !dry) rsx[(size_t)row * 16 + u.pn * 4 + wc] = ss; else asm volatile("" :: "v"(ss)); } }
    }
};
struct EpiDsaIn {
    static constexpr bool PERM = true, AFTER_DRAIN = false;
    const float* rsx; bf16* q; bf16* k; bf16* v; bf16* qi; bf16* sz; bf16* ki; float* wi; const unsigned* rope64; const unsigned* rope32;
    __device__ __forceinline__ void operator()(AccRef acc, const pg8::Unit& u, int wr, int wc, int fr, int fq) const {
        const int pn = u.pn;
        const int cb = wc * 32 + fq * 8;
        const bool rope_tile = pn < 5 || pn == 6 || pn == 7 || pn == 12;
        const unsigned* tab = (pn < 5) ? rope64 : rope32; const int tw = (pn < 5) ? 64 : 32, cm = (pn < 5) ? 127 : 63;
        v4u cs0[4][2];
        if (rope_tile) { const int ai = 0;
#pragma unroll
            for (int m = 0; m < 4; ++m) {
#pragma unroll
                for (int bj = 0; bj < 2; ++bj) { const int c = bj * 128 + cb; if (pn != 12 || c < 64) cs0[m][bj] = *(const v4u*)(tab + (size_t)EPI_ROW * tw + ((c & cm) >> 1)); } } }
        float rst[2][4]; wave_rstd<16>(rsx, u.pm, wr, fr, fq, 1.f / 1024.f, rst);
#pragma unroll
        for (int ai = 0; ai < 2; ++ai)
        { v4u cs[4][2];
            if (ai == 0) {
#pragma unroll
                for (int m = 0; m < 4; ++m) { cs[m][0] = cs0[m][0]; cs[m][1] = cs0[m][1]; }
            } else if (rope_tile) {
#pragma unroll
                for (int m = 0; m < 4; ++m) {
#pragma unroll
                    for (int bj = 0; bj < 2; ++bj) { const int c = bj * 128 + cb; if (pn != 12 || c < 64) cs[m][bj] = *(const v4u*)(tab + (size_t)EPI_ROW * tw + ((c & cm) >> 1)); } }
            }
            EPI_FENCE();
#pragma unroll
            for (int m = 0; m < 4; ++m) { const int row = EPI_ROW; const float rstd = rst[ai][m];
#pragma unroll
                for (int bj = 0; bj < 2; ++bj) { const int c = bj * 128 + cb;
                    f32x4 v0 = acc[ai][bj][m][0] * rstd, v1 = acc[ai][bj][m][1] * rstd;
                    if (pn < 4) { rope8h(v0, v1, cs[m][bj]); *(v4u*)(q + (size_t)row * 1024 + pn * 256 + c) = pack8(v0, v1); }
                    else if (pn == 4) { rope8h(v0, v1, cs[m][bj]); *(v4u*)(k + (size_t)row * 256 + c) = pack8(v0, v1); }
                    else if (pn == 5) { *(v4u*)(v + (size_t)row * 256 + c) = pack8(v0, v1); }
                    else if (pn < 8) { rope8h(v0, v1, cs[m][bj]); *(v4u*)(qi + (size_t)row * 512 + (pn - 6) * 256 + c) = pack8(v0, v1); }
                    else if (pn < 12) {
#pragma unroll
                        for (int e = 0; e < 4; ++e) { v0[e] = silu_f(v0[e]); v1[e] = silu_f(v1[e]); }
                        *(v4u*)(sz + (size_t)row * 1024 + (pn - 8) * 256 + c) = pack8(v0, v1); }
                    else if (c < 64) { rope8h(v0, v1, cs[m][bj]); *(v4u*)(ki + (size_t)row * 64 + c) = pack8(v0, v1); }
                    else if (c == 64) { *(f32x4*)(wi + (size_t)row * 8) = v0; *(f32x4*)(wi + (size_t)row * 8 + 4) = v1; }
                } } }
    }
};

__device__ __forceinline__ int src_col(int map, int n) {
    switch (map) {
    case 1:
        if (n < 512) return n; if (n < 1536) return n + 64; if (n < 1600) { const int c = n - 1536; return 512 + (c >> 1) + 32 * (c & 1); } return -1;
    case 2: {
        const int h = n / 192, c = n - h * 192; if (c < 128) return n; const int c2 = c - 128; return h * 192 + 128 + (c2 >> 1) + 32 * (c2 & 1); }
    case 3:
        if (n < 1280) { const int h = n >> 7, c = n & 127; return h * 128 + (c >> 1) + 64 * (c & 1); }
        if (n < 1536) return n;
        if (n < 2048) { const int c = n - 1536, h = c >> 6, cc = c & 63; return 1536 + h * 64 + (cc >> 1) + 32 * (cc & 1); }
        if (n < 3072) return 2120 + (n - 2048);
        if (n < 3136) { const int c = n - 3072; return 2048 + (c >> 1) + 32 * (c & 1); }
        if (n < 3144) return 2112 + (n - 3136);
        return -1;
    default: return n;
    }
}
__device__ __forceinline__ void tr_item(const float* W, int K, int N, bf16* WT, int Nout, const float* gain, int map, LAS float* scr, int item, int lane) {
    const int nblk = Nout / 32, kb = item / nblk, nb = item % nblk, k0 = 64 * kb, n0 = 32 * nb;
    const int src = src_col(map, n0 + (lane & 31));
    const int srcc = src >= 0 ? src : 0; float wv_[32], gv_[32];
#pragma unroll
    for (int i = 0; i < 32; ++i) { const int kk = 2 * i + (lane >> 5); wv_[i] = W[(size_t)(k0 + kk) * N + srcc]; gv_[i] = gain ? gain[k0 + kk] : 1.f; }
#pragma unroll
    for (int i = 0; i < 32; ++i) { const int kk = 2 * i + (lane >> 5); scr[kk * 33 + (lane & 31)] = src >= 0 ? wv_[i] * gv_[i] : 0.f; }
    LDS_WAIT(); asm volatile("" ::: "memory");
    const int c = lane & 7;
#pragma unroll
    for (int j = 0; j < 4; ++j) { const int n = (lane >> 3) + 8 * j; const LAS float* s = scr + (8 * c) * 33 + n;
        v4u o; o.x = cvtpk(s[0 * 33], s[1 * 33]); o.y = cvtpk(s[2 * 33], s[3 * 33]); o.z = cvtpk(s[4 * 33], s[5 * 33]); o.w = cvtpk(s[6 * 33], s[7 * 33]);
        *(v4u*)(WT + (size_t)(n0 + n) * K + k0 + 8 * c) = o; }
    LDS_WAIT(); asm volatile("" ::: "memory");
}

struct Args { const float* in[17]; float* out; unsigned char* ws; int ph_lo, ph_hi, pmode, pad; };

__device__ __forceinline__ void prologue(const Args& a, LAS unsigned char* lds, int gw, int ngw, int wave, int lane) {
    bf16* Wb = (bf16*)(a.ws + WS_W);
    LAS float* scr = (LAS float*)(lds + wave * 16384);
    for (int mi = 0; mi < 22; ++mi) {
        const float* W; int K, N, Nout, map = 0; const float* gain = nullptr; bf16* WT;
        if (mi < 2)       { const int j = mi;      W = a.in[4] + (size_t)j * 1024 * 1600;  K = 1024; N = 1600; Nout = MLA_N; map = 1; gain = a.in[3] + (size_t)(2 * j) * 1024; WT = Wb + W_WINM + (size_t)j * MLA_N * 1024; }
        else if (mi < 4)  { const int j = mi - 2;  W = a.in[7] + (size_t)j * 256 * 1536;   K = 256;  N = 1536; Nout = 1536;  map = 2; gain = a.in[5] + (size_t)j * 256; WT = Wb + W_WUQ + (size_t)j * 1536 * 256; }
        else if (mi < 6)  { const int j = mi - 4;  W = a.in[8] + (size_t)j * 256 * 1024;   K = 256;  N = 1024; Nout = 1024;  gain = a.in[6] + (size_t)j * 256; WT = Wb + W_WUK + (size_t)j * 1024 * 256; }
        else if (mi < 8)  { const int j = mi - 6;  W = a.in[9] + (size_t)j * 256 * 1024;   K = 256;  N = 1024; Nout = 1024;  gain = a.in[6] + (size_t)j * 256; WT = Wb + W_WUV + (size_t)j * 1024 * 256; }
        else if (mi < 10) { const int j = mi - 8;  W = a.in[10] + (size_t)j * 1024 * 1024; K = 1024; N = 1024; Nout = 1024;  WT = Wb + W_WOM + (size_t)j * 1024 * 1024; }
        else if (mi < 12) { const int j = mi - 10; W = a.in[11] + (size_t)j * 1024 * 3144; K = 1024; N = 3144; Nout = DSA_N; map = 3; gain = a.in[3] + (size_t)(2 * j + 1) * 1024; WT = Wb + W_WIND + (size_t)j * DSA_N * 1024; }
        else if (mi < 14) { const int j = mi - 12; W = a.in[12] + (size_t)j * 1024 * 1024; K = 1024; N = 1024; Nout = 1024;  WT = Wb + W_WOD + (size_t)j * 1024 * 1024; }
        else if (mi < 18) { const int i = mi - 14; W = a.in[13] + (size_t)i * 256 * 1024;  K = 256;  N = 1024; Nout = 1024;  WT = Wb + W_WP + (size_t)i * 1024 * 256; }
        else              { const int i = mi - 18; W = a.in[15] + (size_t)i * 1024 * 1024; K = 1024; N = 1024; Nout = 1024;  gain = a.in[14] + (size_t)i * 1024; WT = Wb + W_WG + (size_t)i * 1024 * 1024; }
        const int nitems = (K / 64) * (Nout / 32);
        for (int it = gw; it < nitems; it += ngw) tr_item(W, K, N, WT, Nout, gain, map, scr, it, lane);
    }
    {
        const int* pos = (const int*)a.in[2]; unsigned* r64 = (unsigned*)(a.ws + WS_ROPE64); unsigned* r32 = (unsigned*)(a.ws + WS_ROPE32);
        const float inv64 = 1.0f / powf(10000.0f, (float)lane / 64.0f);
        const float inv32 = 1.0f / powf(10000.0f, (float)(lane & 31) / 32.0f);
        for (int t0 = gw * 4; t0 < T; t0 += ngw * 4) { int pi[4];
#pragma unroll
          for (int a = 0; a < 4; ++a) pi[a] = pos[t0 + a];
#pragma unroll
          for (int a = 0; a < 4; ++a) { const int t = t0 + a; const float pf = (float)pi[a];
            { const float ang = pf * inv64; float sn, cs; sincosf(ang, &sn, &cs); r64[(size_t)t * 64 + lane] = pack_cs(cs, sn); }
            if (lane < 32) { const float ang = pf * inv32; float sn, cs; sincosf(ang, &sn, &cs); r32[(size_t)t * 32 + lane] = pack_cs(cs, sn); }
          } }
    }
    {
        const float* x = a.in[0]; bf16* xb = (bf16*)(a.ws + WS_XB0); float* rsx = (float*)(a.ws + WS_RSX);
        for (int r0 = gw * 4; r0 < T; r0 += ngw * 4) {
            f32x4 v[4][4];
#pragma unroll
            for (int a = 0; a < 4; ++a) { const f32x4* xr = (const f32x4*)(x + (size_t)(r0 + a) * 1024) + lane;
#pragma unroll
                for (int j = 0; j < 4; ++j) v[a][j] = xr[64 * j]; }
#pragma unroll
            for (int a = 0; a < 4; ++a) { float s = 0.f;
#pragma unroll
                for (int j = 0; j < 4; ++j) s += sq4(v[a][j]);
                s = wave_sum(s);
                u32x2* o8 = (u32x2*)(xb + (size_t)(r0 + a) * 1024) + lane;
#pragma unroll
                for (int j = 0; j < 4; ++j) { u32x2 w; w.x = cvtpk(v[a][j][0], v[a][j][1]); w.y = cvtpk(v[a][j][2], v[a][j][3]); o8[64 * j] = w; }
                if (lane < 16) rsx[(size_t)(r0 + a) * 16 + lane] = lane == 0 ? s : 0.f; }
        }
    }
}
__device__ __forceinline__ void convert_p(const float* p, bf16* pb, int gtid_in, int gthreads) {
    const int gtid = gtid_in;
    constexpr size_t NCH = (size_t)T * 256 / 8;
    size_t i = gtid;
    for (; i + 3 * (size_t)gthreads < NCH; i += 4 * (size_t)gthreads) { f32x4 a[4], b[4];
#pragma unroll
        for (int u = 0; u < 4; ++u) { const size_t c = i + u * (size_t)gthreads; a[u] = *(const f32x4*)(p + c * 8); b[u] = *(const f32x4*)(p + c * 8 + 4); }
#pragma unroll
        for (int u = 0; u < 4; ++u) { const size_t c = i + u * (size_t)gthreads; *(v4u*)(pb + c * 8) = pack8(a[u], b[u]); } }
    for (; i < NCH; i += gthreads) { const f32x4 a = *(const f32x4*)(p + i * 8), b = *(const f32x4*)(p + i * 8 + 4); *(v4u*)(pb + i * 8) = pack8(a, b); }
}

__device__ __forceinline__ unsigned f2key(float s) { const unsigned u = __builtin_bit_cast(unsigned, s); return (u & 0x80000000u) ? ~u : (u | 0x80000000u); }
__device__ __forceinline__ float relu_bits(float x) { const int i = __float_as_int(x); return __int_as_float(i > 0 ? i : 0); }
struct TkUnit { int b, q0; };
__device__ __forceinline__ TkUnit tk_unit(int i, int blk, int nblk, int per) {
    const int pass = i / (NB * per), rem = i - pass * NB * per, b = rem / per, w0 = blk + (rem - b * per) * nblk; TkUnit u; u.b = b; u.q0 = (pass ? 511 - w0 : w0) * 8; return u;
}
constexpr int TK_H1 = 131072, TK_HW = 131072 + 16384, TK_HWS = 576;
struct TkPre { bf16x8 aX[4], aY[4]; f32x4 w[4][2]; bf16x8 kA[4], kB[4], kC[4]; };
__device__ __forceinline__ void tk_preload(TkPre& P, const TkUnit u, int aw, int lane, const bf16* QI, const bf16* KI, const float* WI) {
    const int r = lane & 31, hb = lane >> 5;
    const int a_q = ((r >> 2) & 1) * 2 + (r >> 4), a_h = (r & 3) + 4 * ((r >> 3) & 1);
    const size_t tok0 = (size_t)u.b * SEQ + u.q0; const int ntile = (u.q0 + 8 + 31) >> 5;
#pragma unroll
    for (int s = 0; s < 4; ++s) { P.aX[s] = *(const bf16x8*)(QI + (tok0 + a_q) * 512 + a_h * 64 + 16 * s + 8 * hb); P.aY[s] = *(const bf16x8*)(QI + (tok0 + 4 + a_q) * 512 + a_h * 64 + 16 * s + 8 * hb); }
#pragma unroll
    for (int i = 0; i < 4; ++i) { const int qc = (i >> 1) * 4 + 2 * hb + (i & 1); P.w[i][0] = *(const f32x4*)(WI + (tok0 + qc) * 8); P.w[i][1] = *(const f32x4*)(WI + (tok0 + qc) * 8 + 4); }
    const bf16* kbase = KI + ((size_t)u.b * SEQ + r) * 64 + 8 * hb;
#pragma unroll
    for (int j = 0; j < 3; ++j) { const int t = aw + 4 * j, tt = t < ntile ? t : ntile - 1;
#pragma unroll
        for (int s = 0; s < 4; ++s) { const bf16x8 v = *(const bf16x8*)(kbase + (size_t)tt * 32 * 64 + 16 * s); if (j == 0) P.kA[s] = v; else if (j == 1) P.kB[s] = v; else P.kC[s] = v; } }
}
__device__ __forceinline__ void tk_stepA(TkPre& P, const TkUnit u, const TkUnit nxt, bool has_next, int aw, int lane, LAS unsigned char* lds, const bf16* QI, const bf16* KI, const float* WI) {
    typedef float f32x16 __attribute__((ext_vector_type(16)));
    LAS unsigned* ky = (LAS unsigned*)lds; LAS unsigned* h1 = (LAS unsigned*)(lds + TK_H1) + (lane & 3) * 1024;
    const int r = lane & 31, hb = lane >> 5;
    const int q0 = u.q0;
    float wv[4][8];
#pragma unroll
    for (int i = 0; i < 4; ++i) {
#pragma unroll
        for (int e = 0; e < 4; ++e) { wv[i][e] = P.w[i][0][e] * (0.125f * 0.35355339059327373f); wv[i][4 + e] = P.w[i][1][e] * (0.125f * 0.35355339059327373f); } }
    const int ntile = (q0 + 8 + 31) >> 5;
    const unsigned kvoff = (unsigned)(r * 64 + 8 * hb) * 2u;
    __amdgpu_buffer_rsrc_t krs; { const unsigned long long b_ = (unsigned long long)(KI + (size_t)u.b * SEQ * 64);
        const unsigned lo_ = __builtin_amdgcn_readfirstlane((unsigned)b_), hi_ = __builtin_amdgcn_readfirstlane((unsigned)(b_ >> 32));
        krs = __builtin_amdgcn_make_buffer_rsrc((void*)(((unsigned long long)hi_ << 32) | lo_), (short)0, 0x7fffffff, 0x00020000); }
    bf16x8 kD[4];
#define TK_KLOAD(buf, t) do { const int tt_ = (t) < ntile ? (t) : ntile - 1;     \
        _Pragma("unroll") for (int s = 0; s < 4; ++s) buf[s] = __builtin_bit_cast(bf16x8, __builtin_amdgcn_raw_buffer_load_b128(krs, (int)(kvoff + 32u * s), tt_ * 4096, 0)); } while (0)
#define TK_TILE(buf, t) do { if ((t) < ntile) { const int key = (t) * 32 + r; f32x16 cX = {}, cY = {};                                                            \
        _Pragma("unroll") for (int s = 0; s < 4; ++s) { cX = __builtin_amdgcn_mfma_f32_32x32x16_bf16(P.aX[s], buf[s], cX, 0, 0, 0); cY = __builtin_amdgcn_mfma_f32_32x32x16_bf16(P.aY[s], buf[s], cY, 0, 0, 0); } \
        float sc[4] = {0.f, 0.f, 0.f, 0.f};                                                                                                                      \
        _Pragma("unroll") for (int e = 0; e < 8; ++e) { sc[0] = __builtin_fmaf(relu_bits(cX[e]), wv[0][e], sc[0]); sc[1] = __builtin_fmaf(relu_bits(cX[8 + e]), wv[1][e], sc[1]); \
                                                        sc[2] = __builtin_fmaf(relu_bits(cY[e]), wv[2][e], sc[2]); sc[3] = __builtin_fmaf(relu_bits(cY[8 + e]), wv[3][e], sc[3]); } \
        _Pragma("unroll") for (int i = 0; i < 4; ++i) { const int qc = (i >> 1) * 4 + 2 * hb + (i & 1); const unsigned ub = __builtin_bit_cast(unsigned, sc[i] + 0.0f);        \
            const unsigned kf = ub ^ ((unsigned)((int)ub >> 31) | 0x80000000u);                                      \
            const unsigned kk = (key <= q0 + qc) ? kf : 0u; ky[qc * 4096 + key] = kk;                                                                            \
            __hip_atomic_fetch_add(h1 + qc * 128 + (kk >> 25), 1u << ((kk >> 20) & 16u), __ATOMIC_RELAXED, __HIP_MEMORY_SCOPE_WORKGROUP); } } } while (0)
    for (int tile = aw; tile < ntile; tile += 16) {
        TK_KLOAD(kD, tile + 12); TK_TILE(P.kA, tile);
        TK_KLOAD(P.kA, tile + 16); TK_TILE(P.kB, tile + 4);
        TK_KLOAD(P.kB, tile + 20); TK_TILE(P.kC, tile + 8);
        TK_KLOAD(P.kC, tile + 24); TK_TILE(kD, tile + 12);
    }
#undef TK_KLOAD
#undef TK_TILE
    const int kend = ((q0 + 8 + 511) >> 9) << 9;
    for (int key = ntile * 32 + aw * 64 + lane; key < kend; key += 256) {
#pragma unroll
        for (int i = 0; i < 8; ++i) ky[i * 4096 + key] = 0u; }
    if (has_next) tk_preload(P, nxt, aw, lane, QI, KI, WI);
}
__device__ __forceinline__ void tk_stepB(const unsigned (&k)[64], int q, size_t tok, int ngrp, int lane, const int (&c0)[4], LAS unsigned* hw, unsigned long long* mask) {
    unsigned thr = 0u; int need = 0;
    if (q >= 256) {
        unsigned prefix = 0u; int rem = 256; bool done = false;
#pragma unroll
        for (int p = 0; p < 4; ++p) {
            constexpr int SH[4] = {24, 15, 6, 0}, NBITS[4] = {8, 9, 9, 6};
            const int sh = SH[p], nb = NBITS[p];
            int c[8];
            if (p == 0) { c[0] = c0[0]; c[1] = c0[1]; c[2] = c0[2]; c[3] = c0[3]; c[4] = 0; c[5] = 0; c[6] = 0; c[7] = 0; }
            else {
                *(LAS v4u*)(hw + lane * 8) = (v4u){0u, 0u, 0u, 0u}; *(LAS v4u*)(hw + lane * 8 + 4) = (v4u){0u, 0u, 0u, 0u};
                const unsigned pfx = prefix >> (sh + nb), dummy = 512u + (unsigned)lane;
#pragma unroll
                for (int g = 0; g < 8; ++g) if (g < ngrp) {
#pragma unroll
                    for (int e = 0; e < 8; ++e) { const unsigned kk = k[g * 8 + e]; const bool cand = (kk >> (sh + nb)) == pfx; const unsigned bin = (kk >> sh) & ((1u << nb) - 1u);
                        if (p == 1) __hip_atomic_fetch_add(hw + (cand ? bin : dummy), 1u, __ATOMIC_RELAXED, __HIP_MEMORY_SCOPE_WORKGROUP);
                        else if (__ballot(cand) != 0ull) { if (cand) __hip_atomic_fetch_add(hw + bin, 1u, __ATOMIC_RELAXED, __HIP_MEMORY_SCOPE_WORKGROUP); } }
                    __builtin_amdgcn_sched_barrier(0); }
                LDS_WAIT(); asm volatile("" ::: "memory");
                const v4u h0 = *(const LAS v4u*)(hw + lane * 8), h1v = *(const LAS v4u*)(hw + lane * 8 + 4);
                c[0] = (int)h0.x; c[1] = (int)h0.y; c[2] = (int)h0.z; c[3] = (int)h0.w; c[4] = (int)h1v.x; c[5] = (int)h1v.y; c[6] = (int)h1v.z; c[7] = (int)h1v.w; }
            const int tot = ((c[0] + c[1]) + (c[2] + c[3])) + ((c[4] + c[5]) + (c[6] + c[7]));
            int P = tot;
            P += __builtin_amdgcn_update_dpp(0, P, 0x111, 0xf, 0xf, false); P += __builtin_amdgcn_update_dpp(0, P, 0x112, 0xf, 0xf, false);
            P += __builtin_amdgcn_update_dpp(0, P, 0x114, 0xf, 0xf, false); P += __builtin_amdgcn_update_dpp(0, P, 0x118, 0xf, 0xf, false);
            P += __builtin_amdgcn_update_dpp(0, P, 0x142, 0xa, 0xf, false); P += __builtin_amdgcn_update_dpp(0, P, 0x143, 0xc, 0xf, false);
            const int total = __builtin_amdgcn_readlane(P, 63);
            const int snext = total - P;
            const int L = __popcll(__ballot(snext + tot >= rem)) - 1;
            int s = snext, dl = 0, cgl = 0, cel = 0;
#pragma unroll
            for (int e = 7; e >= 0; --e) { const int s2 = s + c[e]; const bool hit = (s < rem) && (s2 >= rem); dl = hit ? e : dl; cgl = hit ? s : cgl; cel = hit ? c[e] : cel; s = s2; }
            const int d = L * (p == 0 ? 4 : 8) + __builtin_amdgcn_readlane(dl, L), cgt = __builtin_amdgcn_readlane(cgl, L), ceq = __builtin_amdgcn_readlane(cel, L);
            rem -= cgt; prefix |= (unsigned)d << sh;
            if (ceq == rem) { done = true; break; }
        }
        if (done) { thr = prefix - 1u; need = 0; } else { thr = prefix; need = rem; }
    }
    unsigned wlo = 0u, whi = 0u;
#define WL(J, w) do { const unsigned lo_ = (unsigned)(w), hi_ = (unsigned)((w) >> 32);                                                                      \
                asm volatile("s_nop 3\n\tv_writelane_b32 %0, %2, " #J "\n\tv_writelane_b32 %1, %3, " #J : "+v"(wlo), "+v"(whi) : "s"(lo_), "s"(hi_)); } while (0)
#define REP64(M) M(0); M(1); M(2); M(3); M(4); M(5); M(6); M(7); __builtin_amdgcn_sched_barrier(0); M(8); M(9); M(10); M(11); M(12); M(13); M(14); M(15); __builtin_amdgcn_sched_barrier(0); \
                 M(16); M(17); M(18); M(19); M(20); M(21); M(22); M(23); __builtin_amdgcn_sched_barrier(0); M(24); M(25); M(26); M(27); M(28); M(29); M(30); M(31); __builtin_amdgcn_sched_barrier(0); \
                 M(32); M(33); M(34); M(35); M(36); M(37); M(38); M(39); __builtin_amdgcn_sched_barrier(0); M(40); M(41); M(42); M(43); M(44); M(45); M(46); M(47); __builtin_amdgcn_sched_barrier(0); \
                 M(48); M(49); M(50); M(51); M(52); M(53); M(54); M(55); __builtin_amdgcn_sched_barrier(0); M(56); M(57); M(58); M(59); M(60); M(61); M(62); M(63); __builtin_amdgcn_sched_barrier(0)
    if (need == 0) {
#define SEL_GT8(J0, J1, J2, J3, J4, J5, J6, J7) do { const unsigned long long w0_ = __ballot(k[J0] > thr); const unsigned long long w1_ = __ballot(k[J1] > thr); const unsigned long long w2_ = __ballot(k[J2] > thr); const unsigned long long w3_ = __ballot(k[J3] > thr); const unsigned long long w4_ = __ballot(k[J4] > thr); const unsigned long long w5_ = __ballot(k[J5] > thr); const unsigned long long w6_ = __ballot(k[J6] > thr); const unsigned long long w7_ = __ballot(k[J7] > thr);                                     \
                asm volatile("s_nop 3\n\t" "v_writelane_b32 %0, %2, " #J0 "\n\tv_writelane_b32 %1, %3, " #J0 "\n\t" "v_writelane_b32 %0, %4, " #J1 "\n\tv_writelane_b32 %1, %5, " #J1 "\n\t" "v_writelane_b32 %0, %6, " #J2 "\n\tv_writelane_b32 %1, %7, " #J2 "\n\t" "v_writelane_b32 %0, %8, " #J3 "\n\tv_writelane_b32 %1, %9, " #J3 "\n\t" "v_writelane_b32 %0, %10, " #J4 "\n\tv_writelane_b32 %1, %11, " #J4 "\n\t" "v_writelane_b32 %0, %12, " #J5 "\n\tv_writelane_b32 %1, %13, " #J5 "\n\t" "v_writelane_b32 %0, %14, " #J6 "\n\tv_writelane_b32 %1, %15, " #J6 "\n\t" "v_writelane_b32 %0, %16, " #J7 "\n\tv_writelane_b32 %1, %17, " #J7 "\n\t" : "+v"(wlo), "+v"(whi) : "s"((unsigned)(w0_)), "s"((unsigned)((w0_) >> 32)), "s"((unsigned)(w1_)), "s"((unsigned)((w1_) >> 32)), "s"((unsigned)(w2_)), "s"((unsigned)((w2_) >> 32)), "s"((unsigned)(w3_)), "s"((unsigned)((w3_) >> 32)), "s"((unsigned)(w4_)), "s"((unsigned)((w4_) >> 32)), "s"((unsigned)(w5_)), "s"((unsigned)((w5_) >> 32)), "s"((unsigned)(w6_)), "s"((unsigned)((w6_) >> 32)), "s"((unsigned)(w7_)), "s"((unsigned)((w7_) >> 32))); __builtin_amdgcn_sched_barrier(0); } while (0)
        SEL_GT8(0, 1, 2, 3, 4, 5, 6, 7); SEL_GT8(8, 9, 10, 11, 12, 13, 14, 15); SEL_GT8(16, 17, 18, 19, 20, 21, 22, 23); SEL_GT8(24, 25, 26, 27, 28, 29, 30, 31);
        SEL_GT8(32, 33, 34, 35, 36, 37, 38, 39); SEL_GT8(40, 41, 42, 43, 44, 45, 46, 47); SEL_GT8(48, 49, 50, 51, 52, 53, 54, 55); SEL_GT8(56, 57, 58, 59, 60, 61, 62, 63);
#undef SEL_GT8
    } else {
        int run = 0; const unsigned long long ltmask = (1ull << lane) - 1ull;
#define SEL_TIE(J) do { const unsigned kk = k[J]; const bool eq = kk == thr; const unsigned long long beq = __ballot(eq);                                   \
                const int rank = run + __popcll(beq & ltmask); const bool sel = (kk > thr) || (eq && rank < need);                                          \
                const unsigned long long w = __ballot(sel); WL(J, w); run += __popcll(beq); } while (0)
        REP64(SEL_TIE);
#undef SEL_TIE
    }
#undef REP64
#undef WL
    mask[tok * 64 + lane] = ((unsigned long long)whi << 32) | wlo;
}
#define TK_LOADK(kk, rowi, ngrp_) do { const LAS unsigned* row_ = (const LAS unsigned*)lds + (rowi) * 4096;                                      \
        _Pragma("unroll") for (int g = 0; g < 8; ++g) { if (g < (ngrp_)) { _Pragma("unroll") for (int e = 0; e < 8; ++e) kk[g * 8 + e] = row_[(g * 8 + e) * 64 + lane]; } \
            else { _Pragma("unroll") for (int e = 0; e < 8; ++e) kk[g * 8 + e] = 0u; } } } while (0)
__device__ __forceinline__ void topk_phase(int blk, int nblk, int wave, int lane, LAS unsigned char* lds, const bf16* QI, const bf16* KI, const float* WI, unsigned long long* mask) {
    const bool isA = wave < 4; const int aw = wave, bw = wave - 4;
    const int per = (256 - blk + nblk - 1) / nblk, n = NB * 2 * per;
    if (per <= 0) return;
    { LAS unsigned* z = (LAS unsigned*)(lds + TK_H1); for (int i = wave * 64 + lane; i < 4096; i += 512) z[i] = 0u; }
    LDS_WAIT(); __syncthreads();
    if (isA) {
        TkPre P; tk_preload(P, tk_unit(0, blk, nblk, per), aw, lane, QI, KI, WI);
        tk_stepA(P, tk_unit(0, blk, nblk, per), tk_unit(n > 1 ? 1 : 0, blk, nblk, per), n > 1, aw, lane, lds, QI, KI, WI);
        LDS_WAIT(); __builtin_amdgcn_s_barrier();
        for (int s = 1; s <= n; ++s) {
            LDS_WAIT(); __builtin_amdgcn_s_barrier();
            if (s < n) tk_stepA(P, tk_unit(s, blk, nblk, per), tk_unit(s + 1 < n ? s + 1 : s, blk, nblk, per), s + 1 < n, aw, lane, lds, QI, KI, WI);
            LDS_WAIT(); __builtin_amdgcn_s_barrier();
        }
    } else {
        LDS_WAIT(); __builtin_amdgcn_s_barrier();
        for (int s = 1; s <= n; ++s) {
            const TkUnit up = tk_unit(s - 1, blk, nblk, per);
            const int ngrp = (((up.q0 + 8 + 511) >> 9) << 9) >> 9;
            unsigned k0[64], k1[64];
            TK_LOADK(k0, 2 * bw, ngrp); TK_LOADK(k1, 2 * bw + 1, ngrp);
            int c00[4] = {0, 0, 0, 0}, c01[4] = {0, 0, 0, 0};
            { LAS unsigned* hb0 = (LAS unsigned*)(lds + TK_H1) + (2 * bw) * 128 + lane * 2;
#pragma unroll
              for (int cp = 0; cp < 4; ++cp) { const u32x2 a = *(const LAS u32x2*)(hb0 + cp * 1024), b = *(const LAS u32x2*)(hb0 + cp * 1024 + 128);
                  c00[0] += (int)(a.x & 0xffffu); c00[1] += (int)(a.x >> 16); c00[2] += (int)(a.y & 0xffffu); c00[3] += (int)(a.y >> 16);
                  c01[0] += (int)(b.x & 0xffffu); c01[1] += (int)(b.x >> 16); c01[2] += (int)(b.y & 0xffffu); c01[3] += (int)(b.y >> 16);
                  *(LAS u32x2*)(hb0 + cp * 1024) = (u32x2){0u, 0u}; *(LAS u32x2*)(hb0 + cp * 1024 + 128) = (u32x2){0u, 0u}; } }
            LDS_WAIT(); __builtin_amdgcn_s_barrier();
            LAS unsigned* hw = (LAS unsigned*)(lds + TK_HW) + bw * TK_HWS;
            const size_t tok0 = (size_t)up.b * SEQ + up.q0;
            tk_stepB(k0, up.q0 + 2 * bw, tok0 + 2 * bw, ngrp, lane, c00, hw, mask);
            tk_stepB(k1, up.q0 + 2 * bw + 1, tok0 + 2 * bw + 1, ngrp, lane, c01, hw, mask);
            LDS_WAIT(); __builtin_amdgcn_s_barrier();
        }
    }
    __syncthreads();
}
#undef TK_LOADK

#define PROBE 0
#define IN(k) (lo <= (k) && (k) < hi)
#define SEAM(k) do { if (IN(k) && IN((k) + 1)) { xcd_barrier(bar); if (PROBE == 50) xcd_barrier(bar); } } while (0)
#define WSP(T_, off) ((T_*)(args.ws + (off)))
__device__ __forceinline__ int opaque_tid() { int t = threadIdx.x; asm volatile("" : "+v"(t)); return t; }
#define PROBE 0
template <int I>
__device__ __forceinline__ void layer(const Args& args, LAS unsigned char* lds, const XcdBarrier& bar, const int lo, const int hi, const int G, const int bx) {
    constexpr int k0 = 1 + 5 * I, j = I >> 1;
    extern __shared__ __attribute__((aligned(16))) unsigned char lds_dyn[];
#define ldsg ((char*)lds_dyn)
#define TID_ (opaque_tid())
#define LANE_ ((int)threadIdx.x & 63)
#define WAVE_ (__builtin_amdgcn_readfirstlane((int)threadIdx.x >> 6))
    if constexpr ((I & 1) == 0) {
        if (IN(k0)) {
            pg8::Gemm g{WSP(bf16, WS_XB0), WSP(bf16, WS_W) + W_WINM + (size_t)j * MLA_N * 1024, T, MLA_N, 1024}; pg8::StaticOrder S; S.init(T, MLA_N, G, bx);
            EpiMlaIn E{WSP(float, WS_RSX), WSP(bf16, WS_CQ), WSP(bf16, WS_CKV), WSP(bf16, WS_SZ), WSP(bf16, WS_KPE), WSP(float, WS_RSQ), WSP(float, WS_RSKV), WSP(unsigned, WS_ROPE32)};
            if (PROBE == 5 && I == 0) pg8::gemm_phase<EpiMlaIn, pg8::StaticOrder, true, true>(lds, g, S, E);
            pg8::gemm_phase<EpiMlaIn, pg8::StaticOrder, true, true>(lds, g, S, E);
        }
        SEAM(k0);
        if (IN(k0 + 1)) for (int rep = 0; rep < ((PROBE == 4 && I < 2) ? 2 : 1); ++rep) {
            { pg8::Gemm g{WSP(bf16, WS_CQ), WSP(bf16, WS_W) + W_WUQ + (size_t)j * 1536 * 256, T, 1536, 256}; pg8::StaticOrder S; S.init(T, 1536, G, bx); EpiMlaQ E{WSP(float, WS_RSQ), WSP(bf16, WS_Q), WSP(unsigned, WS_ROPE32)};
              pg8::gemm_phase<EpiMlaQ, pg8::StaticOrder, true, true>(lds, g, S, E); }
            { pg8::Gemm g{WSP(bf16, WS_CKV), WSP(bf16, WS_W) + W_WUK + (size_t)j * 1024 * 256, T, 1024, 256}; pg8::StaticOrder S; S.init(T, 1024, G, bx); EpiMlaKV E{WSP(float, WS_RSKV), WSP(bf16, WS_KN)};
              pg8::gemm_phase<EpiMlaKV, pg8::StaticOrder, true, true>(lds, g, S, E); }
            { pg8::Gemm g{WSP(bf16, WS_CKV), WSP(bf16, WS_W) + W_WUV + (size_t)j * 1024 * 256, T, 1024, 256}; pg8::StaticOrder S; S.init(T, 1024, G, bx); EpiMlaKV E{WSP(float, WS_RSKV), WSP(bf16, WS_V)};
              pg8::gemm_phase<EpiMlaKV, pg8::StaticOrder, true, true>(lds, g, S, E); }
        }
        SEAM(k0 + 1);
        if (IN(k0 + 2)) {
            for (int rep = (PROBE == 11 && I == 0) ? 0 : 1; rep < 2; ++rep)
            att::attn_phase<true, false, 1536, 192, 1024, 1024, 8>(ldsg, WSP(bf16, WS_Q), WSP(bf16, WS_KN), WSP(bf16, WS_V), WSP(bf16, WS_KPE), WSP(bf16, WS_SZ), nullptr, 0.07216878364870323f, args.in[1] + (size_t)I * T * 256, WSP(bf16, WS_PB), rep == 0);
        }
        SEAM(k0 + 2);
    } else {
        if (IN(k0)) {
            pg8::Gemm g{WSP(bf16, WS_XB0), WSP(bf16, WS_W) + W_WIND + (size_t)j * DSA_N * 1024, T, DSA_N, 1024}; pg8::StaticOrder S; S.init(T, DSA_N, G, bx);
            EpiDsaIn E{WSP(float, WS_RSX), WSP(bf16, WS_Q), WSP(bf16, WS_KD), WSP(bf16, WS_VD), WSP(bf16, WS_QI), WSP(bf16, WS_SZ), WSP(bf16, WS_KI), WSP(float, WS_WI), WSP(unsigned, WS_ROPE64), WSP(unsigned, WS_ROPE32)};
            for (int rep = 0; rep < ((PROBE == 4 && I < 2) ? 2 : 1); ++rep) pg8::gemm_phase<EpiDsaIn, pg8::StaticOrder, true, true>(lds, g, S, E);
        }
        SEAM(k0);
        if (IN(k0 + 1)) {
            topk_phase(bx, G, WAVE_, LANE_, lds, WSP(bf16, WS_QI), WSP(bf16, WS_KI), WSP(float, WS_WI), WSP(unsigned long long, WS_MASK)); }
        SEAM(k0 + 1);
        if (IN(k0 + 2)) {
            if (PROBE == 2 && I == 1) att::attn_phase<false, true, 1024, 128, 256, 256, 2, true>(ldsg, WSP(bf16, WS_Q), WSP(bf16, WS_KD), WSP(bf16, WS_VD), nullptr, WSP(bf16, WS_SZ), WSP(unsigned long long, WS_MASK), 0.08838834764831845f, args.in[1] + (size_t)I * T * 256, WSP(bf16, WS_PB));
            att::attn_phase<false, true, 1024, 128, 256, 256, 2>(ldsg, WSP(bf16, WS_Q), WSP(bf16, WS_KD), WSP(bf16, WS_VD), nullptr, WSP(bf16, WS_SZ), WSP(unsigned long long, WS_MASK), 0.08838834764831845f, args.in[1] + (size_t)I * T * 256, WSP(bf16, WS_PB));
        }
        SEAM(k0 + 2);
    }
    if (IN(k0 + 3)) for (int rep = ((PROBE == 4 && I < 2) ? 0 : 1); rep < 2; ++rep) {
        { pg8::Gemm g{WSP(bf16, WS_PB), WSP(bf16, WS_W) + W_WP + (size_t)I * 1024 * 256, T, 1024, 256}; pg8::StaticOrder S; S.init(T, 1024, G, bx); EpiPlain E{WSP(bf16, WS_PP)};
          pg8::gemm_phase<EpiPlain, pg8::StaticOrder, true, true>(lds, g, S, E); }
        { pg8::Gemm g{WSP(bf16, WS_SZ), WSP(bf16, WS_W) + ((I & 1) ? W_WOD : W_WOM) + (size_t)j * 1024 * 1024, T, 1024, 1024}; pg8::StaticOrder S; S.init(T, 1024, G, bx);
          EpiOut E{WSP(bf16, WS_XB0), WSP(bf16, WS_XB1), WSP(float, WS_RS1), rep == 0};
          pg8::gemm_phase<EpiOut, pg8::StaticOrder, true, true>(lds, g, S, E); }
    }
    SEAM(k0 + 3);
    if (IN(k0 + 4)) for (int rep = ((PROBE == 4 && I < 2) ? 0 : 1); rep < 2; ++rep) {
        pg8::Gemm g{WSP(bf16, WS_XB1), WSP(bf16, WS_W) + W_WG + (size_t)I * 1024 * 1024, T, 1024, 1024}; pg8::StaticOrder S; S.init(T, 1024, G, bx);
        EpiGate E{WSP(float, WS_RS1), WSP(bf16, WS_XB1), WSP(bf16, WS_PP), WSP(bf16, WS_XB0), WSP(float, WS_RSX), rep == 0};
        pg8::gemm_phase<EpiGate, pg8::StaticOrder, true, true>(lds, g, S, E);
    }
    SEAM(k0 + 4);
#undef TID_
#undef LANE_
#undef WAVE_
#undef ldsg
}

__global__ void __launch_bounds__(NWAVES * 64, 2) fwd(Args args) {
    extern __shared__ __attribute__((aligned(16))) unsigned char lds_raw[];
    LAS unsigned char* lds = (LAS unsigned char*)lds_raw;
    volatile LAS unsigned* MISC = (volatile LAS unsigned*)(lds + MISC_OFF);
    const int G = gridDim.x, bx = blockIdx.x;
    for (int u = threadIdx.x; u < (LDS_BYTES - MISC_OFF) / 4; u += NWAVES * 64) ((LAS unsigned*)(lds + MISC_OFF))[u] = 0u;
    __syncthreads();
    const int lo = args.ph_lo, hi = args.ph_hi;
    XcdBarrier bar; bar.bar = (unsigned*)(args.ws + WS_CTL) + CW_BAR; bar.x = 0; bar.st = nullptr;
    if (hi - lo > 1) bar = xcd_barrier_post((unsigned*)(args.ws + WS_CTL) + CW_BAR, MISC + 8);

    if (IN(0)) { const int lane = threadIdx.x & 63, wave = __builtin_amdgcn_readfirstlane((int)threadIdx.x >> 6);
        if (PROBE == 8) prologue(args, lds, bx * NWAVES + wave, G * NWAVES, wave, lane); prologue(args, lds, bx * NWAVES + wave, G * NWAVES, wave, lane); }
    SEAM(0);
    layer<0>(args, lds, bar, lo, hi, G, bx);
    layer<1>(args, lds, bar, lo, hi, G, bx);
    layer<2>(args, lds, bar, lo, hi, G, bx);
    layer<3>(args, lds, bar, lo, hi, G, bx);
    if (IN(21)) {
        const int lane = threadIdx.x & 63, wave = __builtin_amdgcn_readfirstlane((int)threadIdx.x >> 6);
        const int gw = bx * NWAVES + wave, ngw = G * NWAVES;
        const float* fg = args.in[16]; f32x4 gv[4];
#pragma unroll
        for (int jj = 0; jj < 4; ++jj) gv[jj] = ((const f32x4*)fg)[lane + 64 * jj];
        const bf16* xbf = (const bf16*)(args.ws + WS_XB0);
        for (int r0 = gw * 2; r0 < T; r0 += ngw * 2) { u32x2 w[2][4];
#pragma unroll
            for (int a = 0; a < 2; ++a) { const u32x2* xr = (const u32x2*)(xbf + (size_t)(r0 + a) * 1024) + lane;
#pragma unroll
                for (int jj = 0; jj < 4; ++jj) w[a][jj] = xr[64 * jj]; }
#pragma unroll
            for (int a = 0; a < 2; ++a) { f32x4 v[4]; float s = 0.f;
#pragma unroll
                for (int jj = 0; jj < 4; ++jj) { v[jj][0] = bf2f(w[a][jj].x & 0xffffu); v[jj][1] = bf2f(w[a][jj].x >> 16); v[jj][2] = bf2f(w[a][jj].y & 0xffffu); v[jj][3] = bf2f(w[a][jj].y >> 16); s += sq4(v[jj]); }
                const float rstd = rsqrtf(wave_sum(s) * (1.f / 1024.f) + NORM_EPS);
                f32x4* orow = (f32x4*)(args.out + (size_t)(r0 + a) * 1024) + lane;
#pragma unroll
                for (int jj = 0; jj < 4; ++jj) orow[64 * jj] = v[jj] * rstd * gv[jj]; } }
    }
}
#undef IN
#undef SEAM

#if PROBE == 12 || PROBE == 13
__global__ void __launch_bounds__(NWAVES * 64, 2) probe_attn(Args args) {
    extern __shared__ __attribute__((aligned(16))) unsigned char lds_raw[];
#if PROBE == 12
    att::attn_phase<true, false, 1536, 192, 1024, 1024, 8, true>((char*)lds_raw, WSP(bf16, WS_Q), WSP(bf16, WS_KN), WSP(bf16, WS_V), WSP(bf16, WS_KPE), WSP(bf16, WS_SZ), nullptr, 0.07216878364870323f, args.in[1], WSP(bf16, WS_PB));
#else
    att::attn_phase<false, true, 1024, 128, 256, 256, 2, true>((char*)lds_raw, WSP(bf16, WS_Q), WSP(bf16, WS_KD), WSP(bf16, WS_VD), nullptr, WSP(bf16, WS_SZ), WSP(unsigned long long, WS_MASK), 0.08838834764831845f, args.in[1], WSP(bf16, WS_PB));
#endif
}
#endif
#ifndef ONE_LAUNCH
#define ONE_LAUNCH 1
#endif
extern "C" void kernel_launch(void* const* d_in, const int* in_sizes, int n_in, void* d_out, int out_size, void* d_ws, size_t ws_size, hipStream_t stream) {
    static int grid = 0;
    if (grid == 0) {
        if (n_in != 17 || out_size != T * DM || ws_size < WS_END) { fprintf(stderr, "kernel_launch: unexpected shapes (n_in %d, out %d, ws %zu)\n", n_in, out_size, ws_size); grid = -1; return; }
        int dev = 0, cus = 0, per_cu = 0;
        if (hipGetDevice(&dev) != hipSuccess || hipDeviceGetAttribute(&cus, hipDeviceAttributeMultiprocessorCount, dev) != hipSuccess) { grid = -1; return; }
        if (hipFuncSetAttribute((const void*)fwd, hipFuncAttributeMaxDynamicSharedMemorySize, LDS_BYTES) != hipSuccess) { fprintf(stderr, "kernel_launch: hipFuncSetAttribute failed\n"); grid = -1; return; }
        if (hipOccupancyMaxActiveBlocksPerMultiprocessor(&per_cu, (const void*)fwd, NWAVES * 64, LDS_BYTES) != hipSuccess || per_cu < 1) fprintf(stderr, "kernel_launch: occupancy query says %d\n", per_cu);
        (void)hipGetLastError();
        grid = cus;
    }
    if (grid < 0) return;
    (void)hipMemsetAsync((char*)d_ws + WS_CTL, 0, CTL_ZERO_BYTES, stream);
    Args a{};
    for (int i = 0; i < 17; ++i) a.in[i] = (const float*)d_in[i];
    a.out = (float*)d_out; a.ws = (unsigned char*)d_ws;
    if (ONE_LAUNCH) { a.ph_lo = 0; a.ph_hi = NPHASE; hipLaunchKernelGGL(fwd, dim3(grid), dim3(NWAVES * 64), LDS_BYTES, stream, a); }
    else for (int ph = 0; ph < NPHASE; ++ph) { a.ph_lo = ph; a.ph_hi = ph + 1; hipLaunchKernelGGL(fwd, dim3(grid), dim3(NWAVES * 64), LDS_BYTES, stream, a); }
#if PROBE >= 100
    a.pmode = (PROBE / 100) - 1; a.ph_lo = PROBE % 100; a.ph_hi = PROBE % 100 + 1; hipLaunchKernelGGL(fwd, dim3(grid), dim3(NWAVES * 64), LDS_BYTES, stream, a);
#endif
#if PROBE == 12 || PROBE == 13
    { static bool attr2 = false; if (!attr2) { attr2 = true; (void)hipFuncSetAttribute((const void*)probe_attn, hipFuncAttributeMaxDynamicSharedMemorySize, LDS_BYTES); }
      hipLaunchKernelGGL(probe_attn, dim3(grid), dim3(NWAVES * 64), LDS_BYTES, stream, a); }
#endif
}
```

```cpp
#include <hip/hip_runtime.h>
#include <cstdio>
#include <cstdint>
namespace pg8 {
#define PG8_LAS __attribute__((address_space(3)))
typedef unsigned short bf16_t;
typedef short bf16x8 __attribute__((ext_vector_type(8)));
typedef float f32x4 __attribute__((ext_vector_type(4)));
typedef unsigned u32x4 __attribute__((ext_vector_type(4)));
constexpr int BM = 256, BK = 64, HALF = 128, HTB = HALF * BK * 2  , STAGE_BYTES = 8 * HTB, NXCD = 8, WGM = 8;

__host__ __device__ __forceinline__ int lds_byte(int r, int c) { const int st = (r >> 4) * 2 + (c >> 5), rr = r & 15, cc = c & 31, ob = rr * 64 + cc * 2; return st * 1024 + (ob ^ (((ob >> 9) & 1) << 5)); }
__host__ __device__ __forceinline__ void stage_rc(int b, int& R, int& C) { const int st = b / 1024, sb = b % 1024, swz = sb ^ (((sb >> 9) & 1) << 5); R = (st >> 1) * 16 + swz / 64; C = (st & 1) * 32 + (swz % 64) / 2; }
__host__ __device__ __forceinline__ int perm32(int rho) { const int n = rho >> 4, i = rho & 15; return 8 * (i >> 2) + 4 * n + (i & 3); }

struct Unit { int pm, pn; };
struct Gemm { const bf16_t* A; const bf16_t* Bt; int M, N, K; };

struct StaticOrder {
    int nM, nN, nwg, G, c;
    __host__ __device__ void init(int M, int N, int G_, int c_) { nM = M / BM; nN = N / BM; nwg = nM * nN; G = G_; c = c_; }
    __host__ __device__ bool next(int i, Unit& u) const {
        const long L = (long)i * G + c; if (L >= nwg) return false;
        int wgid = (int)L; { const int q = nwg / NXCD, r = nwg % NXCD, xcd = wgid % NXCD, off = wgid / NXCD; wgid = (xcd < r ? xcd * (q + 1) : r * (q + 1) + (xcd - r) * q) + off; }
        const int nig = WGM * nN, gid = wgid / nig, fm = gid * WGM, gsz = (nM - fm) < WGM ? (nM - fm) : WGM;
        u.pm = fm + ((wgid % nig) % gsz); u.pn = (wgid % nig) / gsz; return true;
    }
    __device__ __forceinline__ void a_ready(const Unit&) const {}
    __device__ __forceinline__ void done(const Unit&) const {}
};

__device__ __forceinline__ unsigned cvt_pk_bf16(float lo, float hi) { unsigned r; asm volatile("v_cvt_pk_bf16_f32 %0, %1, %2" : "=v"(r) : "v"(lo), "v"(hi)); return r; }
typedef float f32x2 __attribute__((ext_vector_type(2)));
template <class Epi, class Sched, bool ALIGN_EPI = false, bool SP2 = false>
__device__ __forceinline__ void gemm_phase(PG8_LAS unsigned char* lds, const Gemm g, const Sched& S, const Epi& E) {
    const int tid = threadIdx.x, wid = __builtin_amdgcn_readfirstlane(tid >> 6), lane = tid & 63, wr = wid >> 2, wc = wid & 3, fr = lane & 15, fq = lane >> 4;
    const int K = g.K, nt = K / BK;
    unsigned voffA[2], voffB[2];
#pragma unroll
    for (int i = 0; i < 2; ++i) { int R, C; stage_rc(tid * 16 + i * 8192, R, C); const int Rb = Epi::PERM ? ((R & ~31) + perm32(R & 31)) : R;
        voffA[i] = (unsigned)(R * K + C) * 2u; voffB[i] = (unsigned)(Rb * K + C) * 2u; }
    const size_t kstep = (size_t)(BK * 2);
    const size_t hstep = (size_t)HALF * K * 2;
    const size_t tstep = 2 * hstep;
    const unsigned ldsw = (unsigned)wid * 1024u;
    const int aoff = lds_byte(wr * 64 + fr, fq * 8), boff = lds_byte(wc * 32 + fr, fq * 8);
#define PG8_SA(b, h) (((b) * 2 + (h)) * HTB)
#define PG8_SB(b, h) ((4 + (b) * 2 + (h)) * HTB)
#define PG8_STAGE(bufoff, gbase, voff) do { _Pragma("unroll") for (int _i = 0; _i < 2; ++_i) \
        __builtin_amdgcn_global_load_lds((const unsigned*)((const char*)(gbase) + (voff)[_i]), (PG8_LAS unsigned*)(lds + (bufoff) + ldsw + _i * 8192), 16, 0, 0); } while (0)
#define PG8_LDA(dst, b, h) do { _Pragma("unroll") for (int m = 0; m < 4; ++m) _Pragma("unroll") for (int k = 0; k < 2; ++k) dst[m][k] = *(const PG8_LAS bf16x8*)(lds + PG8_SA(b, h) + aoff + m * 2048 + k * 1024); } while (0)
#define PG8_LDB(dst, b, h) do { _Pragma("unroll") for (int n = 0; n < 2; ++n) _Pragma("unroll") for (int k = 0; k < 2; ++k) dst[n][k] = *(const PG8_LAS bf16x8*)(lds + PG8_SB(b, h) + boff + n * 2048 + k * 1024); } while (0)
#define PG8_MMA(ai, bj, At, Bt) do { __builtin_amdgcn_s_setprio(1); _Pragma("unroll") for (int m = 0; m < 4; ++m) _Pragma("unroll") for (int n = 0; n < 2; ++n) _Pragma("unroll") for (int k = 0; k < 2; ++k) \
        acc[ai][bj][m][n] = __builtin_amdgcn_mfma_f32_16x16x32_bf16(Bt[n][k], At[m][k], acc[ai][bj][m][n], 0, 0, 0); __builtin_amdgcn_s_setprio(0); } while (0)
#define PG8_WAIT_V(n) asm volatile("s_waitcnt vmcnt(" #n ")" ::: "memory")
#define PG8_WAIT_L(n) asm volatile("s_waitcnt lgkmcnt(" #n ")" ::: "memory")
#define PG8_BAR __builtin_amdgcn_s_barrier()
#define PG8_SCHED __builtin_amdgcn_sched_barrier(0)
    Unit cur, nxt; int ui = 0;
    if (!S.next(0, cur)) return;
    f32x4 acc[2][2][4][2];
#pragma unroll
    for (int a = 0; a < 2; ++a)
#pragma unroll
        for (int b = 0; b < 2; ++b)
#pragma unroll
            for (int m = 0; m < 4; ++m)
#pragma unroll
                for (int n = 0; n < 2; ++n) acc[a][b][m][n] = (f32x4){0.f, 0.f, 0.f, 0.f};
    bf16x8 At[4][2], B0[2][2], B1[2][2];
    const char* cA = (const char*)g.A + (size_t)cur.pm * tstep; const char* cB = (const char*)g.Bt + (size_t)cur.pn * tstep;
    S.a_ready(cur);
    if constexpr (SP2) {
        PG8_STAGE(PG8_SB(0, 0), cB, voffB); PG8_STAGE(PG8_SB(0, 1), cB + hstep, voffB); PG8_STAGE(PG8_SA(0, 0), cA, voffA); PG8_STAGE(PG8_SA(0, 1), cA + hstep, voffA);
        if (wr == 1) PG8_BAR;
        PG8_WAIT_V(2); PG8_BAR;
        PG8_STAGE(PG8_SB(1, 0), cB + kstep, voffB); PG8_STAGE(PG8_SA(1, 0), cA + kstep, voffA); PG8_STAGE(PG8_SB(1, 1), cB + hstep + kstep, voffB);
        PG8_WAIT_V(6); PG8_BAR;
    } else {
        PG8_STAGE(PG8_SB(0, 0), cB, voffB); PG8_STAGE(PG8_SA(0, 0), cA, voffA); PG8_STAGE(PG8_SB(0, 1), cB + hstep, voffB); PG8_STAGE(PG8_SA(0, 1), cA + hstep, voffA);
        if (wr == 1) PG8_BAR;
        PG8_WAIT_V(4); PG8_BAR;
        PG8_STAGE(PG8_SB(1, 0), cB + kstep, voffB); PG8_STAGE(PG8_SA(1, 0), cA + kstep, voffA); PG8_STAGE(PG8_SB(1, 1), cB + hstep + kstep, voffB);
        PG8_WAIT_V(6); PG8_BAR;
    }
    for (;;) {
        const bool has_next = S.next(ui + 1, nxt);
        const char* nA = has_next ? (const char*)g.A + (size_t)nxt.pm * tstep : cA; const char* nB = has_next ? (const char*)g.Bt + (size_t)nxt.pn * tstep : cB;
        _Pragma("nounroll") for (int t = 0; t < nt; t += 2) {
            const bool last = (t == nt - 2);
            const char* a1 = cA + (size_t)(t + 1) * kstep;
            const char* a2 = last ? nA : cA + (size_t)(t + 2) * kstep; const char* b2 = last ? nB : cB + (size_t)(t + 2) * kstep;
            const char* a3 = a2 + kstep; const char* b3 = b2 + kstep;
            if (last && has_next) S.a_ready(nxt);
            if constexpr (SP2) {
            PG8_LDB(B0, 0, 0); PG8_LDB(B1, 0, 1); PG8_SCHED; PG8_LDA(At, 0, 0); PG8_STAGE(PG8_SA(1, 1), a1 + hstep, voffA);
            PG8_WAIT_V(8); PG8_WAIT_L(0); PG8_BAR; PG8_MMA(0, 0, At, B0); PG8_MMA(0, 1, At, B1); PG8_BAR; PG8_SCHED;
            PG8_LDA(At, 0, 1); PG8_STAGE(PG8_SB(0, 0), b2, voffB); PG8_STAGE(PG8_SB(0, 1), b2 + hstep, voffB); PG8_STAGE(PG8_SA(0, 0), a2, voffA);
            PG8_WAIT_V(8); PG8_WAIT_L(0); PG8_BAR; PG8_MMA(1, 0, At, B0); PG8_MMA(1, 1, At, B1); PG8_BAR; PG8_SCHED;
            PG8_LDB(B0, 1, 0); PG8_LDB(B1, 1, 1); PG8_SCHED; PG8_LDA(At, 1, 0); PG8_STAGE(PG8_SA(0, 1), a2 + hstep, voffA);
            PG8_WAIT_V(8); PG8_WAIT_L(0); PG8_BAR; PG8_MMA(0, 0, At, B0); PG8_MMA(0, 1, At, B1); PG8_BAR; PG8_SCHED;
            PG8_LDA(At, 1, 1); PG8_STAGE(PG8_SB(1, 0), b3, voffB); PG8_STAGE(PG8_SB(1, 1), b3 + hstep, voffB); PG8_STAGE(PG8_SA(1, 0), a3, voffA);
            PG8_WAIT_V(8); PG8_WAIT_L(0); PG8_BAR; PG8_MMA(1, 0, At, B0); PG8_MMA(1, 1, At, B1); PG8_BAR; PG8_SCHED;
            } else {
            PG8_LDB(B0, 0, 0); PG8_SCHED; PG8_LDA(At, 0, 0); PG8_STAGE(PG8_SA(1, 1), a1 + hstep, voffA);
            PG8_WAIT_L(8); PG8_BAR; PG8_WAIT_L(0); PG8_MMA(0, 0, At, B0); PG8_BAR; PG8_SCHED;
            PG8_LDB(B1, 0, 1); PG8_STAGE(PG8_SB(0, 0), b2, voffB);
            PG8_BAR; PG8_WAIT_L(0); PG8_MMA(0, 1, At, B1); PG8_BAR;
            PG8_LDA(At, 0, 1); PG8_STAGE(PG8_SA(0, 0), a2, voffA);
            PG8_BAR; PG8_WAIT_L(0); PG8_MMA(1, 0, At, B0); PG8_BAR; PG8_SCHED;
            PG8_STAGE(PG8_SB(0, 1), b2 + hstep, voffB);
            PG8_WAIT_V(6); PG8_BAR; PG8_MMA(1, 1, At, B1); PG8_BAR;
            PG8_LDB(B0, 1, 0); PG8_SCHED; PG8_LDA(At, 1, 0); PG8_STAGE(PG8_SA(0, 1), a2 + hstep, voffA);
            PG8_WAIT_L(8); PG8_BAR; PG8_WAIT_L(0); PG8_MMA(0, 0, At, B0); PG8_BAR; PG8_SCHED;
            PG8_LDB(B1, 1, 1); PG8_STAGE(PG8_SB(1, 0), b3, voffB);
            PG8_BAR; PG8_WAIT_L(0); PG8_MMA(0, 1, At, B1); PG8_BAR;
            PG8_LDA(At, 1, 1); PG8_STAGE(PG8_SA(1, 0), a3, voffA);
            PG8_BAR; PG8_WAIT_L(0); PG8_MMA(1, 0, At, B0); PG8_BAR; PG8_SCHED;
            PG8_STAGE(PG8_SB(1, 1), b3 + hstep, voffB);
            PG8_WAIT_V(6); PG8_BAR; PG8_MMA(1, 1, At, B1); PG8_BAR;
            }
        }
        if constexpr (ALIGN_EPI) { if (wr == 0) PG8_BAR; }
        if constexpr (!Epi::AFTER_DRAIN) { E(acc, cur, wr, wc, fr, fq); S.done(cur); }
        if (!has_next) break;
#pragma unroll
        for (int a = 0; a < 2; ++a)
#pragma unroll
            for (int b = 0; b < 2; ++b)
#pragma unroll
                for (int m = 0; m < 4; ++m)
#pragma unroll
                    for (int n = 0; n < 2; ++n) acc[a][b][m][n] = (f32x4){0.f, 0.f, 0.f, 0.f};
        cur = nxt; cA = nA; cB = nB; ++ui;
        if constexpr (ALIGN_EPI) { if (wr == 1) PG8_BAR; }
    }
    PG8_WAIT_V(0);
    if constexpr (!ALIGN_EPI) { if (wr == 0) PG8_BAR; }
    PG8_BAR;
    if constexpr (Epi::AFTER_DRAIN) { E.fused(acc, cur, wr, wc, fr, fq, lds, wid, lane); S.done(cur); }
#undef PG8_SA
#undef PG8_SB
#undef PG8_STAGE
#undef PG8_LDA
#undef PG8_LDB
#undef PG8_MMA
#undef PG8_WAIT_V
#undef PG8_WAIT_L
#undef PG8_BAR
#undef PG8_SCHED
}
}
constexpr int NB = 16, SEQ = 4096, T = NB * SEQ, DM = 1024, DEPTH = 4;
constexpr int MLA_N = 1792;
constexpr int DSA_N = 3328;
constexpr float NORM_EPS = 1e-6f;
constexpr int NPHASE = 22;

constexpr size_t MiB = 1u << 20;
constexpr size_t WS_CTL = 0, CTL_ZERO_BYTES = 1 * MiB;
constexpr size_t WS_W = 2 * MiB;
constexpr size_t W_WINM = 0, W_WUQ = W_WINM + 2ull * MLA_N * 1024, W_WUK = W_WUQ + 2ull * 1536 * 256, W_WUV = W_WUK + 2ull * 1024 * 256,
                 W_WOM = W_WUV + 2ull * 1024 * 256, W_WIND = W_WOM + 2ull * 1024 * 1024, W_WOD = W_WIND + 2ull * DSA_N * 1024,
                 W_WP = W_WOD + 2ull * 1024 * 1024, W_WG = W_WP + 4ull * 1024 * 256, W_END = W_WG + 4ull * 1024 * 1024;
static_assert(WS_W + W_END * 2 <= 46 * MiB, "weights");
constexpr size_t WS_ROPE64 = 48 * MiB, WS_ROPE32 = 80 * MiB;
constexpr size_t WS_RSX = 96 * MiB, WS_RS1 = 100 * MiB, WS_RSQ = 104 * MiB, WS_RSKV = 105 * MiB;
constexpr size_t WS_PB = 112 * MiB;
constexpr size_t WS_XB0 = 144 * MiB;
constexpr size_t WS_SZ = 272 * MiB;
constexpr size_t WS_CQ = 400 * MiB, WS_CKV = 432 * MiB, WS_KPE = 464 * MiB;
constexpr size_t WS_QI = 400 * MiB, WS_KI = 464 * MiB, WS_WI = 472 * MiB;
constexpr size_t WS_Q = 480 * MiB;
constexpr size_t WS_PP = 480 * MiB;
constexpr size_t WS_KN = 672 * MiB, WS_V = 800 * MiB;
constexpr size_t WS_KD = 672 * MiB, WS_VD = 704 * MiB, WS_MASK = 736 * MiB;
constexpr size_t WS_XB1 = 672 * MiB;
constexpr size_t WS_END = 928 * MiB;
constexpr int CW_BAR = 4096;

constexpr int RING_BYTES = 131072;
constexpr int LDS_QIS = 131072;
constexpr int MISC_OFF = 159744;
constexpr int LDS_BYTES = 159744 + 512;
constexpr int NWAVES = 8;

#define GAS __attribute__((address_space(1)))
#define LAS __attribute__((address_space(3)))
typedef unsigned short bf16;
typedef unsigned v4u __attribute__((ext_vector_type(4)));
typedef float f32x4 __attribute__((ext_vector_type(4)));
typedef short bf16x8 __attribute__((ext_vector_type(8)));
typedef GAS unsigned gu32;
#define LDS_WAIT() asm volatile("s_waitcnt lgkmcnt(0)" ::: "memory")
#define VM_WAIT() asm volatile("s_waitcnt vmcnt(0)" ::: "memory")
__device__ __forceinline__ unsigned f2bf(float f) { unsigned u = __builtin_bit_cast(unsigned, f); return (u + 0x7fffu + ((u >> 16) & 1u)) >> 16; }
#define XB_TMO      128
#define XB_XCNT(j)  (256  + 64 * (j))
#define XB_XSUB(j)  (1280 + 64 * (j))
#define XB_XGEN(j)  (2304 + 64 * (j))
#define XB_TOP      3328
#define XB_TOPGEN   3392
#define XCD_BAR_WORDS 3456
#define XB_SPIN_CAP (1u << 25)

__device__ __forceinline__ unsigned xb_ld(unsigned* p)              { return __hip_atomic_load(p, __ATOMIC_RELAXED, __HIP_MEMORY_SCOPE_AGENT); }
__device__ __forceinline__ unsigned xb_add(unsigned* p, unsigned v) { return __hip_atomic_fetch_add(p, v, __ATOMIC_RELAXED, __HIP_MEMORY_SCOPE_AGENT); }
__device__ __forceinline__ unsigned xb_xcc_id() { return (unsigned)__builtin_amdgcn_s_getreg((3 << 11) | 20) & 0xFu; }
#define XB_SPIN(cond, bar) do { unsigned _sp = 0; while (cond) { __builtin_amdgcn_s_sleep(1); \
    if ((++_sp & 255u) == 0u) { if (xb_ld(&(bar)[XB_TMO])) break; if (_sp > XB_SPIN_CAP) { atomicAdd(&(bar)[XB_TMO], 1u); break; } } } } while (0)

struct XcdBarrier {
    unsigned* bar; unsigned x;
    volatile LAS unsigned* st;
};

__device__ __forceinline__ XcdBarrier xcd_barrier_post(unsigned* bar, volatile LAS unsigned* st) {
    XcdBarrier b; b.bar = bar; b.x = xb_xcc_id(); b.st = st;
    if (threadIdx.x == 0) (void)xb_add(&bar[XB_XCNT(b.x)], 1u);
    return b;
}
__device__ __forceinline__ void xcd_barrier_complete(unsigned* bar, unsigned x, unsigned& nloc, unsigned& nx) {
    const unsigned G = gridDim.x * gridDim.y * gridDim.z;
    unsigned sum, cnt, mine, sp = 0u;
    for (;;) {
        sum = 0u; cnt = 0u; mine = 0u;
#pragma unroll
        for (unsigned j = 0; j < 16; ++j) { const unsigned c = xb_ld(&bar[XB_XCNT(j)]); sum += c; cnt += (c > 0u) ? 1u : 0u; mine = (j == x) ? c : mine; }
        if (sum == G) break;
        __builtin_amdgcn_s_sleep(1);
        if ((++sp & 255u) == 0u) { if (xb_ld(&bar[XB_TMO])) break; if (sp > XB_SPIN_CAP) { atomicAdd(&bar[XB_TMO], 1u); break; } }
    }
    nloc = mine > 0u ? mine : 1u; nx = cnt > 0u ? cnt : 1u;
}

__device__ __forceinline__ void xcd_barrier(const XcdBarrier& b) {
    asm volatile("s_waitcnt vmcnt(0)" ::: "memory");
    __syncthreads();
    if (threadIdx.x == 0) {
        unsigned* bar = b.bar;
        __builtin_amdgcn_s_waitcnt(0);
        unsigned nloc = b.st[0], nx = b.st[1];
        if (nloc == 0u) { xcd_barrier_complete(bar, b.x, nloc, nx); b.st[0] = nloc; b.st[1] = nx; }
        const unsigned old = xb_add(&bar[XB_XSUB(b.x)], 1u);
        const unsigned gen = old / nloc;
        if (old + 1u == (gen + 1u) * nloc) {
            __builtin_amdgcn_fence(__ATOMIC_RELEASE, "agent");
            asm volatile("s_waitcnt vmcnt(0)" ::: "memory");
            const unsigned og = xb_add(&bar[XB_TOP], 1u);
            const unsigned tg = og / nx;
            if (og + 1u == (tg + 1u) * nx) xb_add(&bar[XB_TOPGEN], 1u);
            else XB_SPIN(xb_ld(&bar[XB_TOPGEN]) == tg, bar);
            __builtin_amdgcn_fence(__ATOMIC_ACQUIRE, "agent");
            xb_add(&bar[XB_XGEN(b.x)], 1u);
            asm volatile("s_waitcnt vmcnt(0)" ::: "memory");
        } else {
            XB_SPIN(xb_ld(&bar[XB_XGEN(b.x)]) == gen, bar);
            __builtin_amdgcn_fence(__ATOMIC_ACQUIRE, "agent");
            asm volatile("s_waitcnt vmcnt(0)" ::: "memory");
        }
    }
    __syncthreads();
}


typedef unsigned u32x2 __attribute__((ext_vector_type(2)));
__device__ __forceinline__ float bf2f(unsigned h) { return __builtin_bit_cast(float, h << 16); }
typedef __bf16 bf16x2_t __attribute__((ext_vector_type(2)));
typedef float f32x2_t __attribute__((ext_vector_type(2)));
__device__ __forceinline__ unsigned cvtpk(float lo, float hi) { const f32x2_t v = {lo, hi}; return __builtin_bit_cast(unsigned, __builtin_convertvector(v, bf16x2_t)); }
__device__ __forceinline__ v4u pack8(f32x4 a, f32x4 b) { v4u w; w.x = cvtpk(a[0], a[1]); w.y = cvtpk(a[2], a[3]); w.z = cvtpk(b[0], b[1]); w.w = cvtpk(b[2], b[3]); return w; }
__device__ __forceinline__ float wave_sum(float v) {
#pragma unroll
    for (int o = 1; o < 64; o <<= 1) v += __shfl_xor(v, o);
    return v;
}
__device__ __forceinline__ float wave_max(float v) {
#pragma unroll
    for (int o = 1; o < 64; o <<= 1) v = fmaxf(v, __shfl_xor(v, o));
    return v;
}
__device__ __forceinline__ int wave_sum_i(int v) {
#pragma unroll
    for (int o = 1; o < 64; o <<= 1) v += __shfl_xor(v, o);
    return v;
}
__device__ __forceinline__ float sum16_rstd(const float* rs, int row, float invn) {
    const f32x4* p = (const f32x4*)(rs + (size_t)row * 16); const f32x4 a = p[0], b = p[1], c = p[2], d = p[3];
    const float s = ((a[0] + a[1]) + (a[2] + a[3])) + ((b[0] + b[1]) + (b[2] + b[3])) + ((c[0] + c[1]) + (c[2] + c[3])) + ((d[0] + d[1]) + (d[2] + d[3]));
    return rsqrtf(s * invn + NORM_EPS);
}
__device__ __forceinline__ float sum4_rstd(const float* rs, int row, float invn) {
    const f32x4 a = *(const f32x4*)(rs + (size_t)row * 4); return rsqrtf(((a[0] + a[1]) + (a[2] + a[3])) * invn + NORM_EPS);
}
__device__ __forceinline__ float silu_f(float v) { return v * __builtin_amdgcn_rcpf(1.f + __expf(-v)); }
__device__ __forceinline__ float sigmoid_f(float v) { return __builtin_amdgcn_rcpf(1.f + __expf(-v)); }
__device__ __forceinline__ float sq4(f32x4 v) { return (v[0] * v[0] + v[1] * v[1]) + (v[2] * v[2] + v[3] * v[3]); }
__device__ __forceinline__ void rope8(f32x4& v0, f32x4& v1, const f32x4 c0, const f32x4 c1) {
    f32x4 o0, o1;
    o0[0] = v0[0] * c0[0] - v0[1] * c0[1]; o0[1] = v0[1] * c0[0] + v0[0] * c0[1];
    o0[2] = v0[2] * c0[2] - v0[3] * c0[3]; o0[3] = v0[3] * c0[2] + v0[2] * c0[3];
    o1[0] = v1[0] * c1[0] - v1[1] * c1[1]; o1[1] = v1[1] * c1[0] + v1[0] * c1[1];
    o1[2] = v1[2] * c1[2] - v1[3] * c1[3]; o1[3] = v1[3] * c1[2] + v1[2] * c1[3];
    v0 = o0; v1 = o1;
}
typedef _Float16 f16x2_t __attribute__((ext_vector_type(2)));
__device__ __forceinline__ unsigned pack_cs(float c, float sn) { const f16x2_t h = {(_Float16)c, (_Float16)sn}; return __builtin_bit_cast(unsigned, h); }
__device__ __forceinline__ f16x2_t as_h2(unsigned u) { return __builtin_bit_cast(f16x2_t, u); }
__device__ __forceinline__ void rope8h(f32x4& v0, f32x4& v1, const v4u w) {
    f32x4 c0, c1;
#pragma unroll
    for (int e = 0; e < 2; ++e) { const f16x2_t a = as_h2(w[e]), b = as_h2(w[2 + e]);
        c0[2 * e] = (float)a[0]; c0[2 * e + 1] = (float)a[1]; c1[2 * e] = (float)b[0]; c1[2 * e + 1] = (float)b[1]; }
    rope8(v0, v1, c0, c1);
}


namespace att {
constexpr int NW = 8, QBLK = 32, KVBLK = 64, QB = NW * QBLK, D = 128;
constexpr int KROW = D * 2 + 16, SHM_V = KVBLK * D * 2, SHM_K = KVBLK * KROW, KPROW = 144, SHM_KP = KVBLK * KPROW;
constexpr int OFF_V = 0, OFF_K = 2 * SHM_V, OFF_WS = OFF_K + 2 * SHM_K, OFF_KP = OFF_WS + NW * 64 * 4, OFF_QP = OFF_KP + 2 * SHM_KP, LDS_NEED = OFF_QP + NW * QBLK * 272;
constexpr float THR = 8.f;
typedef short s16x4 __attribute__((ext_vector_type(4)));
typedef float f32x16 __attribute__((ext_vector_type(16)));

#define KSWZ(row, colB) ((row) * KROW + (colB))
#define KPSWZ(row, ch) ((row) * KPROW + ((ch) << 4))
#define SBAR() __builtin_amdgcn_sched_barrier(0)
__device__ __forceinline__ int v_st(int k, int c) { const int kk = (k & ~0xC) | ((k & 4) << 1) | ((k & 8) >> 1); return ((kk >> 3) * 4 + (c >> 5)) * 512 + ((kk & 7) * 32 + (c & 31)) * 2; }
__device__ __forceinline__ int v_rd_base(int lane) { return ((lane & 3) << 3) | (((lane >> 2) & 3) << 6) | (((lane >> 4) & 1) << 5) | (((lane >> 5) & 1) << 8); }
constexpr int v_rd_off(int d0, int ks, int half) { return d0 * 512 + ks * 4096 + half * 2048; }
__device__ __forceinline__ int crow(int r, int hi) { return (r & 3) + 8 * (r >> 2) + 4 * hi; }
__device__ __forceinline__ bf16x8 load8(const bf16* p) { return *reinterpret_cast<const bf16x8*>(p); }
__device__ __forceinline__ unsigned long long gld_u64(const unsigned long long* ubase, unsigned voff) {
    const unsigned long long b_ = (unsigned long long)ubase;
    const unsigned lo_ = __builtin_amdgcn_readfirstlane((unsigned)b_), hi_ = __builtin_amdgcn_readfirstlane((unsigned)(b_ >> 32));
    __amdgpu_buffer_rsrc_t r_ = __builtin_amdgcn_make_buffer_rsrc((void*)(((unsigned long long)hi_ << 32) | lo_), (short)0, 0x7fffffff, 0x00020000);
    typedef unsigned u32x2_ __attribute__((ext_vector_type(2)));
    const u32x2_ w_ = __builtin_amdgcn_raw_buffer_load_b64(r_, (int)voff, 0, 0); return ((unsigned long long)w_.y << 32) | w_.x; }
__device__ __forceinline__ bf16x8 gld8(const bf16* ubase, unsigned voff) {
    const unsigned long long b_ = (unsigned long long)ubase;
    const unsigned lo_ = __builtin_amdgcn_readfirstlane((unsigned)b_), hi_ = __builtin_amdgcn_readfirstlane((unsigned)(b_ >> 32));
    __amdgpu_buffer_rsrc_t r_ = __builtin_amdgcn_make_buffer_rsrc((void*)(((unsigned long long)hi_ << 32) | lo_), (short)0, 0x7fffffff, 0x00020000);
    const v4u w_ = __builtin_amdgcn_raw_buffer_load_b128(r_, (int)voff, 0, 0); return __builtin_bit_cast(bf16x8, w_); }

__device__ __forceinline__ unsigned selbits(unsigned m, int c) { unsigned t; asm("v_bfe_i32 %0, %1, %2, 1" : "=v"(t) : "v"(m), "n"(c)); return t; }
__device__ __forceinline__ void mask_tile(f32x16& p0, f32x16& p1, int dq) {
    const float NEG = -__builtin_inff();
#pragma unroll
    for (int r = 0; r < 16; ++r) {
        const int c = (r & 3) + 8 * (r >> 2);
        if (dq - c < 0) p0[r] = NEG;
        if (dq - c - 32 < 0) p1[r] = NEG;
    }
}
template <bool MASKED>
__device__ __forceinline__ void partialSM(f32x16& p0, f32x16& p1, float& m_reg, float& mn, float& alpha, const float SCALE, unsigned mlo) {
    float pmax = p0[0]; for (int r = 1; r < 16; ++r) pmax = fmaxf(pmax, p0[r]); for (int r = 0; r < 16; ++r) pmax = fmaxf(pmax, p1[r]);
    { auto rr = __builtin_amdgcn_permlane32_swap(__float_as_uint(pmax), __float_as_uint(pmax), false, false);
      pmax = fmaxf(__uint_as_float(rr[0]), __uint_as_float(rr[1])); }
    const float C2 = 1.4426950408889634f * SCALE;
    if (__builtin_expect(__all((pmax - m_reg) * SCALE <= THR), 1)) { mn = m_reg; alpha = 1.f; }
    else { mn = fmaxf(m_reg, pmax); alpha = __builtin_amdgcn_exp2f((m_reg - mn) * C2); m_reg = mn; }
    const float mnL = -mn * C2;
    for (int r = 0; r < 16; ++r) p0[r] = fmaf(p0[r], C2, mnL); for (int r = 0; r < 16; ++r) p1[r] = fmaf(p1[r], C2, mnL);
    for (int r = 0; r < 16; ++r) p0[r] = __builtin_amdgcn_exp2f(p0[r]);
    if (MASKED) {
#pragma unroll
        for (int r = 0; r < 16; ++r) { const int c = (r & 3) + 8 * (r >> 2); p0[r] = __uint_as_float(__float_as_uint(p0[r]) & selbits(mlo, c)); }
    }
}
template <bool MASKED>
__device__ __forceinline__ void finishSM(f32x16& p0, f32x16& p1, float alpha, float& l_reg, bf16x8& pa0, bf16x8& pa1, bf16x8& pa2, bf16x8& pa3, unsigned mhi) {
    for (int r = 0; r < 16; ++r) p1[r] = __builtin_amdgcn_exp2f(p1[r]);
    if (MASKED) {
#pragma unroll
        for (int r = 0; r < 16; ++r) { const int c = (r & 3) + 8 * (r >> 2); p1[r] = __uint_as_float(__float_as_uint(p1[r]) & selbits(mhi, c)); }
    }
    float ps = 0; for (int r = 0; r < 16; ++r) ps += p0[r]; for (int r = 0; r < 16; ++r) ps += p1[r];
    { auto rr = __builtin_amdgcn_permlane32_swap(__float_as_uint(ps), __float_as_uint(ps), false, false);
      ps = __uint_as_float(rr[0]) + __uint_as_float(rr[1]); }
    l_reg = l_reg * alpha + ps;
#define PK4(P, B_, OUT) do { unsigned a0 = cvtpk(P[B_+0], P[B_+1]), a1 = cvtpk(P[B_+2], P[B_+3]);                          \
        unsigned b0 = cvtpk(P[B_+4], P[B_+5]), b1 = cvtpk(P[B_+6], P[B_+7]);                                             \
        auto r0 = __builtin_amdgcn_permlane32_swap(a0, b0, false, false); auto r1 = __builtin_amdgcn_permlane32_swap(a1, b1, false, false); \
        v4u w = {r0[0], r1[0], r0[1], r1[1]}; OUT = *reinterpret_cast<bf16x8*>(&w); } while (0)
    PK4(p0, 0, pa0); PK4(p0, 8, pa1); PK4(p1, 0, pa2); PK4(p1, 8, pa3);
#undef PK4
}
template <int KB, bool PE>
__device__ __forceinline__ void qkt(f32x16& p0, f32x16& p1, const char* lds, int r32, int hi, const bf16x8* qr, int kpb, int qpb) {
    p0 = f32x16{}; p1 = f32x16{};
    const char* kb[4];
#pragma unroll
    for (int dd = 0; dd < 4; ++dd) kb[dd] = lds + OFF_K + KB * SHM_K + KSWZ(r32, (dd * 16 + hi * 8) * 2);
    const char* qp_ = lds + qpb;
#pragma unroll
    for (int d0 = 0; d0 < 8; ++d0) { const char* a = kb[d0 & 3] + (d0 >> 2) * 128;
        bf16x8 b0 = *reinterpret_cast<const bf16x8*>(a);
        bf16x8 b1 = *reinterpret_cast<const bf16x8*>(a + 32 * KROW);
        bf16x8 qf; if (d0 >= 4) qf = *reinterpret_cast<const bf16x8*>(qp_ + (d0 - 4) * 32); else qf = qr[d0];
        p0 = __builtin_amdgcn_mfma_f32_32x32x16_bf16(b0, qf, p0, 0, 0, 0);
        p1 = __builtin_amdgcn_mfma_f32_32x32x16_bf16(b1, qf, p1, 0, 0, 0); }
    if (PE) {
        const char* kp_ = lds + kpb;
#pragma unroll
        for (int d0 = 0; d0 < 4; ++d0) {
            bf16x8 b0 = *reinterpret_cast<const bf16x8*>(kp_ + (KB * SHM_KP + d0 * 32));
            bf16x8 b1 = *reinterpret_cast<const bf16x8*>(kp_ + (KB * SHM_KP + d0 * 32 + 32 * KPROW));
            const bf16x8 qf = *reinterpret_cast<const bf16x8*>(qp_ + 128 + d0 * 32);
            p0 = __builtin_amdgcn_mfma_f32_32x32x16_bf16(b0, qf, p0, 0, 0, 0);
            p1 = __builtin_amdgcn_mfma_f32_32x32x16_bf16(b1, qf, p1, 0, 0, 0); }
    }
}
template <int VB>
__device__ __forceinline__ void pv_tile(f32x16* o, int vb0, bf16x8 pa0, bf16x8 pa1, bf16x8 pa2, bf16x8 pa3) {
#define TRRD(dst, off) asm volatile("ds_read_b64_tr_b16 %0, %1 offset:%2" : "=&v"(dst) : "v"(vb0), "i"(off) : "memory")
#define PV_D0(d0) do { s16x4 l0, l1, l2, l3, h0, h1, h2, h3; constexpr int b_ = OFF_V + VB * SHM_V + v_rd_off(d0, 0, 0); \
        TRRD(l0, b_); TRRD(h0, b_ + 2048); TRRD(l1, b_ + 4096); TRRD(h1, b_ + 6144); TRRD(l2, b_ + 8192); TRRD(h2, b_ + 10240); TRRD(l3, b_ + 12288); TRRD(h3, b_ + 14336); \
        asm volatile("s_waitcnt lgkmcnt(0)" ::: "memory"); SBAR();   \
        o[d0] = __builtin_amdgcn_mfma_f32_32x32x16_bf16(pa0, (bf16x8){l0[0], l0[1], l0[2], l0[3], h0[0], h0[1], h0[2], h0[3]}, o[d0], 0, 0, 0);   \
        o[d0] = __builtin_amdgcn_mfma_f32_32x32x16_bf16(pa1, (bf16x8){l1[0], l1[1], l1[2], l1[3], h1[0], h1[1], h1[2], h1[3]}, o[d0], 0, 0, 0);   \
        o[d0] = __builtin_amdgcn_mfma_f32_32x32x16_bf16(pa2, (bf16x8){l2[0], l2[1], l2[2], l2[3], h2[0], h2[1], h2[2], h2[3]}, o[d0], 0, 0, 0);   \
        o[d0] = __builtin_amdgcn_mfma_f32_32x32x16_bf16(pa3, (bf16x8){l3[0], l3[1], l3[2], l3[3], h3[0], h3[1], h3[2], h3[3]}, o[d0], 0, 0, 0); } while (0)
    PV_D0(0); PV_D0(1); PV_D0(2); PV_D0(3);
#undef PV_D0
#undef TRRD
}

template <int VB, bool MASKED>
__device__ __forceinline__ void pv_sm(f32x16* o, int vb0, bf16x8 pa0, bf16x8 pa1, bf16x8 pa2, bf16x8 pa3,
                                      f32x16& p0, f32x16& p1, float& m_reg, float& mn, float& alpha, const float SCALE, unsigned mlo) {
#define TRRD(dst, off) asm volatile("ds_read_b64_tr_b16 %0, %1 offset:%2" : "=&v"(dst) : "v"(vb0), "i"(off) : "memory")
#define PVS_LD(d0) s16x4 l0, l1, l2, l3, h0, h1, h2, h3; { constexpr int b_ = OFF_V + VB * SHM_V + v_rd_off(d0, 0, 0); \
        TRRD(l0, b_); TRRD(h0, b_ + 2048); TRRD(l1, b_ + 4096); TRRD(h1, b_ + 6144); TRRD(l2, b_ + 8192); TRRD(h2, b_ + 10240); TRRD(l3, b_ + 12288); TRRD(h3, b_ + 14336); \
        asm volatile("s_waitcnt lgkmcnt(0)" ::: "memory"); SBAR(); }
#define PVS_MM(d0) do { \
        o[d0] = __builtin_amdgcn_mfma_f32_32x32x16_bf16(pa0, (bf16x8){l0[0], l0[1], l0[2], l0[3], h0[0], h0[1], h0[2], h0[3]}, o[d0], 0, 0, 0);   \
        o[d0] = __builtin_amdgcn_mfma_f32_32x32x16_bf16(pa1, (bf16x8){l1[0], l1[1], l1[2], l1[3], h1[0], h1[1], h1[2], h1[3]}, o[d0], 0, 0, 0);   \
        o[d0] = __builtin_amdgcn_mfma_f32_32x32x16_bf16(pa2, (bf16x8){l2[0], l2[1], l2[2], l2[3], h2[0], h2[1], h2[2], h2[3]}, o[d0], 0, 0, 0);   \
        o[d0] = __builtin_amdgcn_mfma_f32_32x32x16_bf16(pa3, (bf16x8){l3[0], l3[1], l3[2], l3[3], h3[0], h3[1], h3[2], h3[3]}, o[d0], 0, 0, 0); } while (0)
#define PVS_SGB(nv) do { _Pragma("unroll") for (int g_ = 0; g_ < 4; ++g_) { __builtin_amdgcn_sched_group_barrier(0x008, 1, 0); __builtin_amdgcn_sched_group_barrier(0x402, nv, 0); } } while (0)
    const float C2 = 1.4426950408889634f * SCALE;
    float pmax, mnL;
    { PVS_LD(0); PVS_MM(0);
      float pm0 = p0[0], pm1 = p1[0];
#pragma unroll
      for (int r = 1; r < 16; ++r) { pm0 = fmaxf(pm0, p0[r]); pm1 = fmaxf(pm1, p1[r]); }
      pmax = fmaxf(pm0, pm1);
      { auto rr = __builtin_amdgcn_permlane32_swap(__float_as_uint(pmax), __float_as_uint(pmax), false, false);
        pmax = fmaxf(__uint_as_float(rr[0]), __uint_as_float(rr[1])); }
      PVS_SGB(5); }
    { PVS_LD(1); PVS_MM(1);
      const bool keep = __all((pmax - m_reg) * SCALE <= THR);
      mn = keep ? m_reg : fmaxf(m_reg, pmax); alpha = keep ? 1.f : __builtin_amdgcn_exp2f((m_reg - mn) * C2); m_reg = mn;
      mnL = -mn * C2;
#pragma unroll
      for (int r = 0; r < 16; ++r) p0[r] = fmaf(p0[r], C2, mnL);
      PVS_SGB(7); }
    { PVS_LD(2); PVS_MM(2);
#pragma unroll
      for (int r = 0; r < 16; ++r) p1[r] = fmaf(p1[r], C2, mnL);
#pragma unroll
      for (int r = 0; r < 6; ++r) p0[r] = __builtin_amdgcn_exp2f(p0[r]);
      PVS_SGB(6); }
    { PVS_LD(3); PVS_MM(3);
#pragma unroll
      for (int r = 6; r < 16; ++r) p0[r] = __builtin_amdgcn_exp2f(p0[r]);
      if (MASKED) {
#pragma unroll
          for (int r = 0; r < 16; ++r) { const int c = (r & 3) + 8 * (r >> 2); p0[r] = __uint_as_float(__float_as_uint(p0[r]) & selbits(mlo, c)); }
      }
      asm volatile("" : "+v"(p0), "+v"(p1));
      PVS_SGB(MASKED ? 8 : 3); }
#undef PVS_LD
#undef PVS_MM
#undef PVS_SGB
#undef TRRD
}

struct BlockRef { const bf16* Q; const bf16* K; const bf16* V; const bf16* KP; bf16* O; const unsigned long long* M; int P0; };
template <bool PE> struct Seam { bf16x8 qr[4]; bf16x8 qx[PE ? 8 : 4]; bf16x8 st_v0, st_v1, st_k0, st_k1, st_kp; };

#define VMW() asm volatile("s_waitcnt vmcnt(0)" ::: "memory")
#define VMWN(n) asm volatile("s_waitcnt vmcnt(%0)" :: "i"(n) : "memory")
#define SLOAD_H(Kp, Vp, KPp, k0) do { S.st_v0 = gld8((Vp) + (size_t)(k0) * LDV, voffkv); S.st_v1 = gld8((Vp) + (size_t)((k0) + 32) * LDV, voffkv);     \
                         S.st_k0 = gld8((Kp) + (size_t)(k0) * LDK, voffkv); S.st_k1 = gld8((Kp) + (size_t)((k0) + 32) * LDK, voffkv);                       \
                         if (PE) S.st_kp = gld8((KPp) + (size_t)(k0) * 64, voffkp); } while (0)
#define SWRITE_HK(bf) do { *(bf16x8*)(lds + OFF_K + (bf) * SHM_K + kws) = S.st_k0; *(bf16x8*)(lds + OFF_K + (bf) * SHM_K + kws + 32 * KROW) = S.st_k1;   \
                           if (PE) *(bf16x8*)(lds + kpws + (bf) * SHM_KP) = S.st_kp; } while (0)
#define SWRITE_HV(bf) do { *(bf16x8*)(lds + OFF_V + (bf) * SHM_V + vst0) = S.st_v0; *(bf16x8*)(lds + OFF_V + (bf) * SHM_V + vst1) = S.st_v1; } while (0)
#define SWRITE_H(bf) do { SWRITE_HV(bf); SWRITE_HK(bf); } while (0)
#define QLOAD(ref) do { _Pragma("unroll") for (int d0 = 0; d0 < 4; ++d0) S.qr[d0] = gld8((ref).Q + d0 * 16, voffq); } while (0)
#define QXLOAD(ref) do { _Pragma("unroll") for (int c_ = 0; c_ < QX / 16; ++c_) S.qx[c_] = gld8((ref).Q + (size_t)(c_ * (512 / QX)) * LDQ, voffqx); } while (0)
#define QXWRITE() do { _Pragma("unroll") for (int c_ = 0; c_ < QX / 16; ++c_) *(bf16x8*)(lds + qxw + c_ * (512 / QX) * QXROW) = S.qx[c_]; } while (0)

#define ATT_LANE_CONSTS \
    constexpr int QX = PE ? 128 : 64, QXROW = 2 * QX + 16, SHM_QP = QBLK * QXROW, CPR = QX / 8;                                                  \
    const int tid = threadIdx.x, wid = __builtin_amdgcn_readfirstlane(tid >> 6), lane = tid & 63, r32 = lane & 31, hi = lane >> 5;             \
    const int sr = tid >> 4, sc = (tid & 15) * 8, kws = KSWZ(sr, sc * 2), kpws = OFF_KP + KPSWZ(tid >> 3, tid & 7);                            \
    const unsigned voffkv = (unsigned)(sr * LDK + sc) * 2u, voffkp = (unsigned)((tid >> 3) * 64 + (tid & 7) * 8) * 2u;                          \
    const unsigned voffq = (unsigned)((wid * QBLK + r32) * LDQ + hi * 8) * 2u, voffqx = (unsigned)((wid * QBLK + lane / CPR) * LDQ + 64 + (lane % CPR) * 8) * 2u; \
    const int qxw = OFF_QP + wid * SHM_QP + (lane / CPR) * QXROW + (lane % CPR) * 16;
template <bool PE, bool MASKED, int LDQ, int LDK, int LDV>
__device__ __forceinline__ void attn_prime(const BlockRef& cur, char* lds, Seam<PE>& S) {
    static_assert(LDK == LDV, "k and v share the staging offset");
    ATT_LANE_CONSTS
    (void)kws; (void)kpws; (void)qxw; (void)r32; (void)hi;
    QLOAD(cur); QXLOAD(cur);
    SLOAD_H(cur.K, cur.V, cur.KP, 0); VMW(); SWRITE_HK(0);
    __syncthreads();
}
template <bool PE, bool MASKED, int LDQ, int LDK, int LDV, bool DRY>
__device__ __forceinline__ void attn_block(const BlockRef& cur, const BlockRef& nxt, char* lds, Seam<PE>& S, const float SCALE, const bool rdry, const float* psrc, bf16* pdst, const int kblk) {
    ATT_LANE_CONSTS
    const int NT = (cur.P0 + QB - 1) / KVBLK + 1;
    const int qlo = cur.P0 + wid * QBLK, qm = qlo + r32 - 4 * hi;
    float* ws = (float*)(lds + OFF_WS) + wid * 64; float* li_l = ws, * al_l = ws + 32;
    float m_reg = -1e30f, l_reg = 0; f32x16 o[4] = {};
    const int vst0 = v_st(sr, sc), vst1 = v_st(32 + sr, sc);
    const int vb0 = (int)(uintptr_t)lds + v_rd_base(lane);
    const int kpb = OFF_KP + r32 * KPROW + hi * 16, qpb = OFF_QP + wid * SHM_QP + r32 * QXROW + hi * 16 - (PE ? 0 : 0);
    const bf16* Kh = cur.K; const bf16* Vh = cur.V; const bf16* KPh = cur.KP;
    const unsigned voffm = (unsigned)(wid * QBLK + r32) * 512u;
#define RESC(a) do { if (__any((a) < 1.f)) { if (hi == 0) al_l[r32] = (a); asm volatile("s_waitcnt lgkmcnt(0)" ::: "memory");              \
                     for (int d_ = 0; d_ < 4; ++d_) for (int r = 0; r < 16; ++r) o[d_][r] *= al_l[crow(r, hi)]; } } while (0)
#define KBASE(t) ((t) * KVBLK)
#define MASKT(P0_, P1_, t) do { if (!MASKED) { const int kb_ = KBASE(t); if (kb_ + KVBLK - 1 > qlo) mask_tile(P0_, P1_, qm - kb_); } } while (0)
#define MLOAD(mw, t) do { if (MASKED) mw = gld_u64(cur.M + (t), voffm); } while (0)
#define MLO(mw) ((unsigned)(mw) >> (4 * hi))
#define MHI(mw) ((unsigned)((mw) >> 32) >> (4 * hi))
    constexpr int NQL = 4;
#define SEAM_K0() do { VMWN(NQL); SWRITE_HK(0); SBAR(); } while (0)
    f32x16 pA0, pA1, pB0, pB1; float mnA, mnB, alA, alB; bf16x8 pa0, pa1, pa2, pa3; unsigned long long mwA = 0, mwB = 0;
    QXWRITE(); SWRITE_HV(0); SBAR();
    if (NT > 1) SLOAD_H(Kh, Vh, KPh, KBASE(1));
    MLOAD(mwA, 0);
    SBAR(); qkt<0, PE>(pA0, pA1, lds, r32, hi, S.qr, kpb, qpb);
    MASKT(pA0, pA1, 0); partialSM<MASKED>(pA0, pA1, m_reg, mnA, alA, SCALE, MLO(mwA));
    if (NT > 1) { VMW(); SWRITE_H(1); }
    __syncthreads();
#define SGB_(mask, n) __builtin_amdgcn_sched_group_barrier(mask, n, 0)
#define SGB_STEP(nrd, nva) do { SGB_(0x100, nrd); SGB_(0x008, 1); SGB_(0x402, nva); SGB_(0x008, 1); SGB_(0x402, nva); } while (0)
#define SGB_QK_FIN() do { constexpr int NV_ = MASKED ? 6 : 3; SGB_(0x100, 2);                                              \
        SGB_STEP(2, NV_); SGB_STEP(2, NV_); SGB_STEP(2, NV_); SGB_STEP(3, NV_); SGB_STEP(3, NV_); SGB_STEP(3, NV_); SGB_STEP(3, NV_);                      \
        if (PE) { SGB_STEP(3, NV_); SGB_STEP(3, NV_); SGB_STEP(3, NV_); SGB_STEP(3, NV_); SGB_STEP(0, NV_); } else SGB_STEP(0, NV_); } while (0)
#define HALF_STEP(PX0, PX1, mnX, alX, mwX, PY0, PY1, alY, mwY, t, KB, VB, SB) do {                                            \
        SBAR(); MLOAD(mwX, t); qkt<KB, PE>(PX0, PX1, lds, r32, hi, S.qr, kpb, qpb);                                                \
        finishSM<MASKED>(PY0, PY1, alY, l_reg, pa0, pa1, pa2, pa3, MHI(mwY)); SGB_QK_FIN(); SBAR();                            \
        if ((t) + 1 < NT) { SLOAD_H(Kh, Vh, KPh, KBASE((t) + 1)); SBAR(); }                                                    \
        MASKT(PX0, PX1, (t)); SBAR(); pv_sm<VB, MASKED>(o, vb0, pa0, pa1, pa2, pa3, PX0, PX1, m_reg, mnX, alX, SCALE, MLO(mwX));                   \
        __syncthreads();                                                                                                      \
        if ((t) + 1 < NT) { VMW(); SWRITE_H(SB); }                                                                            \
        RESC(alX); __syncthreads(); } while (0)
    for (int t = 1; t + 1 < NT; t += 2) {
        HALF_STEP(pB0, pB1, mnB, alB, mwB, pA0, pA1, alA, mwA, t, 1, 0, 0);
        HALF_STEP(pA0, pA1, mnA, alA, mwA, pB0, pB1, alB, mwB, t + 1, 0, 1, 1);
    }
    const bool even = (NT & 1) == 0;
    (void)even;
    MLOAD(mwB, NT - 1);
    SBAR();
    const unsigned voffg = (unsigned)((wid * QBLK + (lane >> 4)) * 1024 + (lane & 15) * 8) * 2u;
    bf16x8 szq[8];
#pragma unroll
    for (int j = 0; j < 8; ++j) szq[j] = gld8(cur.O + (size_t)(4 * j) * 1024, voffg);
    constexpr size_t PNCH = (size_t)NB * 4096 * 256 / 8;
    f32x4 pcv[2][2]; size_t pcc[2];
    { const size_t gth_ = (size_t)gridDim.x * (NW * 64), gid_ = (size_t)blockIdx.x * (NW * 64) + tid;
#pragma unroll
      for (int u = 0; u < 2; ++u) { const size_t c_ = (size_t)(kblk * 2 + u) * gth_ + gid_; pcc[u] = c_; const size_t cl_ = c_ < PNCH ? c_ : PNCH - 1;
          pcv[u][0] = *(const f32x4*)(psrc + cl_ * 8); pcv[u][1] = *(const f32x4*)(psrc + cl_ * 8 + 4); } }
    SBAR(); qkt<1, PE>(pB0, pB1, lds, r32, hi, S.qr, kpb, qpb);
    finishSM<MASKED>(pA0, pA1, alA, l_reg, pa0, pa1, pa2, pa3, MHI(mwA)); SGB_QK_FIN(); SBAR();
    MASKT(pB0, pB1, NT - 1); SBAR(); pv_sm<0, MASKED>(o, vb0, pa0, pa1, pa2, pa3, pB0, pB1, m_reg, mnB, alB, SCALE, MLO(mwB));
    SBAR(); SLOAD_H(nxt.K, nxt.V, nxt.KP, 0); SBAR();
    QLOAD(nxt);
    SBAR();
    __syncthreads(); RESC(alB);
    finishSM<MASKED>(pB0, pB1, alB, l_reg, pa0, pa1, pa2, pa3, MHI(mwB)); SBAR();
    pv_tile<1>(o, vb0, pa0, pa1, pa2, pa3);
    SBAR(); SEAM_K0(); QXLOAD(nxt); SBAR();
    if (hi == 0) li_l[r32] = l_reg; asm volatile("s_waitcnt lgkmcnt(0)" ::: "memory");
    float rli[16];
#pragma unroll
    for (int r = 0; r < 16; ++r) rli[r] = __builtin_amdgcn_rcpf(li_l[crow(r, hi)]);
    char* stg = lds + OFF_QP + wid * (QBLK * 272) + (4 * hi) * 272 + r32 * 2;
#pragma unroll
    for (int d0 = 0; d0 < 4; ++d0)
#pragma unroll
        for (int r = 0; r < 16; r += 2) { const unsigned w = cvtpk(o[d0][r] * rli[r], o[d0][r + 1] * rli[r + 1]);
            *(unsigned short*)(stg + ((r & 3) + 8 * (r >> 2)) * 272 + d0 * 64) = (unsigned short)w;
            *(unsigned short*)(stg + (((r + 1) & 3) + 8 * ((r + 1) >> 2)) * 272 + d0 * 64) = (unsigned short)(w >> 16); }
    asm volatile("s_waitcnt lgkmcnt(0)" ::: "memory");
    const char* strd = lds + OFF_QP + wid * (QBLK * 272) + (lane >> 4) * 272 + (lane & 15) * 16;
#pragma unroll
    for (int j = 0; j < 8; ++j) { const v4u ow = *(const v4u*)(strd + (4 * j) * 272); const v4u zw = __builtin_bit_cast(v4u, szq[j]); v4u gw;
#pragma unroll
        for (int e = 0; e < 4; ++e) gw[e] = cvtpk(__uint_as_float(ow[e] << 16) * __uint_as_float(zw[e] << 16), __uint_as_float(ow[e] & 0xffff0000u) * __uint_as_float(zw[e] & 0xffff0000u));
        v4u* gp = (v4u*)((char*)(cur.O + (size_t)(4 * j) * 1024) + voffg);
        if (!DRY && !rdry) *gp = gw; else asm volatile("" :: "v"(gw)); }
#pragma unroll
    for (int u = 0; u < 2; ++u) { const v4u pw = pack8(pcv[u][0], pcv[u][1]); if (pcc[u] < PNCH) *(v4u*)(pdst + pcc[u] * 8) = pw; }
    __syncthreads();
#undef RESC
#undef KBASE
#undef MASKT
#undef MLOAD
#undef MLO
#undef MHI
#undef SEAM_K0
#undef HALF_STEP
}
#undef VMW
#undef VMWN
#undef SLOAD_H
#undef SWRITE_HK
#undef SWRITE_HV
#undef SWRITE_H
#undef QLOAD
#undef QXLOAD
#undef QXWRITE

struct Item { int bh, qb0, qb1; };
__device__ __forceinline__ Item decode(int L, int nhkv) {
    const int Gq = 8 / nhkv, xcd = L & 7, k = L >> 3, per = Gq * 8, gi = k / per, r = k - gi * per;
    Item it; it.bh = (gi * 8 + xcd) * Gq + r / 8; const int x = r % 8; it.qb0 = x; it.qb1 = 15 - x; return it;
}
template <bool PE, bool MASKED, int LDQ, int QH, int LDK, int LDV, int NHKV>
__device__ __forceinline__ BlockRef make_ref(const Item& it, int pass, const bf16* Q, const bf16* K, const bf16* V, const bf16* KP, bf16* O, const unsigned long long* M) {
    const int qb = pass ? it.qb1 : it.qb0, b = it.bh >> 3, h = it.bh & 7, hk = h / (8 / NHKV); const size_t tok0 = (size_t)b * SEQ + (size_t)qb * QB;
    BlockRef r; r.Q = Q + tok0 * LDQ + h * QH; r.K = K + (size_t)b * SEQ * LDK + hk * 128; r.V = V + (size_t)b * SEQ * LDV + hk * 128; r.KP = PE ? KP + (size_t)b * SEQ * 64 : nullptr;
    r.O = O + tok0 * 1024 + h * 128; r.M = MASKED ? M + tok0 * 64 : nullptr; r.P0 = qb * QB; return r;
}
template <bool PE, bool MASKED, int LDQ, int QH, int LDK, int LDV, int NHKV, bool DRY = false>
__device__ __forceinline__ void attn_phase(char* lds, const bf16* Q, const bf16* K, const bf16* V, const bf16* KP, bf16* O, const unsigned long long* M, const float SCALE, const float* psrc, bf16* pdst, const bool rdry = false) {
    const int total = 8 * NB * 8, stride = gridDim.x;
    int L = blockIdx.x; if (L >= total) return;
    if (__builtin_amdgcn_readfirstlane((int)threadIdx.x) >= 256) __builtin_amdgcn_s_setprio(1);
    Item it = decode(L, NHKV); int pass = 0, kblk = 0;
    BlockRef cur = make_ref<PE, MASKED, LDQ, QH, LDK, LDV, NHKV>(it, 0, Q, K, V, KP, O, M);
    Seam<PE> S;
    attn_prime<PE, MASKED, LDQ, LDK, LDV>(cur, lds, S);
    for (;;) {
        const bool more_pass = pass == 0, more_item = L + stride < total, last = !more_pass && !more_item;
        Item itn = it; int passn = pass + 1, Ln = L;
        if (!more_pass) { passn = 0; Ln = more_item ? L + stride : L; itn = decode(Ln, NHKV); }
        const BlockRef nxt = last ? cur : make_ref<PE, MASKED, LDQ, QH, LDK, LDV, NHKV>(itn, passn, Q, K, V, KP, O, M);
        attn_block<PE, MASKED, LDQ, LDK, LDV, DRY>(cur, nxt, lds, S, SCALE, rdry, psrc, pdst, kblk); ++kblk;
        if (last) break;
        cur = nxt; it = itn; pass = passn; L = Ln;
    }
    __builtin_amdgcn_s_setprio(0);
    { constexpr size_t PNCH = (size_t)NB * 4096 * 256 / 8; const size_t gth_ = (size_t)gridDim.x * (NW * 64);
      for (size_t c_ = (size_t)kblk * 2 * gth_ + (size_t)blockIdx.x * (NW * 64) + threadIdx.x; c_ < PNCH; c_ += gth_) {
          const f32x4 a_ = *(const f32x4*)(psrc + c_ * 8), b_ = *(const f32x4*)(psrc + c_ * 8 + 4); *(v4u*)(pdst + c_ * 8) = pack8(a_, b_); } }
}
#undef KSWZ
#undef KPSWZ
#undef SBAR
}
#define EPI_ROWS _Pragma("unroll") for (int ai = 0; ai < 2; ++ai) _Pragma("unroll") for (int m = 0; m < 4; ++m)
#define EPI_ROW (u.pm * 256 + ai * 128 + wr * 64 + m * 16 + fr)
#define EPI_FENCE() __builtin_amdgcn_sched_barrier(0)
__device__ __forceinline__ __amdgpu_buffer_rsrc_t epi_rsrc(const void* ubase) {
    const unsigned long long b_ = (unsigned long long)ubase;
    const unsigned lo_ = __builtin_amdgcn_readfirstlane((unsigned)b_), hi_ = __builtin_amdgcn_readfirstlane((unsigned)(b_ >> 32));
    return __builtin_amdgcn_make_buffer_rsrc((void*)(((unsigned long long)hi_ << 32) | lo_), (short)0, 0x7fffffff, 0x00020000); }
__device__ __forceinline__ v4u epi_ld16(__amdgpu_buffer_rsrc_t r, unsigned voff) { return __builtin_amdgcn_raw_buffer_load_b128(r, (int)voff, 0, 0); }
typedef const f32x4 (&AccRef)[2][2][4][2];
template <int NP>
__device__ __forceinline__ void wave_rstd(const float* rs, int pm, int wr, int fr, int fq, float invn, float (&out)[2][4]) {
    const int l = fq * 16 + fr; float r2[2];
#pragma unroll
    for (int ai = 0; ai < 2; ++ai) { const int row = pm * 256 + ai * 128 + wr * 64 + l; float s;
        if (NP == 16) { const f32x4* p = (const f32x4*)(rs + (size_t)row * 16); const f32x4 a = p[0], b = p[1], c = p[2], d = p[3];
            s = ((a[0] + a[1]) + (a[2] + a[3])) + ((b[0] + b[1]) + (b[2] + b[3])) + ((c[0] + c[1]) + (c[2] + c[3])) + ((d[0] + d[1]) + (d[2] + d[3])); }
        else { const f32x4 a = *(const f32x4*)(rs + (size_t)row * 4); s = (a[0] + a[1]) + (a[2] + a[3]); }
        r2[ai] = rsqrtf(s * invn + NORM_EPS); }
#pragma unroll
    for (int ai = 0; ai < 2; ++ai)
#pragma unroll
        for (int m = 0; m < 4; ++m) out[ai][m] = __shfl(r2[ai], m * 16 + fr);
}

struct RstdHalf { f32x4 a, b, c, d; };
__device__ __forceinline__ void rstd_half_issue(const float* rs, int pm, int wr, int fr, int fq, int ai, RstdHalf& h) {
    const int l = fq * 16 + fr; const f32x4* p = (const f32x4*)(rs + (size_t)(pm * 256 + ai * 128 + wr * 64 + l) * 16); h.a = p[0]; h.b = p[1]; h.c = p[2]; h.d = p[3]; }
__device__ __forceinline__ void rstd_half_finish(const RstdHalf& h, int fr, float invn, float (&out)[4]) {
    const float s_ = ((h.a[0] + h.a[1]) + (h.a[2] + h.a[3])) + ((h.b[0] + h.b[1]) + (h.b[2] + h.b[3])) + ((h.c[0] + h.c[1]) + (h.c[2] + h.c[3])) + ((h.d[0] + h.d[1]) + (h.d[2] + h.d[3]));
    const float r2 = rsqrtf(s_ * invn + NORM_EPS);
#pragma unroll
    for (int m = 0; m < 4; ++m) out[m] = __shfl(r2, m * 16 + fr); }

struct EpiMlaIn {
    static constexpr bool PERM = true, AFTER_DRAIN = false;
    const float* rsx; bf16* cq; bf16* ckv; bf16* sz; bf16* kpe; float* rsq; float* rskv; const unsigned* rope32;
    __device__ __forceinline__ void operator()(AccRef acc, const pg8::Unit& u, int wr, int wc, int fr, int fq) const {
        const int pn = u.pn; float rst[2][4]; wave_rstd<16>(rsx, u.pm, wr, fr, fq, 1.f / 1024.f, rst);
        if (pn < 2) { bf16* dst = pn == 0 ? cq : ckv; float* rs = pn == 0 ? rsq : rskv;
            EPI_ROWS { const int row = EPI_ROW; const float rstd = rst[ai][m]; float ss = 0.f;
#pragma unroll
                for (int bj = 0; bj < 2; ++bj) { const f32x4 v0 = acc[ai][bj][m][0] * rstd, v1 = acc[ai][bj][m][1] * rstd; ss += sq4(v0) + sq4(v1);
                    *(v4u*)(dst + (size_t)row * 256 + bj * 128 + wc * 32 + fq * 8) = pack8(v0, v1); }
                ss += __shfl_xor(ss, 16); ss += __shfl_xor(ss, 32);
                if (fq == 0) rs[(size_t)row * 4 + wc] = ss; }
        } else if (pn < 6) {
            EPI_ROWS { const int row = EPI_ROW; const float rstd = rst[ai][m];
#pragma unroll
                for (int bj = 0; bj < 2; ++bj) { f32x4 v0 = acc[ai][bj][m][0] * rstd, v1 = acc[ai][bj][m][1] * rstd;
#pragma unroll
                    for (int e = 0; e < 4; ++e) { v0[e] = silu_f(v0[e]); v1[e] = silu_f(v1[e]); }
                    *(v4u*)(sz + (size_t)row * 1024 + (pn - 2) * 256 + bj * 128 + wc * 32 + fq * 8) = pack8(v0, v1); } }
        } else if (wc < 2) {
            const int c = wc * 32 + fq * 8;
#pragma unroll
            for (int ai = 0; ai < 2; ++ai)
            { v4u cs[4];
#pragma unroll
                for (int m = 0; m < 4; ++m) cs[m] = *(const v4u*)(rope32 + (size_t)EPI_ROW * 32 + (c >> 1));
                EPI_FENCE();
#pragma unroll
                for (int m = 0; m < 4; ++m) { const int row = EPI_ROW; const float rstd = rst[ai][m]; f32x4 v0 = acc[ai][0][m][0] * rstd, v1 = acc[ai][0][m][1] * rstd;
                    rope8h(v0, v1, cs[m]);
                    *(v4u*)(kpe + (size_t)row * 64 + c) = pack8(v0, v1); } }
        }
    }
};
struct EpiMlaQ {
    static constexpr bool PERM = true, AFTER_DRAIN = false;
    const float* rsq; bf16* q; const unsigned* rope32;
    __device__ __forceinline__ void operator()(AccRef acc, const pg8::Unit& u, int wr, int wc, int fr, int fq) const {
        int col[2], cin[2];
#pragma unroll
        for (int bj = 0; bj < 2; ++bj) { col[bj] = u.pn * 256 + bj * 128 + wc * 32 + fq * 8; const int h = col[bj] / 192; cin[bj] = col[bj] - h * 192; }
        const __amdgpu_buffer_rsrc_t rt_ = epi_rsrc(rope32 + (size_t)u.pm * 256 * 32);
        const unsigned to_ = (unsigned)((wr * 64 + fr) * 32) * 4u;
        v4u cs0[4][2], cs1[4][2];
#pragma unroll
        for (int m = 0; m < 4; ++m) {
#pragma unroll
            for (int bj = 0; bj < 2; ++bj) if (cin[bj] >= 128) { const unsigned o_ = to_ + (unsigned)((m * 16) * 32 + ((cin[bj] - 128) >> 1)) * 4u; cs0[m][bj] = epi_ld16(rt_, o_); cs1[m][bj] = epi_ld16(rt_, o_ + 128u * 32u * 4u); } }
        float rst[2][4]; wave_rstd<4>(rsq, u.pm, wr, fr, fq, 1.f / 256.f, rst);
#pragma unroll
        for (int ai = 0; ai < 2; ++ai)
        { v4u cs[4][2];
#pragma unroll
            for (int m = 0; m < 4; ++m) {
#pragma unroll
                for (int bj = 0; bj < 2; ++bj) cs[m][bj] = ai == 0 ? cs0[m][bj] : cs1[m][bj]; }
            EPI_FENCE();
#pragma unroll
            for (int m = 0; m < 4; ++m) { const int row = EPI_ROW; const float rstd = rst[ai][m];
#pragma unroll
                for (int bj = 0; bj < 2; ++bj) { f32x4 v0 = acc[ai][bj][m][0] * rstd, v1 = acc[ai][bj][m][1] * rstd;
                    if (cin[bj] >= 128) rope8h(v0, v1, cs[m][bj]);
                    *(v4u*)(q + (size_t)row * 1536 + col[bj]) = pack8(v0, v1); } } }
    }
};
struct EpiMlaKV {
    static constexpr bool PERM = true, AFTER_DRAIN = false;
    const float* rskv; bf16* dst;
    __device__ __forceinline__ void operator()(AccRef acc, const pg8::Unit& u, int wr, int wc, int fr, int fq) const {
        float rst[2][4]; wave_rstd<4>(rskv, u.pm, wr, fr, fq, 1.f / 256.f, rst);
        EPI_ROWS { const int row = EPI_ROW; const float rstd = rst[ai][m];
#pragma unroll
            for (int bj = 0; bj < 2; ++bj) { const int col = u.pn * 256 + bj * 128 + wc * 32 + fq * 8;
                *(v4u*)(dst + (size_t)row * 1024 + col) = pack8(acc[ai][bj][m][0] * rstd, acc[ai][bj][m][1] * rstd); }
        }
    }
};
struct EpiPlain {
    static constexpr bool PERM = true, AFTER_DRAIN = false;
    bf16* dst;
    __device__ __forceinline__ void operator()(AccRef acc, const pg8::Unit& u, int wr, int wc, int fr, int fq) const {
        EPI_ROWS { const int row = EPI_ROW;
#pragma unroll
            for (int bj = 0; bj < 2; ++bj) { const int col = u.pn * 256 + bj * 128 + wc * 32 + fq * 8;
                *(v4u*)(dst + (size_t)row * 1024 + col) = pack8(acc[ai][bj][m][0], acc[ai][bj][m][1]); }
        }
    }
};
#define SS8(ow) ({ const float r0 = bf2f((ow).x & 0xffffu), r1 = bf2f((ow).x >> 16), r2 = bf2f((ow).y & 0xffffu), r3 = bf2f((ow).y >> 16), r4 = bf2f((ow).z & 0xffffu), r5 = bf2f((ow).z >> 16), r6 = bf2f((ow).w & 0xffffu), r7 = bf2f((ow).w >> 16); \
                   ((r0 * r0 + r1 * r1) + (r2 * r2 + r3 * r3)) + ((r4 * r4 + r5 * r5) + (r6 * r6 + r7 * r7)); })
struct EpiOut {
    static constexpr bool PERM = true, AFTER_DRAIN = false;
    const bf16* xin; bf16* xb; float* rs1; bool dry;
    __device__ __forceinline__ void operator()(AccRef acc, const pg8::Unit& u, int wr, int wc, int fr, int fq) const {
        const size_t c0 = (size_t)u.pn * 256 + wc * 32 + fq * 8;
        v4u xw[2][4][2];
#pragma unroll
        for (int ai = 0; ai < 2; ++ai)
#pragma unroll
        for (int m = 0; m < 4; ++m) {
#pragma unroll
            for (int bj = 0; bj < 2; ++bj) xw[ai][m][bj] = *(const v4u*)(xin + (size_t)EPI_ROW * 1024 + c0 + bj * 128); }
        EPI_FENCE();
#pragma unroll
        for (int ai = 0; ai < 2; ++ai) {
#pragma unroll
        for (int m = 0; m < 4; ++m) { const int row = EPI_ROW; float ss = 0.f;
#pragma unroll
            for (int bj = 0; bj < 2; ++bj) { const v4u w = xw[ai][m][bj]; f32x4 a0 = acc[ai][bj][m][0], a1 = acc[ai][bj][m][1];
                a0[0] += bf2f(w.x & 0xffffu); a0[1] += bf2f(w.x >> 16); a0[2] += bf2f(w.y & 0xffffu); a0[3] += bf2f(w.y >> 16);
                a1[0] += bf2f(w.z & 0xffffu); a1[1] += bf2f(w.z >> 16); a1[2] += bf2f(w.w & 0xffffu); a1[3] += bf2f(w.w >> 16);
                const v4u ow = pack8(a0, a1); if (!dry) *(v4u*)(xb + (size_t)row * 1024 + c0 + bj * 128) = ow; ss += SS8(ow); }
            ss += __shfl_xor(ss, 16); ss += __shfl_xor(ss, 32);
            if (fq == 0 && !dry) rs1[(size_t)row * 16 + u.pn * 4 + wc] = ss; else asm volatile("" :: "v"(ss));
        } }
    }
};
struct EpiGate {
    static constexpr bool PERM = true, AFTER_DRAIN = false;
    const float* rs1; const bf16* x1; const bf16* pp; bf16* xb; float* rsx; bool dry;
    __device__ __forceinline__ void operator()(AccRef acc, const pg8::Unit& u, int wr, int wc, int fr, int fq) const {
        float rst[2][4]; RstdHalf rh; rstd_half_issue(rs1, u.pm, wr, fr, fq, 0, rh);
        const size_t c0 = (size_t)u.pn * 256 + wc * 32 + fq * 8;
        const __amdgpu_buffer_rsrc_t rx = epi_rsrc(x1 + (size_t)u.pm * 256 * 1024), rp = epi_rsrc(pp + (size_t)u.pm * 256 * 1024);
        const unsigned vo = (unsigned)((wr * 64 + fr) * 1024 + u.pn * 256 + wc * 32 + fq * 8) * 2u;
#pragma unroll
        for (int ai = 0; ai < 2; ++ai) { v4u xw[4][2], pw[4][2];
#pragma unroll
            for (int m = 0; m < 4; ++m)
#pragma unroll
                for (int bj = 0; bj < 2; ++bj) { const unsigned o_ = vo + (unsigned)((ai * 128 + m * 16) * 1024 + bj * 128) * 2u; xw[m][bj] = epi_ld16(rx, o_); pw[m][bj] = epi_ld16(rp, o_); }
            EPI_FENCE();
            rstd_half_finish(rh, fr, 1.f / 1024.f, rst[ai]);
            if (ai == 0) { rstd_half_issue(rs1, u.pm, wr, fr, fq, 1, rh); EPI_FENCE(); }
#pragma unroll
            for (int m = 0; m < 4; ++m) { const int row = EPI_ROW; const float rstd = rst[ai][m]; float ss = 0.f;
#pragma unroll
                for (int bj = 0; bj < 2; ++bj) { const v4u xv = xw[m][bj], pv = pw[m][bj];
                    const f32x4 g0 = acc[ai][bj][m][0] * rstd, g1 = acc[ai][bj][m][1] * rstd; f32x4 a0, a1;
                    a0[0] = bf2f(xv.x & 0xffffu) + bf2f(pv.x & 0xffffu) * sigmoid_f(g0[0]); a0[1] = bf2f(xv.x >> 16) + bf2f(pv.x >> 16) * sigmoid_f(g0[1]);
                    a0[2] = bf2f(xv.y & 0xffffu) + bf2f(pv.y & 0xffffu) * sigmoid_f(g0[2]); a0[3] = bf2f(xv.y >> 16) + bf2f(pv.y >> 16) * sigmoid_f(g0[3]);
                    a1[0] = bf2f(xv.z & 0xffffu) + bf2f(pv.z & 0xffffu) * sigmoid_f(g1[0]); a1[1] = bf2f(xv.z >> 16) + bf2f(pv.z >> 16) * sigmoid_f(g1[1]);
                    a1[2] = bf2f(xv.w & 0xffffu) + bf2f(pv.w & 0xffffu) * sigmoid_f(g1[2]); a1[3] = bf2f(xv.w >> 16) + bf2f(pv.w >> 16) * sigmoid_f(g1[3]);
                    const v4u ow = pack8(a0, a1); if (!dry) *(v4u*)(xb + (size_t)row * 1024 + c0 + bj * 128) = ow; ss += SS8(ow); }
                ss += __shfl_xor(ss, 16); ss += __shfl_xor(ss, 32);
                if (fq == 0 && !dry) rsx[(size_t)row * 16 + u.pn * 4 + wc] = ss; else asm volatile("" :: "v"(ss)); } }
    }
};
struct EpiDsaIn {
    static constexpr bool PERM = true, AFTER_DRAIN = false;
    const float* rsx; bf16* q; bf16* k; bf16* v; bf16* qi; bf16* sz; bf16* ki; float* wi; const unsigned* rope64; const unsigned* rope32;
    __device__ __forceinline__ void operator()(AccRef acc, const pg8::Unit& u, int wr, int wc, int fr, int fq) const {
        const int pn = u.pn;
        const int cb = wc * 32 + fq * 8;
        const bool rope_tile = pn < 5 || pn == 6 || pn == 7 || pn == 12;
        const unsigned* tab = (pn < 5) ? rope64 : rope32; const int tw = (pn < 5) ? 64 : 32, cm = (pn < 5) ? 127 : 63;
        v4u cs0[4][2];
        if (rope_tile) { const int ai = 0;
#pragma unroll
            for (int m = 0; m < 4; ++m) {
#pragma unroll
                for (int bj = 0; bj < 2; ++bj) { const int c = bj * 128 + cb; if (pn != 12 || c < 64) cs0[m][bj] = *(const v4u*)(tab + (size_t)EPI_ROW * tw + ((c & cm) >> 1)); } } }
        float rst[2][4]; wave_rstd<16>(rsx, u.pm, wr, fr, fq, 1.f / 1024.f, rst);
#pragma unroll
        for (int ai = 0; ai < 2; ++ai)
        { v4u cs[4][2];
            if (ai == 0) {
#pragma unroll
                for (int m = 0; m < 4; ++m) { cs[m][0] = cs0[m][0]; cs[m][1] = cs0[m][1]; }
            } else if (rope_tile) {
#pragma unroll
                for (int m = 0; m < 4; ++m) {
#pragma unroll
                    for (int bj = 0; bj < 2; ++bj) { const int c = bj * 128 + cb; if (pn != 12 || c < 64) cs[m][bj] = *(const v4u*)(tab + (size_t)EPI_ROW * tw + ((c & cm) >> 1)); } }
            }
            EPI_FENCE();
#pragma unroll
            for (int m = 0; m < 4; ++m) { const int row = EPI_ROW; const float rstd = rst[ai][m];
#pragma unroll
                for (int bj = 0; bj < 2; ++bj) { const int c = bj * 128 + cb;
                    f32x4 v0 = acc[ai][bj][m][0] * rstd, v1 = acc[ai][bj][m][1] * rstd;
                    if (pn < 4) { rope8h(v0, v1, cs[m][bj]); *(v4u*)(q + (size_t)row * 1024 + pn * 256 + c) = pack8(v0, v1); }
                    else if (pn == 4) { rope8h(v0, v1, cs[m][bj]); *(v4u*)(k + (size_t)row * 256 + c) = pack8(v0, v1); }
                    else if (pn == 5) { *(v4u*)(v + (size_t)row * 256 + c) = pack8(v0, v1); }
                    else if (pn < 8) { rope8h(v0, v1, cs[m][bj]); *(v4u*)(qi + (size_t)row * 512 + (pn - 6) * 256 + c) = pack8(v0, v1); }
                    else if (pn < 12) {
#pragma unroll
                        for (int e = 0; e < 4; ++e) { v0[e] = silu_f(v0[e]); v1[e] = silu_f(v1[e]); }
                        *(v4u*)(sz + (size_t)row * 1024 + (pn - 8) * 256 + c) = pack8(v0, v1); }
                    else if (c < 64) { rope8h(v0, v1, cs[m][bj]); *(v4u*)(ki + (size_t)row * 64 + c) = pack8(v0, v1); }
                    else if (c == 64) { *(f32x4*)(wi + (size_t)row * 8) = v0; *(f32x4*)(wi + (size_t)row * 8 + 4) = v1; }
                } } }
    }
};

__device__ __forceinline__ int src_col(int map, int n) {
    switch (map) {
    case 1:
        if (n < 512) return n; if (n < 1536) return n + 64; if (n < 1600) { const int c = n - 1536; return 512 + (c >> 1) + 32 * (c & 1); } return -1;
    case 2: {
        const int h = n / 192, c = n - h * 192; if (c < 128) return n; const int c2 = c - 128; return h * 192 + 128 + (c2 >> 1) + 32 * (c2 & 1); }
    case 3:
        if (n < 1280) { const int h = n >> 7, c = n & 127; return h * 128 + (c >> 1) + 64 * (c & 1); }
        if (n < 1536) return n;
        if (n < 2048) { const int c = n - 1536, h = c >> 6, cc = c & 63; return 1536 + h * 64 + (cc >> 1) + 32 * (cc & 1); }
        if (n < 3072) return 2120 + (n - 2048);
        if (n < 3136) { const int c = n - 3072; return 2048 + (c >> 1) + 32 * (c & 1); }
        if (n < 3144) return 2112 + (n - 3136);
        return -1;
    default: return n;
    }
}
__device__ __forceinline__ void tr_item(const float* W, int K, int N, bf16* WT, int Nout, const float* gain, int map, LAS float* scr, int item, int lane) {
    const int nblk = Nout / 32, kb = item / nblk, nb = item % nblk, k0 = 64 * kb, n0 = 32 * nb;
    const int src = src_col(map, n0 + (lane & 31));
    const int srcc = src >= 0 ? src : 0; float wv_[32], gv_[32];
#pragma unroll
    for (int i = 0; i < 32; ++i) { const int kk = 2 * i + (lane >> 5); wv_[i] = W[(size_t)(k0 + kk) * N + srcc]; gv_[i] = gain ? gain[k0 + kk] : 1.f; }
#pragma unroll
    for (int i = 0; i < 32; ++i) { const int kk = 2 * i + (lane >> 5); scr[kk * 33 + (lane & 31)] = src >= 0 ? wv_[i] * gv_[i] : 0.f; }
    LDS_WAIT(); asm volatile("" ::: "memory");
    const int c = lane & 7;
#pragma unroll
    for (int j = 0; j < 4; ++j) { const int n = (lane >> 3) + 8 * j; const LAS float* s = scr + (8 * c) * 33 + n;
        v4u o; o.x = cvtpk(s[0 * 33], s[1 * 33]); o.y = cvtpk(s[2 * 33], s[3 * 33]); o.z = cvtpk(s[4 * 33], s[5 * 33]); o.w = cvtpk(s[6 * 33], s[7 * 33]);
        *(v4u*)(WT + (size_t)(n0 + n) * K + k0 + 8 * c) = o; }
    LDS_WAIT(); asm volatile("" ::: "memory");
}

struct Args { const float* in[17]; float* out; unsigned char* ws; int ph_lo, ph_hi, pmode, pad; };

__device__ __forceinline__ void prologue(const Args& a, LAS unsigned char* lds, int gw, int ngw, int wave, int lane) {
    bf16* Wb = (bf16*)(a.ws + WS_W);
    LAS float* scr = (LAS float*)(lds + wave * 16384);
    for (int mi = 0; mi < 22; ++mi) {
        const float* W; int K, N, Nout, map = 0; const float* gain = nullptr; bf16* WT;
        if (mi < 2)       { const int j = mi;      W = a.in[4] + (size_t)j * 1024 * 1600;  K = 1024; N = 1600; Nout = MLA_N; map = 1; gain = a.in[3] + (size_t)(2 * j) * 1024; WT = Wb + W_WINM + (size_t)j * MLA_N * 1024; }
        else if (mi < 4)  { const int j = mi - 2;  W = a.in[7] + (size_t)j * 256 * 1536;   K = 256;  N = 1536; Nout = 1536;  map = 2; gain = a.in[5] + (size_t)j * 256; WT = Wb + W_WUQ + (size_t)j * 1536 * 256; }
        else if (mi < 6)  { const int j = mi - 4;  W = a.in[8] + (size_t)j * 256 * 1024;   K = 256;  N = 1024; Nout = 1024;  gain = a.in[6] + (size_t)j * 256; WT = Wb + W_WUK + (size_t)j * 1024 * 256; }
        else if (mi < 8)  { const int j = mi - 6;  W = a.in[9] + (size_t)j * 256 * 1024;   K = 256;  N = 1024; Nout = 1024;  gain = a.in[6] + (size_t)j * 256; WT = Wb + W_WUV + (size_t)j * 1024 * 256; }
        else if (mi < 10) { const int j = mi - 8;  W = a.in[10] + (size_t)j * 1024 * 1024; K = 1024; N = 1024; Nout = 1024;  WT = Wb + W_WOM + (size_t)j * 1024 * 1024; }
        else if (mi < 12) { const int j = mi - 10; W = a.in[11] + (size_t)j * 1024 * 3144; K = 1024; N = 3144; Nout = DSA_N; map = 3; gain = a.in[3] + (size_t)(2 * j + 1) * 1024; WT = Wb + W_WIND + (size_t)j * DSA_N * 1024; }
        else if (mi < 14) { const int j = mi - 12; W = a.in[12] + (size_t)j * 1024 * 1024; K = 1024; N = 1024; Nout = 1024;  WT = Wb + W_WOD + (size_t)j * 1024 * 1024; }
        else if (mi < 18) { const int i = mi - 14; W = a.in[13] + (size_t)i * 256 * 1024;  K = 256;  N = 1024; Nout = 1024;  WT = Wb + W_WP + (size_t)i * 1024 * 256; }
        else              { const int i = mi - 18; W = a.in[15] + (size_t)i * 1024 * 1024; K = 1024; N = 1024; Nout = 1024;  gain = a.in[14] + (size_t)i * 1024; WT = Wb + W_WG + (size_t)i * 1024 * 1024; }
        const int nitems = (K / 64) * (Nout / 32);
        for (int it = gw; it < nitems; it += ngw) tr_item(W, K, N, WT, Nout, gain, map, scr, it, lane);
    }
    {
        const int* pos = (const int*)a.in[2]; unsigned* r64 = (unsigned*)(a.ws + WS_ROPE64); unsigned* r32 = (unsigned*)(a.ws + WS_ROPE32);
        const float inv64 = 1.0f / powf(10000.0f, (float)lane / 64.0f);
        const float inv32 = 1.0f / powf(10000.0f, (float)(lane & 31) / 32.0f);
        for (int t0 = gw * 4; t0 < T; t0 += ngw * 4) { int pi[4];
#pragma unroll
          for (int a = 0; a < 4; ++a) pi[a] = pos[t0 + a];
#pragma unroll
          for (int a = 0; a < 4; ++a) { const int t = t0 + a; const float pf = (float)pi[a];
            { const float ang = pf * inv64; float sn, cs; sincosf(ang, &sn, &cs); r64[(size_t)t * 64 + lane] = pack_cs(cs, sn); }
            if (lane < 32) { const float ang = pf * inv32; float sn, cs; sincosf(ang, &sn, &cs); r32[(size_t)t * 32 + lane] = pack_cs(cs, sn); }
          } }
    }
    {
        const float* x = a.in[0]; bf16* xb = (bf16*)(a.ws + WS_XB0); float* rsx = (float*)(a.ws + WS_RSX);
        for (int r0 = gw * 4; r0 < T; r0 += ngw * 4) {
            f32x4 v[4][4];
#pragma unroll
            for (int a = 0; a < 4; ++a) { const f32x4* xr = (const f32x4*)(x + (size_t)(r0 + a) * 1024) + lane;
#pragma unroll
                for (int j = 0; j < 4; ++j) v[a][j] = xr[64 * j]; }
#pragma unroll
            for (int a = 0; a < 4; ++a) { float s = 0.f;
#pragma unroll
                for (int j = 0; j < 4; ++j) s += sq4(v[a][j]);
                s = wave_sum(s);
                u32x2* o8 = (u32x2*)(xb + (size_t)(r0 + a) * 1024) + lane;
#pragma unroll
                for (int j = 0; j < 4; ++j) { u32x2 w; w.x = cvtpk(v[a][j][0], v[a][j][1]); w.y = cvtpk(v[a][j][2], v[a][j][3]); o8[64 * j] = w; }
                if (lane < 16) rsx[(size_t)(r0 + a) * 16 + lane] = lane == 0 ? s : 0.f; }
        }
    }
}
__device__ __forceinline__ void convert_p(const float* p, bf16* pb, int gtid_in, int gthreads) {
    const int gtid = gtid_in;
    constexpr size_t NCH = (size_t)T * 256 / 8;
    size_t i = gtid;
    for (; i + 3 * (size_t)gthreads < NCH; i += 4 * (size_t)gthreads) { f32x4 a[4], b[4];
#pragma unroll
        for (int u = 0; u < 4; ++u) { const size_t c = i + u * (size_t)gthreads; a[u] = *(const f32x4*)(p + c * 8); b[u] = *(const f32x4*)(p + c * 8 + 4); }
#pragma unroll
        for (int u = 0; u < 4; ++u) { const size_t c = i + u * (size_t)gthreads; *(v4u*)(pb + c * 8) = pack8(a[u], b[u]); } }
    for (; i < NCH; i += gthreads) { const f32x4 a = *(const f32x4*)(p + i * 8), b = *(const f32x4*)(p + i * 8 + 4); *(v4u*)(pb + i * 8) = pack8(a, b); }
}

__device__ __forceinline__ unsigned f2key(float s) { const unsigned u = __builtin_bit_cast(unsigned, s); return (u & 0x80000000u) ? ~u : (u | 0x80000000u); }
__device__ __forceinline__ float relu_bits(float x) { const int i = __float_as_int(x); return __int_as_float(i > 0 ? i : 0); }
struct TkUnit { int b, q0; };
__device__ __forceinline__ TkUnit tk_unit(int i, int blk, int nblk, int per) {
    const int pass = i / (NB * per), rem = i - pass * NB * per, b = rem / per, w0 = blk + (rem - b * per) * nblk; TkUnit u; u.b = b; u.q0 = (pass ? 511 - w0 : w0) * 8; return u;
}
constexpr int TK_H1 = 131072, TK_HW = 131072 + 16384, TK_HWS = 576;
struct TkPre { bf16x8 aX[4], aY[4]; f32x4 w[4][2]; bf16x8 kA[4], kB[4], kC[4]; };
__device__ __forceinline__ void tk_preload(TkPre& P, const TkUnit u, int aw, int lane, const bf16* QI, const bf16* KI, const float* WI) {
    const int r = lane & 31, hb = lane >> 5;
    const int a_q = ((r >> 2) & 1) * 2 + (r >> 4), a_h = (r & 3) + 4 * ((r >> 3) & 1);
    const size_t tok0 = (size_t)u.b * SEQ + u.q0; const int ntile = (u.q0 + 8 + 31) >> 5;
#pragma unroll
    for (int s = 0; s < 4; ++s) { P.aX[s] = *(const bf16x8*)(QI + (tok0 + a_q) * 512 + a_h * 64 + 16 * s + 8 * hb); P.aY[s] = *(const bf16x8*)(QI + (tok0 + 4 + a_q) * 512 + a_h * 64 + 16 * s + 8 * hb); }
#pragma unroll
    for (int i = 0; i < 4; ++i) { const int qc = (i >> 1) * 4 + 2 * hb + (i & 1); P.w[i][0] = *(const f32x4*)(WI + (tok0 + qc) * 8); P.w[i][1] = *(const f32x4*)(WI + (tok0 + qc) * 8 + 4); }
    const bf16* kbase = KI + ((size_t)u.b * SEQ + r) * 64 + 8 * hb;
#pragma unroll
    for (int j = 0; j < 3; ++j) { const int t = aw + 4 * j, tt = t < ntile ? t : ntile - 1;
#pragma unroll
        for (int s = 0; s < 4; ++s) { const bf16x8 v = *(const bf16x8*)(kbase + (size_t)tt * 32 * 64 + 16 * s); if (j == 0) P.kA[s] = v; else if (j == 1) P.kB[s] = v; else P.kC[s] = v; } }
}
__device__ __forceinline__ void tk_stepA(TkPre& P, const TkUnit u, const TkUnit nxt, bool has_next, int aw, int lane, LAS unsigned char* lds, const bf16* QI, const bf16* KI, const float* WI) {
    typedef float f32x16 __attribute__((ext_vector_type(16)));
    LAS unsigned* ky = (LAS unsigned*)lds; LAS unsigned* h1 = (LAS unsigned*)(lds + TK_H1) + (lane & 3) * 1024;
    const int r = lane & 31, hb = lane >> 5;
    const int q0 = u.q0;
    float wv[4][8];
#pragma unroll
    for (int i = 0; i < 4; ++i) {
#pragma unroll
        for (int e = 0; e < 4; ++e) { wv[i][e] = P.w[i][0][e] * (0.125f * 0.35355339059327373f); wv[i][4 + e] = P.w[i][1][e] * (0.125f * 0.35355339059327373f); } }
    const int ntile = (q0 + 8 + 31) >> 5;
    const unsigned kvoff = (unsigned)(r * 64 + 8 * hb) * 2u;
    __amdgpu_buffer_rsrc_t krs; { const unsigned long long b_ = (unsigned long long)(KI + (size_t)u.b * SEQ * 64);
        const unsigned lo_ = __builtin_amdgcn_readfirstlane((unsigned)b_), hi_ = __builtin_amdgcn_readfirstlane((unsigned)(b_ >> 32));
        krs = __builtin_amdgcn_make_buffer_rsrc((void*)(((unsigned long long)hi_ << 32) | lo_), (short)0, 0x7fffffff, 0x00020000); }
    bf16x8 kD[4];
#define TK_KLOAD(buf, t) do { const int tt_ = (t) < ntile ? (t) : ntile - 1;     \
        _Pragma("unroll") for (int s = 0; s < 4; ++s) buf[s] = __builtin_bit_cast(bf16x8, __builtin_amdgcn_raw_buffer_load_b128(krs, (int)(kvoff + 32u * s), tt_ * 4096, 0)); } while (0)
#define TK_TILE(buf, t) do { if ((t) < ntile) { const int key = (t) * 32 + r; f32x16 cX = {}, cY = {};                                                            \
        _Pragma("unroll") for (int s = 0; s < 4; ++s) { cX = __builtin_amdgcn_mfma_f32_32x32x16_bf16(P.aX[s], buf[s], cX, 0, 0, 0); cY = __builtin_amdgcn_mfma_f32_32x32x16_bf16(P.aY[s], buf[s], cY, 0, 0, 0); } \
        float sc[4] = {0.f, 0.f, 0.f, 0.f};                                                                                                                      \
        _Pragma("unroll") for (int e = 0; e < 8; ++e) { sc[0] = __builtin_fmaf(relu_bits(cX[e]), wv[0][e], sc[0]); sc[1] = __builtin_fmaf(relu_bits(cX[8 + e]), wv[1][e], sc[1]); \
                                                        sc[2] = __builtin_fmaf(relu_bits(cY[e]), wv[2][e], sc[2]); sc[3] = __builtin_fmaf(relu_bits(cY[8 + e]), wv[3][e], sc[3]); } \
        _Pragma("unroll") for (int i = 0; i < 4; ++i) { const int qc = (i >> 1) * 4 + 2 * hb + (i & 1); const unsigned ub = __builtin_bit_cast(unsigned, sc[i] + 0.0f);        \
            const unsigned kf = ub ^ ((unsigned)((int)ub >> 31) | 0x80000000u);                                      \
            const unsigned kk = (key <= q0 + qc) ? kf : 0u; ky[qc * 4096 + key] = kk;                                                                            \
            __hip_atomic_fetch_add(h1 + qc * 128 + (kk >> 25), 1u << ((kk >> 20) & 16u), __ATOMIC_RELAXED, __HIP_MEMORY_SCOPE_WORKGROUP); } } } while (0)
    for (int tile = aw; tile < ntile; tile += 16) {
        TK_KLOAD(kD, tile + 12); TK_TILE(P.kA, tile);
        TK_KLOAD(P.kA, tile + 16); TK_TILE(P.kB, tile + 4);
        TK_KLOAD(P.kB, tile + 20); TK_TILE(P.kC, tile + 8);
        TK_KLOAD(P.kC, tile + 24); TK_TILE(kD, tile + 12);
    }
#undef TK_KLOAD
#undef TK_TILE
    const int kend = ((q0 + 8 + 511) >> 9) << 9;
    for (int key = ntile * 32 + aw * 64 + lane; key < kend; key += 256) {
#pragma unroll
        for (int i = 0; i < 8; ++i) ky[i * 4096 + key] = 0u; }
    if (has_next) tk_preload(P, nxt, aw, lane, QI, KI, WI);
}
__device__ __forceinline__ void tk_stepB(const unsigned (&k)[64], int q, size_t tok, int ngrp, int lane, const int (&c0)[4], LAS unsigned* hw, unsigned long long* mask) {
    unsigned thr = 0u; int need = 0;
    if (q >= 256) {
        unsigned prefix = 0u; int rem = 256; bool done = false;
#pragma unroll
        for (int p = 0; p < 4; ++p) {
            constexpr int SH[4] = {24, 15, 6, 0}, NBITS[4] = {8, 9, 9, 6};
            const int sh = SH[p], nb = NBITS[p];
            int c[8];
            if (p == 0) { c[0] = c0[0]; c[1] = c0[1]; c[2] = c0[2]; c[3] = c0[3]; c[4] = 0; c[5] = 0; c[6] = 0; c[7] = 0; }
            else {
                *(LAS v4u*)(hw + lane * 8) = (v4u){0u, 0u, 0u, 0u}; *(LAS v4u*)(hw + lane * 8 + 4) = (v4u){0u, 0u, 0u, 0u};
                const unsigned pfx = prefix >> (sh + nb), dummy = 512u + (unsigned)lane;
#pragma unroll
                for (int g = 0; g < 8; ++g) if (g < ngrp) {
#pragma unroll
                    for (int e = 0; e < 8; ++e) { const unsigned kk = k[g * 8 + e]; const bool cand = (kk >> (sh + nb)) == pfx; const unsigned bin = (kk >> sh) & ((1u << nb) - 1u);
                        if (p == 1) __hip_atomic_fetch_add(hw + (cand ? bin : dummy), 1u, __ATOMIC_RELAXED, __HIP_MEMORY_SCOPE_WORKGROUP);
                        else if (__ballot(cand) != 0ull) { if (cand) __hip_atomic_fetch_add(hw + bin, 1u, __ATOMIC_RELAXED, __HIP_MEMORY_SCOPE_WORKGROUP); } }
                    __builtin_amdgcn_sched_barrier(0); }
                LDS_WAIT(); asm volatile("" ::: "memory");
                const v4u h0 = *(const LAS v4u*)(hw + lane * 8), h1v = *(const LAS v4u*)(hw + lane * 8 + 4);
                c[0] = (int)h0.x; c[1] = (int)h0.y; c[2] = (int)h0.z; c[3] = (int)h0.w; c[4] = (int)h1v.x; c[5] = (int)h1v.y; c[6] = (int)h1v.z; c[7] = (int)h1v.w; }
            const int tot = ((c[0] + c[1]) + (c[2] + c[3])) + ((c[4] + c[5]) + (c[6] + c[7]));
            int P = tot;
            P += __builtin_amdgcn_update_dpp(0, P, 0x111, 0xf, 0xf, false); P += __builtin_amdgcn_update_dpp(0, P, 0x112, 0xf, 0xf, false);
            P += __builtin_amdgcn_update_dpp(0, P, 0x114, 0xf, 0xf, false); P += __builtin_amdgcn_update_dpp(0, P, 0x118, 0xf, 0xf, false);
            P += __builtin_amdgcn_update_dpp(0, P, 0x142, 0xa, 0xf, false); P += __builtin_amdgcn_update_dpp(0, P, 0x143, 0xc, 0xf, false);
            const int total = __builtin_amdgcn_readlane(P, 63);
            const int snext = total - P;
            const int L = __popcll(__ballot(snext + tot >= rem)) - 1;
            int s = snext, dl = 0, cgl = 0, cel = 0;
#pragma unroll
            for (int e = 7; e >= 0; --e) { const int s2 = s + c[e]; const bool hit = (s < rem) && (s2 >= rem); dl = hit ? e : dl; cgl = hit ? s : cgl; cel = hit ? c[e] : cel; s = s2; }
            const int d = L * (p == 0 ? 4 : 8) + __builtin_amdgcn_readlane(dl, L), cgt = __builtin_amdgcn_readlane(cgl, L), ceq = __builtin_amdgcn_readlane(cel, L);
            rem -= cgt; prefix |= (unsigned)d << sh;
            if (ceq == rem) { done = true; break; }
        }
        if (done) { thr = prefix - 1u; need = 0; } else { thr = prefix; need = rem; }
    }
    unsigned wlo = 0u, whi = 0u;
#define WL(J, w) do { const unsigned lo_ = (unsigned)(w), hi_ = (unsigned)((w) >> 32);                                                                      \
                asm volatile("s_nop 3\n\tv_writelane_b32 %0, %2, " #J "\n\tv_writelane_b32 %1, %3, " #J : "+v"(wlo), "+v"(whi) : "s"(lo_), "s"(hi_)); } while (0)
#define REP64(M) M(0); M(1); M(2); M(3); M(4); M(5); M(6); M(7); __builtin_amdgcn_sched_barrier(0); M(8); M(9); M(10); M(11); M(12); M(13); M(14); M(15); __builtin_amdgcn_sched_barrier(0); \
                 M(16); M(17); M(18); M(19); M(20); M(21); M(22); M(23); __builtin_amdgcn_sched_barrier(0); M(24); M(25); M(26); M(27); M(28); M(29); M(30); M(31); __builtin_amdgcn_sched_barrier(0); \
                 M(32); M(33); M(34); M(35); M(36); M(37); M(38); M(39); __builtin_amdgcn_sched_barrier(0); M(40); M(41); M(42); M(43); M(44); M(45); M(46); M(47); __builtin_amdgcn_sched_barrier(0); \
                 M(48); M(49); M(50); M(51); M(52); M(53); M(54); M(55); __builtin_amdgcn_sched_barrier(0); M(56); M(57); M(58); M(59); M(60); M(61); M(62); M(63); __builtin_amdgcn_sched_barrier(0)
    if (need == 0) {
#define SEL_GT8(J0, J1, J2, J3, J4, J5, J6, J7) do { const unsigned long long w0_ = __ballot(k[J0] > thr); const unsigned long long w1_ = __ballot(k[J1] > thr); const unsigned long long w2_ = __ballot(k[J2] > thr); const unsigned long long w3_ = __ballot(k[J3] > thr); const unsigned long long w4_ = __ballot(k[J4] > thr); const unsigned long long w5_ = __ballot(k[J5] > thr); const unsigned long long w6_ = __ballot(k[J6] > thr); const unsigned long long w7_ = __ballot(k[J7] > thr);                                     \
                asm volatile("s_nop 3\n\t" "v_writelane_b32 %0, %2, " #J0 "\n\tv_writelane_b32 %1, %3, " #J0 "\n\t" "v_writelane_b32 %0, %4, " #J1 "\n\tv_writelane_b32 %1, %5, " #J1 "\n\t" "v_writelane_b32 %0, %6, " #J2 "\n\tv_writelane_b32 %1, %7, " #J2 "\n\t" "v_writelane_b32 %0, %8, " #J3 "\n\tv_writelane_b32 %1, %9, " #J3 "\n\t" "v_writelane_b32 %0, %10, " #J4 "\n\tv_writelane_b32 %1, %11, " #J4 "\n\t" "v_writelane_b32 %0, %12, " #J5 "\n\tv_writelane_b32 %1, %13, " #J5 "\n\t" "v_writelane_b32 %0, %14, " #J6 "\n\tv_writelane_b32 %1, %15, " #J6 "\n\t" "v_writelane_b32 %0, %16, " #J7 "\n\tv_writelane_b32 %1, %17, " #J7 "\n\t" : "+v"(wlo), "+v"(whi) : "s"((unsigned)(w0_)), "s"((unsigned)((w0_) >> 32)), "s"((unsigned)(w1_)), "s"((unsigned)((w1_) >> 32)), "s"((unsigned)(w2_)), "s"((unsigned)((w2_) >> 32)), "s"((unsigned)(w3_)), "s"((unsigned)((w3_) >> 32)), "s"((unsigned)(w4_)), "s"((unsigned)((w4_) >> 32)), "s"((unsigned)(w5_)), "s"((unsigned)((w5_) >> 32)), "s"((unsigned)(w6_)), "s"((unsigned)((w6_) >> 32)), "s"((unsigned)(w7_)), "s"((unsigned)((w7_) >> 32))); __builtin_amdgcn_sched_barrier(0); } while (0)
        SEL_GT8(0, 1, 2, 3, 4, 5, 6, 7); SEL_GT8(8, 9, 10, 11, 12, 13, 14, 15); SEL_GT8(16, 17, 18, 19, 20, 21, 22, 23); SEL_GT8(24, 25, 26, 27, 28, 29, 30, 31);
        SEL_GT8(32, 33, 34, 35, 36, 37, 38, 39); SEL_GT8(40, 41, 42, 43, 44, 45, 46, 47); SEL_GT8(48, 49, 50, 51, 52, 53, 54, 55); SEL_GT8(56, 57, 58, 59, 60, 61, 62, 63);
#undef SEL_GT8
    } else {
        int run = 0; const unsigned long long ltmask = (1ull << lane) - 1ull;
#define SEL_TIE(J) do { const unsigned kk = k[J]; const bool eq = kk == thr; const unsigned long long beq = __ballot(eq);                                   \
                const int rank = run + __popcll(beq & ltmask); const bool sel = (kk > thr) || (eq && rank < need);                                          \
                const unsigned long long w = __ballot(sel); WL(J, w); run += __popcll(beq); } while (0)
        REP64(SEL_TIE);
#undef SEL_TIE
    }
#undef REP64
#undef WL
    mask[tok * 64 + lane] = ((unsigned long long)whi << 32) | wlo;
}
#define TK_LOADK(kk, rowi, ngrp_) do { const LAS unsigned* row_ = (const LAS unsigned*)lds + (rowi) * 4096;                                      \
        _Pragma("unroll") for (int g = 0; g < 8; ++g) { if (g < (ngrp_)) { _Pragma("unroll") for (int e = 0; e < 8; ++e) kk[g * 8 + e] = row_[(g * 8 + e) * 64 + lane]; } \
            else { _Pragma("unroll") for (int e = 0; e < 8; ++e) kk[g * 8 + e] = 0u; } } } while (0)
__device__ __forceinline__ void topk_phase(int blk, int nblk, int wave, int lane, LAS unsigned char* lds, const bf16* QI, const bf16* KI, const float* WI, unsigned long long* mask) {
    const bool isA = wave < 4; const int aw = wave, bw = wave - 4;
    const int per = (256 - blk + nblk - 1) / nblk, n = NB * 2 * per;
    if (per <= 0) return;
    { LAS unsigned* z = (LAS unsigned*)(lds + TK_H1); for (int i = wave * 64 + lane; i < 4096; i += 512) z[i] = 0u; }
    LDS_WAIT(); __syncthreads();
    if (isA) {
        TkPre P; tk_preload(P, tk_unit(0, blk, nblk, per), aw, lane, QI, KI, WI);
        tk_stepA(P, tk_unit(0, blk, nblk, per), tk_unit(n > 1 ? 1 : 0, blk, nblk, per), n > 1, aw, lane, lds, QI, KI, WI);
        LDS_WAIT(); __builtin_amdgcn_s_barrier();
        for (int s = 1; s <= n; ++s) {
            LDS_WAIT(); __builtin_amdgcn_s_barrier();
            if (s < n) tk_stepA(P, tk_unit(s, blk, nblk, per), tk_unit(s + 1 < n ? s + 1 : s, blk, nblk, per), s + 1 < n, aw, lane, lds, QI, KI, WI);
            LDS_WAIT(); __builtin_amdgcn_s_barrier();
        }
    } else {
        LDS_WAIT(); __builtin_amdgcn_s_barrier();
        for (int s = 1; s <= n; ++s) {
            const TkUnit up = tk_unit(s - 1, blk, nblk, per);
            const int ngrp = (((up.q0 + 8 + 511) >> 9) << 9) >> 9;
            unsigned k0[64], k1[64];
            TK_LOADK(k0, 2 * bw, ngrp); TK_LOADK(k1, 2 * bw + 1, ngrp);
            int c00[4] = {0, 0, 0, 0}, c01[4] = {0, 0, 0, 0};
            { LAS unsigned* hb0 = (LAS unsigned*)(lds + TK_H1) + (2 * bw) * 128 + lane * 2;
#pragma unroll
              for (int cp = 0; cp < 4; ++cp) { const u32x2 a = *(const LAS u32x2*)(hb0 + cp * 1024), b = *(const LAS u32x2*)(hb0 + cp * 1024 + 128);
                  c00[0] += (int)(a.x & 0xffffu); c00[1] += (int)(a.x >> 16); c00[2] += (int)(a.y & 0xffffu); c00[3] += (int)(a.y >> 16);
                  c01[0] += (int)(b.x & 0xffffu); c01[1] += (int)(b.x >> 16); c01[2] += (int)(b.y & 0xffffu); c01[3] += (int)(b.y >> 16);
                  *(LAS u32x2*)(hb0 + cp * 1024) = (u32x2){0u, 0u}; *(LAS u32x2*)(hb0 + cp * 1024 + 128) = (u32x2){0u, 0u}; } }
            LDS_WAIT(); __builtin_amdgcn_s_barrier();
            LAS unsigned* hw = (LAS unsigned*)(lds + TK_HW) + bw * TK_HWS;
            const size_t tok0 = (size_t)up.b * SEQ + up.q0;
            tk_stepB(k0, up.q0 + 2 * bw, tok0 + 2 * bw, ngrp, lane, c00, hw, mask);
            tk_stepB(k1, up.q0 + 2 * bw + 1, tok0 + 2 * bw + 1, ngrp, lane, c01, hw, mask);
            LDS_WAIT(); __builtin_amdgcn_s_barrier();
        }
    }
    __syncthreads();
}
#undef TK_LOADK

#define PROBE 0
#define IN(k) (lo <= (k) && (k) < hi)
#define SEAM(k) do { if (IN(k) && IN((k) + 1)) { xcd_barrier(bar); if (PROBE == 50) xcd_barrier(bar); } } while (0)
#define WSP(T_, off) ((T_*)(args.ws + (off)))
__device__ __forceinline__ int opaque_tid() { int t = threadIdx.x; asm volatile("" : "+v"(t)); return t; }
#define PROBE 0
template <int I>
__device__ __forceinline__ void layer(const Args& args, LAS unsigned char* lds, const XcdBarrier& bar, const int lo, const int hi, const int G, const int bx) {
    constexpr int k0 = 1 + 5 * I, j = I >> 1;
    extern __shared__ __attribute__((aligned(16))) unsigned char lds_dyn[];
#define ldsg ((char*)lds_dyn)
#define TID_ (opaque_tid())
#define LANE_ ((int)threadIdx.x & 63)
#define WAVE_ (__builtin_amdgcn_readfirstlane((int)threadIdx.x >> 6))
    if constexpr ((I & 1) == 0) {
        if (IN(k0)) {
            pg8::Gemm g{WSP(bf16, WS_XB0), WSP(bf16, WS_W) + W_WINM + (size_t)j * MLA_N * 1024, T, MLA_N, 1024}; pg8::StaticOrder S; S.init(T, MLA_N, G, bx);
            EpiMlaIn E{WSP(float, WS_RSX), WSP(bf16, WS_CQ), WSP(bf16, WS_CKV), WSP(bf16, WS_SZ), WSP(bf16, WS_KPE), WSP(float, WS_RSQ), WSP(float, WS_RSKV), WSP(unsigned, WS_ROPE32)};
            if (PROBE == 5 && I == 0) pg8::gemm_phase<EpiMlaIn, pg8::StaticOrder, true, true>(lds, g, S, E);
            pg8::gemm_phase<EpiMlaIn, pg8::StaticOrder, true, true>(lds, g, S, E);
        }
        SEAM(k0);
        if (IN(k0 + 1)) for (int rep = 0; rep < ((PROBE == 4 && I < 2) ? 2 : 1); ++rep) {
            { pg8::Gemm g{WSP(bf16, WS_CQ), WSP(bf16, WS_W) + W_WUQ + (size_t)j * 1536 * 256, T, 1536, 256}; pg8::StaticOrder S; S.init(T, 1536, G, bx); EpiMlaQ E{WSP(float, WS_RSQ), WSP(bf16, WS_Q), WSP(unsigned, WS_ROPE32)};
              pg8::gemm_phase<EpiMlaQ, pg8::StaticOrder, true, true>(lds, g, S, E); }
            { pg8::Gemm g{WSP(bf16, WS_CKV), WSP(bf16, WS_W) + W_WUK + (size_t)j * 1024 * 256, T, 1024, 256}; pg8::StaticOrder S; S.init(T, 1024, G, bx); EpiMlaKV E{WSP(float, WS_RSKV), WSP(bf16, WS_KN)};
              pg8::gemm_phase<EpiMlaKV, pg8::StaticOrder, true, true>(lds, g, S, E); }
            { pg8::Gemm g{WSP(bf16, WS_CKV), WSP(bf16, WS_W) + W_WUV + (size_t)j * 1024 * 256, T, 1024, 256}; pg8::StaticOrder S; S.init(T, 1024, G, bx); EpiMlaKV E{WSP(float, WS_RSKV), WSP(bf16, WS_V)};
              pg8::gemm_phase<EpiMlaKV, pg8::StaticOrder, true, true>(lds, g, S, E); }
        }
        SEAM(k0 + 1);
        if (IN(k0 + 2)) {
            for (int rep = (PROBE == 11 && I == 0) ? 0 : 1; rep < 2; ++rep)
            att::attn_phase<true, false, 1536, 192, 1024, 1024, 8>(ldsg, WSP(bf16, WS_Q), WSP(bf16, WS_KN), WSP(bf16, WS_V), WSP(bf16, WS_KPE), WSP(bf16, WS_SZ), nullptr, 0.07216878364870323f, args.in[1] + (size_t)I * T * 256, WSP(bf16, WS_PB), rep == 0);
        }
        SEAM(k0 + 2);
    } else {
        if (IN(k0)) {
            pg8::Gemm g{WSP(bf16, WS_XB0), WSP(bf16, WS_W) + W_WIND + (size_t)j * DSA_N * 1024, T, DSA_N, 1024}; pg8::StaticOrder S; S.init(T, DSA_N, G, bx);
            EpiDsaIn E{WSP(float, WS_RSX), WSP(bf16, WS_Q), WSP(bf16, WS_KD), WSP(bf16, WS_VD), WSP(bf16, WS_QI), WSP(bf16, WS_SZ), WSP(bf16, WS_KI), WSP(float, WS_WI), WSP(unsigned, WS_ROPE64), WSP(unsigned, WS_ROPE32)};
            for (int rep = 0; rep < ((PROBE == 4 && I < 2) ? 2 : 1); ++rep) pg8::gemm_phase<EpiDsaIn, pg8::StaticOrder, true, true>(lds, g, S, E);
        }
        SEAM(k0);
        if (IN(k0 + 1)) {
            topk_phase(bx, G, WAVE_, LANE_, lds, WSP(bf16, WS_QI), WSP(bf16, WS_KI), WSP(float, WS_WI), WSP(unsigned long long, WS_MASK)); }
        SEAM(k0 + 1);
        if (IN(k0 + 2)) {
            if (PROBE == 2 && I == 1) att::attn_phase<false, true, 1024, 128, 256, 256, 2, true>(ldsg, WSP(bf16, WS_Q), WSP(bf16, WS_KD), WSP(bf16, WS_VD), nullptr, WSP(bf16, WS_SZ), WSP(unsigned long long, WS_MASK), 0.08838834764831845f, args.in[1] + (size_t)I * T * 256, WSP(bf16, WS_PB));
            att::attn_phase<false, true, 1024, 128, 256, 256, 2>(ldsg, WSP(bf16, WS_Q), WSP(bf16, WS_KD), WSP(bf16, WS_VD), nullptr, WSP(bf16, WS_SZ), WSP(unsigned long long, WS_MASK), 0.08838834764831845f, args.in[1] + (size_t)I * T * 256, WSP(bf16, WS_PB));
        }
        SEAM(k0 + 2);
    }
    if (IN(k0 + 3)) for (int rep = ((PROBE == 4 && I < 2) ? 0 : 1); rep < 2; ++rep) {
        { pg8::Gemm g{WSP(bf16, WS_PB), WSP(bf16, WS_W) + W_WP + (size_t)I * 1024 * 256, T, 1024, 256}; pg8::StaticOrder S; S.init(T, 1024, G, bx); EpiPlain E{WSP(bf16, WS_PP)};
          pg8::gemm_phase<EpiPlain, pg8::StaticOrder, true, true>(lds, g, S, E); }
        { pg8::Gemm g{WSP(bf16, WS_SZ), WSP(bf16, WS_W) + ((I & 1) ? W_WOD : W_WOM) + (size_t)j * 1024 * 1024, T, 1024, 1024}; pg8::StaticOrder S; S.init(T, 1024, G, bx);
          EpiOut E{WSP(bf16, WS_XB0), WSP(bf16, WS_XB1), WSP(float, WS_RS1), rep == 0};
          pg8::gemm_phase<EpiOut, pg8::StaticOrder, true, true>(lds, g, S, E); }
    }
    SEAM(k0 + 3);
    if (IN(k0 + 4)) for (int rep = ((PROBE == 4 && I < 2) ? 0 : 1); rep < 2; ++rep) {
        pg8::Gemm g{WSP(bf16, WS_XB1), WSP(bf16, WS_W) + W_WG + (size_t)I * 1024 * 1024, T, 1024, 1024}; pg8::StaticOrder S; S.init(T, 1024, G, bx);
        EpiGate E{WSP(float, WS_RS1), WSP(bf16, WS_XB1), WSP(bf16, WS_PP), WSP(bf16, WS_XB0), WSP(float, WS_RSX), rep == 0};
        pg8::gemm_phase<EpiGate, pg8::StaticOrder, true, true>(lds, g, S, E);
    }
    SEAM(k0 + 4);
#undef TID_
#undef LANE_
#undef WAVE_
#undef ldsg
}

__global__ void __launch_bounds__(NWAVES * 64, 2) fwd(Args args) {
    extern __shared__ __attribute__((aligned(16))) unsigned char lds_raw[];
    LAS unsigned char* lds = (LAS unsigned char*)lds_raw;
    volatile LAS unsigned* MISC = (volatile LAS unsigned*)(lds + MISC_OFF);
    const int G = gridDim.x, bx = blockIdx.x;
    for (int u = threadIdx.x; u < (LDS_BYTES - MISC_OFF) / 4; u += NWAVES * 64) ((LAS unsigned*)(lds + MISC_OFF))[u] = 0u;
    __syncthreads();
    const int lo = args.ph_lo, hi = args.ph_hi;
    XcdBarrier bar; bar.bar = (unsigned*)(args.ws + WS_CTL) + CW_BAR; bar.x = 0; bar.st = nullptr;
    if (hi - lo > 1) bar = xcd_barrier_post((unsigned*)(args.ws + WS_CTL) + CW_BAR, MISC + 8);

    if (IN(0)) { const int lane = threadIdx.x & 63, wave = __builtin_amdgcn_readfirstlane((int)threadIdx.x >> 6);
        if (PROBE == 8) prologue(args, lds, bx * NWAVES + wave, G * NWAVES, wave, lane); prologue(args, lds, bx * NWAVES + wave, G * NWAVES, wave, lane); }
    SEAM(0);
    layer<0>(args, lds, bar, lo, hi, G, bx);
    layer<1>(args, lds, bar, lo, hi, G, bx);
    layer<2>(args, lds, bar, lo, hi, G, bx);
    layer<3>(args, lds, bar, lo, hi, G, bx);
    if (IN(21)) {
        const int lane = threadIdx.x & 63, wave = __builtin_amdgcn_readfirstlane((int)threadIdx.x >> 6);
        const int gw = bx * NWAVES + wave, ngw = G * NWAVES;
        const float* fg = args.in[16]; f32x4 gv[4];
#pragma unroll
        for (int jj = 0; jj < 4; ++jj) gv[jj] = ((const f32x4*)fg)[lane + 64 * jj];
        const bf16* xbf = (const bf16*)(args.ws + WS_XB0);
        for (int r0 = gw * 2; r0 < T; r0 += ngw * 2) { u32x2 w[2][4];
#pragma unroll
            for (int a = 0; a < 2; ++a) { const u32x2* xr = (const u32x2*)(xbf + (size_t)(r0 + a) * 1024) + lane;
#pragma unroll
                for (int jj = 0; jj < 4; ++jj) w[a][jj] = xr[64 * jj]; }
#pragma unroll
            for (int a = 0; a < 2; ++a) { f32x4 v[4]; float s = 0.f;
#pragma unroll
                for (int jj = 0; jj < 4; ++jj) { v[jj][0] = bf2f(w[a][jj].x & 0xffffu); v[jj][1] = bf2f(w[a][jj].x >> 16); v[jj][2] = bf2f(w[a][jj].y & 0xffffu); v[jj][3] = bf2f(w[a][jj].y >> 16); s += sq4(v[jj]); }
                const float rstd = rsqrtf(wave_sum(s) * (1.f / 1024.f) + NORM_EPS);
                f32x4* orow = (f32x4*)(args.out + (size_t)(r0 + a) * 1024) + lane;
#pragma unroll
                for (int jj = 0; jj < 4; ++jj) orow[64 * jj] = v[jj] * rstd * gv[jj]; } }
    }
}
#undef IN
#undef SEAM

#if PROBE == 12 || PROBE == 13
__global__ void __launch_bounds__(NWAVES * 64, 2) probe_attn(Args args) {
    extern __shared__ __attribute__((aligned(16))) unsigned char lds_raw[];
#if PROBE == 12
    att::attn_phase<true, false, 1536, 192, 1024, 1024, 8, true>((char*)lds_raw, WSP(bf16, WS_Q), WSP(bf16, WS_KN), WSP(bf16, WS_V), WSP(bf16, WS_KPE), WSP(bf16, WS_SZ), nullptr, 0.07216878364870323f, args.in[1], WSP(bf16, WS_PB));
#else
    att::attn_phase<false, true, 1024, 128, 256, 256, 2, true>((char*)lds_raw, WSP(bf16, WS_Q), WSP(bf16, WS_KD), WSP(bf16, WS_VD), nullptr, WSP(bf16, WS_SZ), WSP(unsigned long long, WS_MASK), 0.08838834764831845f, args.in[1], WSP(bf16, WS_PB));
#endif
}
#endif
#ifndef ONE_LAUNCH
#define ONE_LAUNCH 1
#endif
extern "C" void kernel_launch(void* const* d_in, const int* in_sizes, int n_in, void* d_out, int out_size, void* d_ws, size_t ws_size, hipStream_t stream) {
    static int grid = 0;
    if (grid == 0) {
        if (n_in != 17 || out_size != T * DM || ws_size < WS_END) { fprintf(stderr, "kernel_launch: unexpected shapes (n_in %d, out %d, ws %zu)\n", n_in, out_size, ws_size); grid = -1; return; }
        int dev = 0, cus = 0, per_cu = 0;
        if (hipGetDevice(&dev) != hipSuccess || hipDeviceGetAttribute(&cus, hipDeviceAttributeMultiprocessorCount, dev) != hipSuccess) { grid = -1; return; }
        if (hipFuncSetAttribute((const void*)fwd, hipFuncAttributeMaxDynamicSharedMemorySize, LDS_BYTES) != hipSuccess) { fprintf(stderr, "kernel_launch: hipFuncSetAttribute failed\n"); grid = -1; return; }
        if (hipOccupancyMaxActiveBlocksPerMultiprocessor(&per_cu, (const void*)fwd, NWAVES * 64, LDS_BYTES) != hipSuccess || per_cu < 1) fprintf(stderr, "kernel_launch: occupancy query says %d\n", per_cu);
        (void)hipGetLastError();
        grid = cus;
    }
    if (grid < 0) return;
    (void)hipMemsetAsync((char*)d_ws + WS_CTL, 0, CTL_ZERO_BYTES, stream);
    Args a{};
    for (int i = 0; i < 17; ++i) a.in[i] = (const float*)d_in[i];
    a.out = (float*)d_out; a.ws = (unsigned char*)d_ws;
    if (ONE_LAUNCH) { a.ph_lo = 0; a.ph_hi = NPHASE; hipLaunchKernelGGL(fwd, dim3(grid), dim3(NWAVES * 64), LDS_BYTES, stream, a); }
    else for (int ph = 0; ph < NPHASE; ++ph) { a.ph_lo = ph; a.ph_hi = ph + 1; hipLaunchKernelGGL(fwd, dim3(grid), dim3(NWAVES * 64), LDS_BYTES, stream, a); }
#if PROBE >= 100
    a.pmode = (PROBE / 100) - 1; a.ph_lo = PROBE % 100; a.ph_hi = PROBE % 100 + 1; hipLaunchKernelGGL(fwd, dim3(grid), dim3(NWAVES * 64), LDS_BYTES, stream, a);
#endif
#if PROBE == 12 || PROBE == 13
    { static bool attr2 = false; if (!attr2) { attr2 = true; (void)hipFuncSetAttribute((const void*)probe_attn, hipFuncAttributeMaxDynamicSharedMemorySize, LDS_BYTES); }
      hipLaunchKernelGGL(probe_attn, dim3(grid), dim3(NWAVES * 64), LDS_BYTES, stream, a); }
#endif
}
```

```cpp
#include <hip/hip_runtime.h>
#include <cstdio>
#include <cstdint>
namespace pg8 {
#define PG8_LAS __attribute__((address_space(3)))
typedef unsigned short bf16_t;
typedef short bf16x8 __attribute__((ext_vector_type(8)));
typedef float f32x4 __attribute__((ext_vector_type(4)));
typedef unsigned u32x4 __attribute__((ext_vector_type(4)));
constexpr int BM = 256, BK = 64, HALF = 128, HTB = HALF * BK * 2  , STAGE_BYTES = 8 * HTB, NXCD = 8, WGM = 8;

__host__ __device__ __forceinline__ int lds_byte(int r, int c) { const int st = (r >> 4) * 2 + (c >> 5), rr = r & 15, cc = c & 31, ob = rr * 64 + cc * 2; return st * 1024 + (ob ^ (((ob >> 9) & 1) << 5)); }
__host__ __device__ __forceinline__ void stage_rc(int b, int& R, int& C) { const int st = b / 1024, sb = b % 1024, swz = sb ^ (((sb >> 9) & 1) << 5); R = (st >> 1) * 16 + swz / 64; C = (st & 1) * 32 + (swz % 64) / 2; }
__host__ __device__ __forceinline__ int perm32(int rho) { const int n = rho >> 4, i = rho & 15; return 8 * (i >> 2) + 4 * n + (i & 3); }

struct Unit { int pm, pn; };
struct Gemm { const bf16_t* A; const bf16_t* Bt; int M, N, K; };

struct StaticOrder {
    int nM, nN, nwg, G, c;
    __host__ __device__ void init(int M, int N, int G_, int c_) { nM = M / BM; nN = N / BM; nwg = nM * nN; G = G_; c = c_; }
    __host__ __device__ bool next(int i, Unit& u) const {
        const long L = (long)i * G + c; if (L >= nwg) return false;
        int wgid = (int)L; { const int q = nwg / NXCD, r = nwg % NXCD, xcd = wgid % NXCD, off = wgid / NXCD; wgid = (xcd < r ? xcd * (q + 1) : r * (q + 1) + (xcd - r) * q) + off; }
        const int nig = WGM * nN, gid = wgid / nig, fm = gid * WGM, gsz = (nM - fm) < WGM ? (nM - fm) : WGM;
        u.pm = fm + ((wgid % nig) % gsz); u.pn = (wgid % nig) / gsz; return true;
    }
    __device__ __forceinline__ void a_ready(const Unit&) const {}
    __device__ __forceinline__ void done(const Unit&) const {}
};

__device__ __forceinline__ unsigned cvt_pk_bf16(float lo, float hi) { unsigned r; asm volatile("v_cvt_pk_bf16_f32 %0, %1, %2" : "=v"(r) : "v"(lo), "v"(hi)); return r; }
typedef float f32x2 __attribute__((ext_vector_type(2)));
template <class Epi, class Sched, bool ALIGN_EPI = false, bool SP2 = false>
__device__ __forceinline__ void gemm_phase(PG8_LAS unsigned char* lds, const Gemm g, const Sched& S, const Epi& E) {
    const int tid = threadIdx.x, wid = __builtin_amdgcn_readfirstlane(tid >> 6), lane = tid & 63, wr = wid >> 2, wc = wid & 3, fr = lane & 15, fq = lane >> 4;
    const int K = g.K, nt = K / BK;
    unsigned voffA[2], voffB[2];
#pragma unroll
    for (int i = 0; i < 2; ++i) { int R, C; stage_rc(tid * 16 + i * 8192, R, C); const int Rb = Epi::PERM ? ((R & ~31) + perm32(R & 31)) : R;
        voffA[i] = (unsigned)(R * K + C) * 2u; voffB[i] = (unsigned)(Rb * K + C) * 2u; }
    const size_t kstep = (size_t)(BK * 2);
    const size_t hstep = (size_t)HALF * K * 2;
    const size_t tstep = 2 * hstep;
    const unsigned ldsw = (unsigned)wid * 1024u;
    const int aoff = lds_byte(wr * 64 + fr, fq * 8), boff = lds_byte(wc * 32 + fr, fq * 8);
#define PG8_SA(b, h) (((b) * 2 + (h)) * HTB)
#define PG8_SB(b, h) ((4 + (b) * 2 + (h)) * HTB)
#define PG8_STAGE(bufoff, gbase, voff) do { _Pragma("unroll") for (int _i = 0; _i < 2; ++_i) \
        __builtin_amdgcn_global_load_lds((const unsigned*)((const char*)(gbase) + (voff)[_i]), (PG8_LAS unsigned*)(lds + (bufoff) + ldsw + _i * 8192), 16, 0, 0); } while (0)
#define PG8_LDA(dst, b, h) do { _Pragma("unroll") for (int m = 0; m < 4; ++m) _Pragma("unroll") for (int k = 0; k < 2; ++k) dst[m][k] = *(const PG8_LAS bf16x8*)(lds + PG8_SA(b, h) + aoff + m * 2048 + k * 1024); } while (0)
#define PG8_LDB(dst, b, h) do { _Pragma("unroll") for (int n = 0; n < 2; ++n) _Pragma("unroll") for (int k = 0; k < 2; ++k) dst[n][k] = *(const PG8_LAS bf16x8*)(lds + PG8_SB(b, h) + boff + n * 2048 + k * 1024); } while (0)
#define PG8_MMA(ai, bj, At, Bt) do { __builtin_amdgcn_s_setprio(1); _Pragma("unroll") for (int m = 0; m < 4; ++m) _Pragma("unroll") for (int n = 0; n < 2; ++n) _Pragma("unroll") for (int k = 0; k < 2; ++k) \
        acc[ai][bj][m][n] = __builtin_amdgcn_mfma_f32_16x16x32_bf16(Bt[n][k], At[m][k], acc[ai][bj][m][n], 0, 0, 0); __builtin_amdgcn_s_setprio(0); } while (0)
#define PG8_WAIT_V(n) asm volatile("s_waitcnt vmcnt(" #n ")" ::: "memory")
#define PG8_WAIT_L(n) asm volatile("s_waitcnt lgkmcnt(" #n ")" ::: "memory")
#define PG8_BAR __builtin_amdgcn_s_barrier()
#define PG8_SCHED __builtin_amdgcn_sched_barrier(0)
    Unit cur, nxt; int ui = 0;
    if (!S.next(0, cur)) return;
    f32x4 acc[2][2][4][2];
#pragma unroll
    for (int a = 0; a < 2; ++a)
#pragma unroll
        for (int b = 0; b < 2; ++b)
#pragma unroll
            for (int m = 0; m < 4; ++m)
#pragma unroll
                for (int n = 0; n < 2; ++n) acc[a][b][m][n] = (f32x4){0.f, 0.f, 0.f, 0.f};
    bf16x8 At[4][2], B0[2][2], B1[2][2];
    const char* cA = (const char*)g.A + (size_t)cur.pm * tstep; const char* cB = (const char*)g.Bt + (size_t)cur.pn * tstep;
    S.a_ready(cur);
    if constexpr (SP2) {
        PG8_STAGE(PG8_SB(0, 0), cB, voffB); PG8_STAGE(PG8_SB(0, 1), cB + hstep, voffB); PG8_STAGE(PG8_SA(0, 0), cA, voffA); PG8_STAGE(PG8_SA(0, 1), cA + hstep, voffA);
        if (wr == 1) PG8_BAR;
        PG8_WAIT_V(2); PG8_BAR;
        PG8_STAGE(PG8_SB(1, 0), cB + kstep, voffB); PG8_STAGE(PG8_SA(1, 0), cA + kstep, voffA); PG8_STAGE(PG8_SB(1, 1), cB + hstep + kstep, voffB);
        PG8_WAIT_V(6); PG8_BAR;
    } else {
        PG8_STAGE(PG8_SB(0, 0), cB, voffB); PG8_STAGE(PG8_SA(0, 0), cA, voffA); PG8_STAGE(PG8_SB(0, 1), cB + hstep, voffB); PG8_STAGE(PG8_SA(0, 1), cA + hstep, voffA);
        if (wr == 1) PG8_BAR;
        PG8_WAIT_V(4); PG8_BAR;
        PG8_STAGE(PG8_SB(1, 0), cB + kstep, voffB); PG8_STAGE(PG8_SA(1, 0), cA + kstep, voffA); PG8_STAGE(PG8_SB(1, 1), cB + hstep + kstep, voffB);
        PG8_WAIT_V(6); PG8_BAR;
    }
    for (;;) {
        const bool has_next = S.next(ui + 1, nxt);
        const char* nA = has_next ? (const char*)g.A + (size_t)nxt.pm * tstep : cA; const char* nB = has_next ? (const char*)g.Bt + (size_t)nxt.pn * tstep : cB;
        _Pragma("nounroll") for (int t = 0; t < nt; t += 2) {
            const bool last = (t == nt - 2);
            const char* a1 = cA + (size_t)(t + 1) * kstep;
            const char* a2 = last ? nA : cA + (size_t)(t + 2) * kstep; const char* b2 = last ? nB : cB + (size_t)(t + 2) * kstep;
            const char* a3 = a2 + kstep; const char* b3 = b2 + kstep;
            if (last && has_next) S.a_ready(nxt);
            if constexpr (SP2) {
            PG8_LDB(B0, 0, 0); PG8_LDB(B1, 0, 1); PG8_SCHED; PG8_LDA(At, 0, 0); PG8_STAGE(PG8_SA(1, 1), a1 + hstep, voffA);
            PG8_WAIT_V(8); PG8_WAIT_L(0); PG8_BAR; PG8_MMA(0, 0, At, B0); PG8_MMA(0, 1, At, B1); PG8_BAR; PG8_SCHED;
            PG8_LDA(At, 0, 1); PG8_STAGE(PG8_SB(0, 0), b2, voffB); PG8_STAGE(PG8_SB(0, 1), b2 + hstep, voffB); PG8_STAGE(PG8_SA(0, 0), a2, voffA);
            PG8_WAIT_V(8); PG8_WAIT_L(0); PG8_BAR; PG8_MMA(1, 0, At, B0); PG8_MMA(1, 1, At, B1); PG8_BAR; PG8_SCHED;
            PG8_LDB(B0, 1, 0); PG8_LDB(B1, 1, 1); PG8_SCHED; PG8_LDA(At, 1, 0); PG8_STAGE(PG8_SA(0, 1), a2 + hstep, voffA);
            PG8_WAIT_V(8); PG8_WAIT_L(0); PG8_BAR; PG8_MMA(0, 0, At, B0); PG8_MMA(0, 1, At, B1); PG8_BAR; PG8_SCHED;
            PG8_LDA(At, 1, 1); PG8_STAGE(PG8_SB(1, 0), b3, voffB); PG8_STAGE(PG8_SB(1, 1), b3 + hstep, voffB); PG8_STAGE(PG8_SA(1, 0), a3, voffA);
            PG8_WAIT_V(8); PG8_WAIT_L(0); PG8_BAR; PG8_MMA(1, 0, At, B0); PG8_MMA(1, 1, At, B1); PG8_BAR; PG8_SCHED;
            } else {
            PG8_LDB(B0, 0, 0); PG8_SCHED; PG8_LDA(At, 0, 0); PG8_STAGE(PG8_SA(1, 1), a1 + hstep, voffA);
            PG8_WAIT_L(8); PG8_BAR; PG8_WAIT_L(0); PG8_MMA(0, 0, At, B0); PG8_BAR; PG8_SCHED;
            PG8_LDB(B1, 0, 1); PG8_STAGE(PG8_SB(0, 0), b2, voffB);
            PG8_BAR; PG8_WAIT_L(0); PG8_MMA(0, 1, At, B1); PG8_BAR;
            PG8_LDA(At, 0, 1); PG8_STAGE(PG8_SA(0, 0), a2, voffA);
            PG8_BAR; PG8_WAIT_L(0); PG8_MMA(1, 0, At, B0); PG8_BAR; PG8_SCHED;
            PG8_STAGE(PG8_SB(0, 1), b2 + hstep, voffB);
            PG8_WAIT_V(6); PG8_BAR; PG8_MMA(1, 1, At, B1); PG8_BAR;
            PG8_LDB(B0, 1, 0); PG8_SCHED; PG8_LDA(At, 1, 0); PG8_STAGE(PG8_SA(0, 1), a2 + hstep, voffA);
            PG8_WAIT_L(8); PG8_BAR; PG8_WAIT_L(0); PG8_MMA(0, 0, At, B0); PG8_BAR; PG8_SCHED;
            PG8_LDB(B1, 1, 1); PG8_STAGE(PG8_SB(1, 0), b3, voffB);
            PG8_BAR; PG8_WAIT_L(0); PG8_MMA(0, 1, At, B1); PG8_BAR;
            PG8_LDA(At, 1, 1); PG8_STAGE(PG8_SA(1, 0), a3, voffA);
            PG8_BAR; PG8_WAIT_L(0); PG8_MMA(1, 0, At, B0); PG8_BAR; PG8_SCHED;
            PG8_STAGE(PG8_SB(1, 1), b3 + hstep, voffB);
            PG8_WAIT_V(6); PG8_BAR; PG8_MMA(1, 1, At, B1); PG8_BAR;
            }
        }
        if constexpr (ALIGN_EPI) { if (wr == 0) PG8_BAR; }
        if constexpr (!Epi::AFTER_DRAIN) { E(acc, cur, wr, wc, fr, fq); S.done(cur); }
        if (!has_next) break;
#pragma unroll
        for (int a = 0; a < 2; ++a)
#pragma unroll
            for (int b = 0; b < 2; ++b)
#pragma unroll
                for (int m = 0; m < 4; ++m)
#pragma unroll
                    for (int n = 0; n < 2; ++n) acc[a][b][m][n] = (f32x4){0.f, 0.f, 0.f, 0.f};
        cur = nxt; cA = nA; cB = nB; ++ui;
        if constexpr (ALIGN_EPI) { if (wr == 1) PG8_BAR; }
    }
    PG8_WAIT_V(0);
    if constexpr (!ALIGN_EPI) { if (wr == 0) PG8_BAR; }
    PG8_BAR;
    if constexpr (Epi::AFTER_DRAIN) { E.fused(acc, cur, wr, wc, fr, fq, lds, wid, lane); S.done(cur); }
#undef PG8_SA
#undef PG8_SB
#undef PG8_STAGE
#undef PG8_LDA
#undef PG8_LDB
#undef PG8_MMA
#undef PG8_WAIT_V
#undef PG8_WAIT_L
#undef PG8_BAR
#undef PG8_SCHED
}
}
constexpr int NB = 16, SEQ = 4096, T = NB * SEQ, DM = 1024, DEPTH = 4;
constexpr int MLA_N = 1792;
constexpr int DSA_N = 3328;
constexpr float NORM_EPS = 1e-6f;
constexpr int NPHASE = 22;

constexpr size_t MiB = 1u << 20;
constexpr size_t WS_CTL = 0, CTL_ZERO_BYTES = 1 * MiB;
constexpr size_t WS_W = 2 * MiB;
constexpr size_t W_WINM = 0, W_WUQ = W_WINM + 2ull * MLA_N * 1024, W_WUK = W_WUQ + 2ull * 1536 * 256, W_WUV = W_WUK + 2ull * 1024 * 256,
                 W_WOM = W_WUV + 2ull * 1024 * 256, W_WIND = W_WOM + 2ull * 1024 * 1024, W_WOD = W_WIND + 2ull * DSA_N * 1024,
                 W_WP = W_WOD + 2ull * 1024 * 1024, W_WG = W_WP + 4ull * 1024 * 256, W_END = W_WG + 4ull * 1024 * 1024;
static_assert(WS_W + W_END * 2 <= 46 * MiB, "weights");
constexpr size_t WS_ROPE64 = 48 * MiB, WS_ROPE32 = 80 * MiB;
constexpr size_t WS_RSX = 96 * MiB, WS_RS1 = 100 * MiB, WS_RSQ = 104 * MiB, WS_RSKV = 105 * MiB;
constexpr size_t WS_PB = 112 * MiB;
constexpr size_t WS_XB0 = 144 * MiB;
constexpr size_t WS_SZ = 272 * MiB;
constexpr size_t WS_CQ = 400 * MiB, WS_CKV = 432 * MiB, WS_KPE = 464 * MiB;
constexpr size_t WS_QI = 400 * MiB, WS_KI = 464 * MiB, WS_WI = 472 * MiB;
constexpr size_t WS_Q = 480 * MiB;
constexpr size_t WS_PP = 480 * MiB;
constexpr size_t WS_KN = 672 * MiB, WS_V = 800 * MiB;
constexpr size_t WS_KD = 672 * MiB, WS_VD = 704 * MiB, WS_MASK = 736 * MiB;
constexpr size_t WS_XB1 = 672 * MiB;
constexpr size_t WS_END = 928 * MiB;
constexpr int CW_BAR = 4096;

constexpr int RING_BYTES = 131072;
constexpr int LDS_QIS = 131072;
constexpr int MISC_OFF = 159744;
constexpr int LDS_BYTES = 159744 + 512;
constexpr int NWAVES = 8;

#define GAS __attribute__((address_space(1)))
#define LAS __attribute__((address_space(3)))
typedef unsigned short bf16;
typedef unsigned v4u __attribute__((ext_vector_type(4)));
typedef float f32x4 __attribute__((ext_vector_type(4)));
typedef short bf16x8 __attribute__((ext_vector_type(8)));
typedef GAS unsigned gu32;
#define LDS_WAIT() asm volatile("s_waitcnt lgkmcnt(0)" ::: "memory")
#define VM_WAIT() asm volatile("s_waitcnt vmcnt(0)" ::: "memory")
__device__ __forceinline__ unsigned f2bf(float f) { unsigned u = __builtin_bit_cast(unsigned, f); return (u + 0x7fffu + ((u >> 16) & 1u)) >> 16; }
#define XB_TMO      128
#define XB_XCNT(j)  (256  + 64 * (j))
#define XB_XSUB(j)  (1280 + 64 * (j))
#define XB_XGEN(j)  (2304 + 64 * (j))
#define XB_TOP      3328
#define XB_TOPGEN   3392
#define XCD_BAR_WORDS 3456
#define XB_SPIN_CAP (1u << 25)

__device__ __forceinline__ unsigned xb_ld(unsigned* p)              { return __hip_atomic_load(p, __ATOMIC_RELAXED, __HIP_MEMORY_SCOPE_AGENT); }
__device__ __forceinline__ unsigned xb_add(unsigned* p, unsigned v) { return __hip_atomic_fetch_add(p, v, __ATOMIC_RELAXED, __HIP_MEMORY_SCOPE_AGENT); }
__device__ __forceinline__ unsigned xb_xcc_id() { return (unsigned)__builtin_amdgcn_s_getreg((3 << 11) | 20) & 0xFu; }
#define XB_SPIN(cond, bar) do { unsigned _sp = 0; while (cond) { __builtin_amdgcn_s_sleep(1); \
    if ((++_sp & 255u) == 0u) { if (xb_ld(&(bar)[XB_TMO])) break; if (_sp > XB_SPIN_CAP) { atomicAdd(&(bar)[XB_TMO], 1u); break; } } } } while (0)

struct XcdBarrier {
    unsigned* bar; unsigned x;
    volatile LAS unsigned* st;
};

__device__ __forceinline__ XcdBarrier xcd_barrier_post(unsigned* bar, volatile LAS unsigned* st) {
    XcdBarrier b; b.bar = bar; b.x = xb_xcc_id(); b.st = st;
    if (threadIdx.x == 0) (void)xb_add(&bar[XB_XCNT(b.x)], 1u);
    return b;
}
__device__ __forceinline__ void xcd_barrier_complete(unsigned* bar, unsigned x, unsigned& nloc, unsigned& nx) {
    const unsigned G = gridDim.x * gridDim.y * gridDim.z;
    unsigned sum, cnt, mine, sp = 0u;
    for (;;) {
        sum = 0u; cnt = 0u; mine = 0u;
#pragma unroll
        for (unsigned j = 0; j < 16; ++j) { const unsigned c = xb_ld(&bar[XB_XCNT(j)]); sum += c; cnt += (c > 0u) ? 1u : 0u; mine = (j == x) ? c : mine; }
        if (sum == G) break;
        __builtin_amdgcn_s_sleep(1);
        if ((++sp & 255u) == 0u) { if (xb_ld(&bar[XB_TMO])) break; if (sp > XB_SPIN_CAP) { atomicAdd(&bar[XB_TMO], 1u); break; } }
    }
    nloc = mine > 0u ? mine : 1u; nx = cnt > 0u ? cnt : 1u;
}

__device__ __forceinline__ void xcd_barrier(const XcdBarrier& b) {
    asm volatile("s_waitcnt vmcnt(0)" ::: "memory");
    __syncthreads();
    if (threadIdx.x == 0) {
        unsigned* bar = b.bar;
        __builtin_amdgcn_s_waitcnt(0);
        unsigned nloc = b.st[0], nx = b.st[1];
        if (nloc == 0u) { xcd_barrier_complete(bar, b.x, nloc, nx); b.st[0] = nloc; b.st[1] = nx; }
        const unsigned old = xb_add(&bar[XB_XSUB(b.x)], 1u);
        const unsigned gen = old / nloc;
        if (old + 1u == (gen + 1u) * nloc) {
            __builtin_amdgcn_fence(__ATOMIC_RELEASE, "agent");
            asm volatile("s_waitcnt vmcnt(0)" ::: "memory");
            const unsigned og = xb_add(&bar[XB_TOP], 1u);
            const unsigned tg = og / nx;
            if (og + 1u == (tg + 1u) * nx) xb_add(&bar[XB_TOPGEN], 1u);
            else XB_SPIN(xb_ld(&bar[XB_TOPGEN]) == tg, bar);
            __builtin_amdgcn_fence(__ATOMIC_ACQUIRE, "agent");
            xb_add(&bar[XB_XGEN(b.x)], 1u);
            asm volatile("s_waitcnt vmcnt(0)" ::: "memory");
        } else {
            XB_SPIN(xb_ld(&bar[XB_XGEN(b.x)]) == gen, bar);
            __builtin_amdgcn_fence(__ATOMIC_ACQUIRE, "agent");
            asm volatile("s_waitcnt vmcnt(0)" ::: "memory");
        }
    }
    __syncthreads();
}


typedef unsigned u32x2 __attribute__((ext_vector_type(2)));
__device__ __forceinline__ float bf2f(unsigned h) { return __builtin_bit_cast(float, h << 16); }
typedef __bf16 bf16x2_t __attribute__((ext_vector_type(2)));
typedef float f32x2_t __attribute__((ext_vector_type(2)));
__device__ __forceinline__ unsigned cvtpk(float lo, float hi) { const f32x2_t v = {lo, hi}; return __builtin_bit_cast(unsigned, __builtin_convertvector(v, bf16x2_t)); }
__device__ __forceinline__ v4u pack8(f32x4 a, f32x4 b) { v4u w; w.x = cvtpk(a[0], a[1]); w.y = cvtpk(a[2], a[3]); w.z = cvtpk(b[0], b[1]); w.w = cvtpk(b[2], b[3]); return w; }
__device__ __forceinline__ float wave_sum(float v) {
#pragma unroll
    for (int o = 1; o < 64; o <<= 1) v += __shfl_xor(v, o);
    return v;
}
__device__ __forceinline__ float wave_max(float v) {
#pragma unroll
    for (int o = 1; o < 64; o <<= 1) v = fmaxf(v, __shfl_xor(v, o));
    return v;
}
__device__ __forceinline__ int wave_sum_i(int v) {
#pragma unroll
    for (int o = 1; o < 64; o <<= 1) v += __shfl_xor(v, o);
    return v;
}
__device__ __forceinline__ float sum16_rstd(const float* rs, int row, float invn) {
    const f32x4* p = (const f32x4*)(rs + (size_t)row * 16); const f32x4 a = p[0], b = p[1], c = p[2], d = p[3];
    const float s = ((a[0] + a[1]) + (a[2] + a[3])) + ((b[0] + b[1]) + (b[2] + b[3])) + ((c[0] + c[1]) + (c[2] + c[3])) + ((d[0] + d[1]) + (d[2] + d[3]));
    return rsqrtf(s * invn + NORM_EPS);
}
__device__ __forceinline__ float sum4_rstd(const float* rs, int row, float invn) {
    const f32x4 a = *(const f32x4*)(rs + (size_t)row * 4); return rsqrtf(((a[0] + a[1]) + (a[2] + a[3])) * invn + NORM_EPS);
}
__device__ __forceinline__ float silu_f(float v) { return v * __builtin_amdgcn_rcpf(1.f + __expf(-v)); }
__device__ __forceinline__ float sigmoid_f(float v) { return __builtin_amdgcn_rcpf(1.f + __expf(-v)); }
__device__ __forceinline__ float sq4(f32x4 v) { return (v[0] * v[0] + v[1] * v[1]) + (v[2] * v[2] + v[3] * v[3]); }
__device__ __forceinline__ void rope8(f32x4& v0, f32x4& v1, const f32x4 c0, const f32x4 c1) {
    f32x4 o0, o1;
    o0[0] = v0[0] * c0[0] - v0[1] * c0[1]; o0[1] = v0[1] * c0[0] + v0[0] * c0[1];
    o0[2] = v0[2] * c0[2] - v0[3] * c0[3]; o0[3] = v0[3] * c0[2] + v0[2] * c0[3];
    o1[0] = v1[0] * c1[0] - v1[1] * c1[1]; o1[1] = v1[1] * c1[0] + v1[0] * c1[1];
    o1[2] = v1[2] * c1[2] - v1[3] * c1[3]; o1[3] = v1[3] * c1[2] + v1[2] * c1[3];
    v0 = o0; v1 = o1;
}
typedef _Float16 f16x2_t __attribute__((ext_vector_type(2)));
__device__ __forceinline__ unsigned pack_cs(float c, float sn) { const f16x2_t h = {(_Float16)c, (_Float16)sn}; return __builtin_bit_cast(unsigned, h); }
__device__ __forceinline__ f16x2_t as_h2(unsigned u) { return __builtin_bit_cast(f16x2_t, u); }
__device__ __forceinline__ void rope8h(f32x4& v0, f32x4& v1, const v4u w) {
    f32x4 c0, c1;
#pragma unroll
    for (int e = 0; e < 2; ++e) { const f16x2_t a = as_h2(w[e]), b = as_h2(w[2 + e]);
        c0[2 * e] = (float)a[0]; c0[2 * e + 1] = (float)a[1]; c1[2 * e] = (float)b[0]; c1[2 * e + 1] = (float)b[1]; }
    rope8(v0, v1, c0, c1);
}


namespace att {
constexpr int NW = 8, QBLK = 32, KVBLK = 64, QB = NW * QBLK, D = 128;
constexpr int KROW = D * 2 + 16, SHM_V = KVBLK * D * 2, SHM_K = KVBLK * KROW, KPROW = 144, SHM_KP = KVBLK * KPROW;
constexpr int OFF_V = 0, OFF_K = 2 * SHM_V, OFF_WS = OFF_K + 2 * SHM_K, OFF_KP = OFF_WS + NW * 64 * 4, OFF_QP = OFF_KP + 2 * SHM_KP, LDS_NEED = OFF_QP + NW * QBLK * 272;
constexpr float THR = 8.f;
typedef short s16x4 __attribute__((ext_vector_type(4)));
typedef float f32x16 __attribute__((ext_vector_type(16)));

#define KSWZ(row, colB) ((row) * KROW + (colB))
#define KPSWZ(row, ch) ((row) * KPROW + ((ch) << 4))
#define SBAR() __builtin_amdgcn_sched_barrier(0)
__device__ __forceinline__ int v_st(int k, int c) { const int kk = (k & ~0xC) | ((k & 4) << 1) | ((k & 8) >> 1); return ((kk >> 3) * 4 + (c >> 5)) * 512 + ((kk & 7) * 32 + (c & 31)) * 2; }
__device__ __forceinline__ int v_rd_base(int lane) { return ((lane & 3) << 3) | (((lane >> 2) & 3) << 6) | (((lane >> 4) & 1) << 5) | (((lane >> 5) & 1) << 8); }
constexpr int v_rd_off(int d0, int ks, int half) { return d0 * 512 + ks * 4096 + half * 2048; }
__device__ __forceinline__ int crow(int r, int hi) { return (r & 3) + 8 * (r >> 2) + 4 * hi; }
__device__ __forceinline__ bf16x8 load8(const bf16* p) { return *reinterpret_cast<const bf16x8*>(p); }
__device__ __forceinline__ unsigned long long gld_u64(const unsigned long long* ubase, unsigned voff) {
    const unsigned long long b_ = (unsigned long long)ubase;
    const unsigned lo_ = __builtin_amdgcn_readfirstlane((unsigned)b_), hi_ = __builtin_amdgcn_readfirstlane((unsigned)(b_ >> 32));
    __amdgpu_buffer_rsrc_t r_ = __builtin_amdgcn_make_buffer_rsrc((void*)(((unsigned long long)hi_ << 32) | lo_), (short)0, 0x7fffffff, 0x00020000);
    typedef unsigned u32x2_ __attribute__((ext_vector_type(2)));
    const u32x2_ w_ = __builtin_amdgcn_raw_buffer_load_b64(r_, (int)voff, 0, 0); return ((unsigned long long)w_.y << 32) | w_.x; }
__device__ __forceinline__ bf16x8 gld8(const bf16* ubase, unsigned voff) {
    const unsigned long long b_ = (unsigned long long)ubase;
    const unsigned lo_ = __builtin_amdgcn_readfirstlane((unsigned)b_), hi_ = __builtin_amdgcn_readfirstlane((unsigned)(b_ >> 32));
    __amdgpu_buffer_rsrc_t r_ = __builtin_amdgcn_make_buffer_rsrc((void*)(((unsigned long long)hi_ << 32) | lo_), (short)0, 0x7fffffff, 0x00020000);
    const v4u w_ = __builtin_amdgcn_raw_buffer_load_b128(r_, (int)voff, 0, 0); return __builtin_bit_cast(bf16x8, w_); }

__device__ __forceinline__ unsigned selbits(unsigned m, int c) { unsigned t; asm("v_bfe_i32 %0, %1, %2, 1" : "=v"(t) : "v"(m), "n"(c)); return t; }
__device__ __forceinline__ void mask_tile(f32x16& p0, f32x16& p1, int dq) {
    const float NEG = -__builtin_inff();
#pragma unroll
    for (int r = 0; r < 16; ++r) {
        const int c = (r & 3) + 8 * (r >> 2);
        if (dq - c < 0) p0[r] = NEG;
        if (dq - c - 32 < 0) p1[r] = NEG;
    }
}
template <bool MASKED>
__device__ __forceinline__ void partialSM(f32x16& p0, f32x16& p1, float& m_reg, float& mn, float& alpha, const float SCALE, unsigned mlo) {
    float pmax = p0[0]; for (int r = 1; r < 16; ++r) pmax = fmaxf(pmax, p0[r]); for (int r = 0; r < 16; ++r) pmax = fmaxf(pmax, p1[r]);
    { auto rr = __builtin_amdgcn_permlane32_swap(__float_as_uint(pmax), __float_as_uint(pmax), false, false);
      pmax = fmaxf(__uint_as_float(rr[0]), __uint_as_float(rr[1])); }
    const float C2 = 1.4426950408889634f * SCALE;
    if (__builtin_expect(__all((pmax - m_reg) * SCALE <= THR), 1)) { mn = m_reg; alpha = 1.f; }
    else { mn = fmaxf(m_reg, pmax); alpha = __builtin_amdgcn_exp2f((m_reg - mn) * C2); m_reg = mn; }
    const float mnL = -mn * C2;
    for (int r = 0; r < 16; ++r) p0[r] = fmaf(p0[r], C2, mnL); for (int r = 0; r < 16; ++r) p1[r] = fmaf(p1[r], C2, mnL);
    for (int r = 0; r < 16; ++r) p0[r] = __builtin_amdgcn_exp2f(p0[r]);
    if (MASKED) {
#pragma unroll
        for (int r = 0; r < 16; ++r) { const int c = (r & 3) + 8 * (r >> 2); p0[r] = __uint_as_float(__float_as_uint(p0[r]) & selbits(mlo, c)); }
    }
}
template <bool MASKED>
__device__ __forceinline__ void finishSM(f32x16& p0, f32x16& p1, float alpha, float& l_reg, bf16x8& pa0, bf16x8& pa1, bf16x8& pa2, bf16x8& pa3, unsigned mhi) {
    for (int r = 0; r < 16; ++r) p1[r] = __builtin_amdgcn_exp2f(p1[r]);
    if (MASKED) {
#pragma unroll
        for (int r = 0; r < 16; ++r) { const int c = (r & 3) + 8 * (r >> 2); p1[r] = __uint_as_float(__float_as_uint(p1[r]) & selbits(mhi, c)); }
    }
    float ps = 0; for (int r = 0; r < 16; ++r) ps += p0[r]; for (int r = 0; r < 16; ++r) ps += p1[r];
    { auto rr = __builtin_amdgcn_permlane32_swap(__float_as_uint(ps), __float_as_uint(ps), false, false);
      ps = __uint_as_float(rr[0]) + __uint_as_float(rr[1]); }
    l_reg = l_reg * alpha + ps;
#define PK4(P, B_, OUT) do { unsigned a0 = cvtpk(P[B_+0], P[B_+1]), a1 = cvtpk(P[B_+2], P[B_+3]);                          \
        unsigned b0 = cvtpk(P[B_+4], P[B_+5]), b1 = cvtpk(P[B_+6], P[B_+7]);                                             \
        auto r0 = __builtin_amdgcn_permlane32_swap(a0, b0, false, false); auto r1 = __builtin_amdgcn_permlane32_swap(a1, b1, false, false); \
        v4u w = {r0[0], r1[0], r0[1], r1[1]}; OUT = *reinterpret_cast<bf16x8*>(&w); } while (0)
    PK4(p0, 0, pa0); PK4(p0, 8, pa1); PK4(p1, 0, pa2); PK4(p1, 8, pa3);
#undef PK4
}
template <int KB, bool PE>
__device__ __forceinline__ void qkt(f32x16& p0, f32x16& p1, const char* lds, int r32, int hi, const bf16x8* qr, int kpb, int qpb) {
    p0 = f32x16{}; p1 = f32x16{};
    const char* kb[4];
#pragma unroll
    for (int dd = 0; dd < 4; ++dd) kb[dd] = lds + OFF_K + KB * SHM_K + KSWZ(r32, (dd * 16 + hi * 8) * 2);
    const char* qp_ = lds + qpb;
#pragma unroll
    for (int d0 = 0; d0 < 8; ++d0) { const char* a = kb[d0 & 3] + (d0 >> 2) * 128;
        bf16x8 b0 = *reinterpret_cast<const bf16x8*>(a);
        bf16x8 b1 = *reinterpret_cast<const bf16x8*>(a + 32 * KROW);
        bf16x8 qf; if (d0 >= 4) qf = *reinterpret_cast<const bf16x8*>(qp_ + (d0 - 4) * 32); else qf = qr[d0];
        p0 = __builtin_amdgcn_mfma_f32_32x32x16_bf16(b0, qf, p0, 0, 0, 0);
        p1 = __builtin_amdgcn_mfma_f32_32x32x16_bf16(b1, qf, p1, 0, 0, 0); }
    if (PE) {
        const char* kp_ = lds + kpb;
#pragma unroll
        for (int d0 = 0; d0 < 4; ++d0) {
            bf16x8 b0 = *reinterpret_cast<const bf16x8*>(kp_ + (KB * SHM_KP + d0 * 32));
            bf16x8 b1 = *reinterpret_cast<const bf16x8*>(kp_ + (KB * SHM_KP + d0 * 32 + 32 * KPROW));
            const bf16x8 qf = *reinterpret_cast<const bf16x8*>(qp_ + 128 + d0 * 32);
            p0 = __builtin_amdgcn_mfma_f32_32x32x16_bf16(b0, qf, p0, 0, 0, 0);
            p1 = __builtin_amdgcn_mfma_f32_32x32x16_bf16(b1, qf, p1, 0, 0, 0); }
    }
}
template <int VB>
__device__ __forceinline__ void pv_tile(f32x16* o, int vb0, bf16x8 pa0, bf16x8 pa1, bf16x8 pa2, bf16x8 pa3) {
#define TRRD(dst, off) asm volatile("ds_read_b64_tr_b16 %0, %1 offset:%2" : "=&v"(dst) : "v"(vb0), "i"(off) : "memory")
#define PV_D0(d0) do { s16x4 l0, l1, l2, l3, h0, h1, h2, h3; constexpr int b_ = OFF_V + VB * SHM_V + v_rd_off(d0, 0, 0); \
        TRRD(l0, b_); TRRD(h0, b_ + 2048); TRRD(l1, b_ + 4096); TRRD(h1, b_ + 6144); TRRD(l2, b_ + 8192); TRRD(h2, b_ + 10240); TRRD(l3, b_ + 12288); TRRD(h3, b_ + 14336); \
        asm volatile("s_waitcnt lgkmcnt(0)" ::: "memory"); SBAR();   \
        o[d0] = __builtin_amdgcn_mfma_f32_32x32x16_bf16(pa0, (bf16x8){l0[0], l0[1], l0[2], l0[3], h0[0], h0[1], h0[2], h0[3]}, o[d0], 0, 0, 0);   \
        o[d0] = __builtin_amdgcn_mfma_f32_32x32x16_bf16(pa1, (bf16x8){l1[0], l1[1], l1[2], l1[3], h1[0], h1[1], h1[2], h1[3]}, o[d0], 0, 0, 0);   \
        o[d0] = __builtin_amdgcn_mfma_f32_32x32x16_bf16(pa2, (bf16x8){l2[0], l2[1], l2[2], l2[3], h2[0], h2[1], h2[2], h2[3]}, o[d0], 0, 0, 0);   \
        o[d0] = __builtin_amdgcn_mfma_f32_32x32x16_bf16(pa3, (bf16x8){l3[0], l3[1], l3[2], l3[3], h3[0], h3[1], h3[2], h3[3]}, o[d0], 0, 0, 0); } while (0)
    PV_D0(0); PV_D0(1); PV_D0(2); PV_D0(3);
#undef PV_D0
#undef TRRD
}

template <int VB, bool MASKED>
__device__ __forceinline__ void pv_sm(f32x16* o, int vb0, bf16x8 pa0, bf16x8 pa1, bf16x8 pa2, bf16x8 pa3,
                                      f32x16& p0, f32x16& p1, float& m_reg, float& mn, float& alpha, const float SCALE, unsigned mlo) {
#define TRRD(dst, off) asm volatile("ds_read_b64_tr_b16 %0, %1 offset:%2" : "=&v"(dst) : "v"(vb0), "i"(off) : "memory")
#define PVS_LD(d0) s16x4 l0, l1, l2, l3, h0, h1, h2, h3; { constexpr int b_ = OFF_V + VB * SHM_V + v_rd_off(d0, 0, 0); \
        TRRD(l0, b_); TRRD(h0, b_ + 2048); TRRD(l1, b_ + 4096); TRRD(h1, b_ + 6144); TRRD(l2, b_ + 8192); TRRD(h2, b_ + 10240); TRRD(l3, b_ + 12288); TRRD(h3, b_ + 14336); \
        asm volatile("s_waitcnt lgkmcnt(0)" ::: "memory"); SBAR(); }
#define PVS_MM(d0) do { \
        o[d0] = __builtin_amdgcn_mfma_f32_32x32x16_bf16(pa0, (bf16x8){l0[0], l0[1], l0[2], l0[3], h0[0], h0[1], h0[2], h0[3]}, o[d0], 0, 0, 0);   \
        o[d0] = __builtin_amdgcn_mfma_f32_32x32x16_bf16(pa1, (bf16x8){l1[0], l1[1], l1[2], l1[3], h1[0], h1[1], h1[2], h1[3]}, o[d0], 0, 0, 0);   \
        o[d0] = __builtin_amdgcn_mfma_f32_32x32x16_bf16(pa2, (bf16x8){l2[0], l2[1], l2[2], l2[3], h2[0], h2[1], h2[2], h2[3]}, o[d0], 0, 0, 0);   \
        o[d0] = __builtin_amdgcn_mfma_f32_32x32x16_bf16(pa3, (bf16x8){l3[0], l3[1], l3[2], l3[3], h3[0], h3[1], h3[2], h3[3]}, o[d0], 0, 0, 0); } while (0)
#define PVS_SGB(nv) do { _Pragma("unroll") for (int g_ = 0; g_ < 4; ++g_) { __builtin_amdgcn_sched_group_barrier(0x008, 1, 0); __builtin_amdgcn_sched_group_barrier(0x402, nv, 0); } } while (0)
    const float C2 = 1.4426950408889634f * SCALE;
    float pmax, mnL;
    { PVS_LD(0); PVS_MM(0);
      float pm0 = p0[0], pm1 = p1[0];
#pragma unroll
      for (int r = 1; r < 16; ++r) { pm0 = fmaxf(pm0, p0[r]); pm1 = fmaxf(pm1, p1[r]); }
      pmax = fmaxf(pm0, pm1);
      { auto rr = __builtin_amdgcn_permlane32_swap(__float_as_uint(pmax), __float_as_uint(pmax), false, false);
        pmax = fmaxf(__uint_as_float(rr[0]), __uint_as_float(rr[1])); }
      PVS_SGB(5); }
    { PVS_LD(1); PVS_MM(1);
      const bool keep = __all((pmax - m_reg) * SCALE <= THR);
      mn = keep ? m_reg : fmaxf(m_reg, pmax); alpha = keep ? 1.f : __builtin_amdgcn_exp2f((m_reg - mn) * C2); m_reg = mn;
      mnL = -mn * C2;
#pragma unroll
      for (int r = 0; r < 16; ++r) p0[r] = fmaf(p0[r], C2, mnL);
      PVS_SGB(7); }
    { PVS_LD(2); PVS_MM(2);
#pragma unroll
      for (int r = 0; r < 16; ++r) p1[r] = fmaf(p1[r], C2, mnL);
#pragma unroll
      for (int r = 0; r < 6; ++r) p0[r] = __builtin_amdgcn_exp2f(p0[r]);
      PVS_SGB(6); }
    { PVS_LD(3); PVS_MM(3);
#pragma unroll
      for (int r = 6; r < 16; ++r) p0[r] = __builtin_amdgcn_exp2f(p0[r]);
      if (MASKED) {
#pragma unroll
          for (int r = 0; r < 16; ++r) { const int c = (r & 3) + 8 * (r >> 2); p0[r] = __uint_as_float(__float_as_uint(p0[r]) & selbits(mlo, c)); }
      }
      asm volatile("" : "+v"(p0), "+v"(p1));
      PVS_SGB(MASKED ? 8 : 3); }
#undef PVS_LD
#undef PVS_MM
#undef PVS_SGB
#undef TRRD
}

struct BlockRef { const bf16* Q; const bf16* K; const bf16* V; const bf16* KP; bf16* O; const unsigned long long* M; int P0; };
template <bool PE> struct Seam { bf16x8 qr[4]; bf16x8 qx[PE ? 8 : 4]; bf16x8 st_v0, st_v1, st_k0, st_k1, st_kp; };

#define VMW() asm volatile("s_waitcnt vmcnt(0)" ::: "memory")
#define VMWN(n) asm volatile("s_waitcnt vmcnt(%0)" :: "i"(n) : "memory")
#define SLOAD_H(Kp, Vp, KPp, k0) do { S.st_v0 = gld8((Vp) + (size_t)(k0) * LDV, voffkv); S.st_v1 = gld8((Vp) + (size_t)((k0) + 32) * LDV, voffkv);     \
                         S.st_k0 = gld8((Kp) + (size_t)(k0) * LDK, voffkv); S.st_k1 = gld8((Kp) + (size_t)((k0) + 32) * LDK, voffkv);                       \
                         if (PE) S.st_kp = gld8((KPp) + (size_t)(k0) * 64, voffkp); } while (0)
#define SWRITE_HK(bf) do { *(bf16x8*)(lds + OFF_K + (bf) * SHM_K + kws) = S.st_k0; *(bf16x8*)(lds + OFF_K + (bf) * SHM_K + kws + 32 * KROW) = S.st_k1;   \
                           if (PE) *(bf16x8*)(lds + kpws + (bf) * SHM_KP) = S.st_kp; } while (0)
#define SWRITE_HV(bf) do { *(bf16x8*)(lds + OFF_V + (bf) * SHM_V + vst0) = S.st_v0; *(bf16x8*)(lds + OFF_V + (bf) * SHM_V + vst1) = S.st_v1; } while (0)
#define SWRITE_H(bf) do { SWRITE_HV(bf); SWRITE_HK(bf); } while (0)
#define QLOAD(ref) do { _Pragma("unroll") for (int d0 = 0; d0 < 4; ++d0) S.qr[d0] = gld8((ref).Q + d0 * 16, voffq); } while (0)
#define QXLOAD(ref) do { _Pragma("unroll") for (int c_ = 0; c_ < QX / 16; ++c_) S.qx[c_] = gld8((ref).Q + (size_t)(c_ * (512 / QX)) * LDQ, voffqx); } while (0)
#define QXWRITE() do { _Pragma("unroll") for (int c_ = 0; c_ < QX / 16; ++c_) *(bf16x8*)(lds + qxw + c_ * (512 / QX) * QXROW) = S.qx[c_]; } while (0)

#define ATT_LANE_CONSTS \
    constexpr int QX = PE ? 128 : 64, QXROW = 2 * QX + 16, SHM_QP = QBLK * QXROW, CPR = QX / 8;                                                  \
    const int tid = threadIdx.x, wid = __builtin_amdgcn_readfirstlane(tid >> 6), lane = tid & 63, r32 = lane & 31, hi = lane >> 5;             \
    const int sr = tid >> 4, sc = (tid & 15) * 8, kws = KSWZ(sr, sc * 2), kpws = OFF_KP + KPSWZ(tid >> 3, tid & 7);                            \
    const unsigned voffkv = (unsigned)(sr * LDK + sc) * 2u, voffkp = (unsigned)((tid >> 3) * 64 + (tid & 7) * 8) * 2u;                          \
    const unsigned voffq = (unsigned)((wid * QBLK + r32) * LDQ + hi * 8) * 2u, voffqx = (unsigned)((wid * QBLK + lane / CPR) * LDQ + 64 + (lane % CPR) * 8) * 2u; \
    const int qxw = OFF_QP + wid * SHM_QP + (lane / CPR) * QXROW + (lane % CPR) * 16;
template <bool PE, bool MASKED, int LDQ, int LDK, int LDV>
__device__ __forceinline__ void attn_prime(const BlockRef& cur, char* lds, Seam<PE>& S) {
    static_assert(LDK == LDV, "k and v share the staging offset");
    ATT_LANE_CONSTS
    (void)kws; (void)kpws; (void)qxw; (void)r32; (void)hi;
    QLOAD(cur); QXLOAD(cur);
    SLOAD_H(cur.K, cur.V, cur.KP, 0); VMW(); SWRITE_HK(0);
    __syncthreads();
}
template <bool PE, bool MASKED, int LDQ, int LDK, int LDV, bool DRY>
__device__ __forceinline__ void attn_block(const BlockRef& cur, const BlockRef& nxt, char* lds, Seam<PE>& S, const float SCALE, const bool rdry, const float* psrc, bf16* pdst, const int kblk) {
    ATT_LANE_CONSTS
    const int NT = (cur.P0 + QB - 1) / KVBLK + 1;
    const int qlo = cur.P0 + wid * QBLK, qm = qlo + r32 - 4 * hi;
    float* ws = (float*)(lds + OFF_WS) + wid * 64; float* li_l = ws, * al_l = ws + 32;
    float m_reg = -1e30f, l_reg = 0; f32x16 o[4] = {};
    const int vst0 = v_st(sr, sc), vst1 = v_st(32 + sr, sc);
    const int vb0 = (int)(uintptr_t)lds + v_rd_base(lane);
    const int kpb = OFF_KP + r32 * KPROW + hi * 16, qpb = OFF_QP + wid * SHM_QP + r32 * QXROW + hi * 16 - (PE ? 0 : 0);
    const bf16* Kh = cur.K; const bf16* Vh = cur.V; const bf16* KPh = cur.KP;
    const unsigned voffm = (unsigned)(wid * QBLK + r32) * 512u;
#define RESC(a) do { if (__any((a) < 1.f)) { if (hi == 0) al_l[r32] = (a); asm volatile("s_waitcnt lgkmcnt(0)" ::: "memory");              \
                     for (int d_ = 0; d_ < 4; ++d_) for (int r = 0; r < 16; ++r) o[d_][r] *= al_l[crow(r, hi)]; } } while (0)
#define KBASE(t) ((t) * KVBLK)
#define MASKT(P0_, P1_, t) do { if (!MASKED) { const int kb_ = KBASE(t); if (kb_ + KVBLK - 1 > qlo) mask_tile(P0_, P1_, qm - kb_); } } while (0)
#define MLOAD(mw, t) do { if (MASKED) mw = gld_u64(cur.M + (t), voffm); } while (0)
#define MLO(mw) ((unsigned)(mw) >> (4 * hi))
#define MHI(mw) ((unsigned)((mw) >> 32) >> (4 * hi))
    constexpr int NQL = 4;
#define SEAM_K0() do { VMWN(NQL); SWRITE_HK(0); SBAR(); } while (0)
    f32x16 pA0, pA1, pB0, pB1; float mnA, mnB, alA, alB; bf16x8 pa0, pa1, pa2, pa3; unsigned long long mwA = 0, mwB = 0;
    QXWRITE(); SWRITE_HV(0); SBAR();
    if (NT > 1) SLOAD_H(Kh, Vh, KPh, KBASE(1));
    MLOAD(mwA, 0);
    SBAR(); qkt<0, PE>(pA0, pA1, lds, r32, hi, S.qr, kpb, qpb);
    MASKT(pA0, pA1, 0); partialSM<MASKED>(pA0, pA1, m_reg, mnA, alA, SCALE, MLO(mwA));
    if (NT > 1) { VMW(); SWRITE_H(1); }
    __syncthreads();
#define SGB_(mask, n) __builtin_amdgcn_sched_group_barrier(mask, n, 0)
#define SGB_STEP(nrd, nva) do { SGB_(0x100, nrd); SGB_(0x008, 1); SGB_(0x402, nva); SGB_(0x008, 1); SGB_(0x402, nva); } while (0)
#define SGB_QK_FIN() do { constexpr int NV_ = MASKED ? 6 : 3; SGB_(0x100, 2);                                              \
        SGB_STEP(2, NV_); SGB_STEP(2, NV_); SGB_STEP(2, NV_); SGB_STEP(3, NV_); SGB_STEP(3, NV_); SGB_STEP(3, NV_); SGB_STEP(3, NV_);                      \
        if (PE) { SGB_STEP(3, NV_); SGB_STEP(3, NV_); SGB_STEP(3, NV_); SGB_STEP(3, NV_); SGB_STEP(0, NV_); } else SGB_STEP(0, NV_); } while (0)
#define HALF_STEP(PX0, PX1, mnX, alX, mwX, PY0, PY1, alY, mwY, t, KB, VB, SB) do {                                            \
        SBAR(); MLOAD(mwX, t); qkt<KB, PE>(PX0, PX1, lds, r32, hi, S.qr, kpb, qpb);                                                \
        finishSM<MASKED>(PY0, PY1, alY, l_reg, pa0, pa1, pa2, pa3, MHI(mwY)); SGB_QK_FIN(); SBAR();                            \
        if ((t) + 1 < NT) { SLOAD_H(Kh, Vh, KPh, KBASE((t) + 1)); SBAR(); }                                                    \
        MASKT(PX0, PX1, (t)); SBAR(); pv_sm<VB, MASKED>(o, vb0, pa0, pa1, pa2, pa3, PX0, PX1, m_reg, mnX, alX, SCALE, MLO(mwX));                   \
        __syncthreads();                                                                                                      \
        if ((t) + 1 < NT) { VMW(); SWRITE_H(SB); }                                                                            \
        RESC(alX); __syncthreads(); } while (0)
    for (int t = 1; t + 1 < NT; t += 2) {
        HALF_STEP(pB0, pB1, mnB, alB, mwB, pA0, pA1, alA, mwA, t, 1, 0, 0);
        HALF_STEP(pA0, pA1, mnA, alA, mwA, pB0, pB1, alB, mwB, t + 1, 0, 1, 1);
    }
    const bool even = (NT & 1) == 0;
    (void)even;
    MLOAD(mwB, NT - 1);
    SBAR();
    const unsigned voffg = (unsigned)((wid * QBLK + (lane >> 4)) * 1024 + (lane & 15) * 8) * 2u;
    bf16x8 szq[8];
#pragma unroll
    for (int j = 0; j < 8; ++j) szq[j] = gld8(cur.O + (size_t)(4 * j) * 1024, voffg);
    constexpr size_t PNCH = (size_t)NB * 4096 * 256 / 8;
    f32x4 pcv[2][2]; size_t pcc[2];
    { const size_t gth_ = (size_t)gridDim.x * (NW * 64), gid_ = (size_t)blockIdx.x * (NW * 64) + tid;
#pragma unroll
      for (int u = 0; u < 2; ++u) { const size_t c_ = (size_t)(kblk * 2 + u) * gth_ + gid_; pcc[u] = c_; const size_t cl_ = c_ < PNCH ? c_ : PNCH - 1;
          pcv[u][0] = *(const f32x4*)(psrc + cl_ * 8); pcv[u][1] = *(const f32x4*)(psrc + cl_ * 8 + 4); } }
    SBAR(); qkt<1, PE>(pB0, pB1, lds, r32, hi, S.qr, kpb, qpb);
    finishSM<MASKED>(pA0, pA1, alA, l_reg, pa0, pa1, pa2, pa3, MHI(mwA)); SGB_QK_FIN(); SBAR();
    MASKT(pB0, pB1, NT - 1); SBAR(); pv_sm<0, MASKED>(o, vb0, pa0, pa1, pa2, pa3, pB0, pB1, m_reg, mnB, alB, SCALE, MLO(mwB));
    SBAR(); SLOAD_H(nxt.K, nxt.V, nxt.KP, 0); SBAR();
    QLOAD(nxt);
    SBAR();
    __syncthreads(); RESC(alB);
    finishSM<MASKED>(pB0, pB1, alB, l_reg, pa0, pa1, pa2, pa3, MHI(mwB)); SBAR();
    pv_tile<1>(o, vb0, pa0, pa1, pa2, pa3);
    SBAR(); SEAM_K0(); QXLOAD(nxt); SBAR();
    if (hi == 0) li_l[r32] = l_reg; asm volatile("s_waitcnt lgkmcnt(0)" ::: "memory");
    float rli[16];
#pragma unroll
    for (int r = 0; r < 16; ++r) rli[r] = __builtin_amdgcn_rcpf(li_l[crow(r, hi)]);
    char* stg = lds + OFF_QP + wid * (QBLK * 272) + (4 * hi) * 272 + r32 * 2;
#pragma unroll
    for (int d0 = 0; d0 < 4; ++d0)
#pragma unroll
        for (int r = 0; r < 16; r += 2) { const unsigned w = cvtpk(o[d0][r] * rli[r], o[d0][r + 1] * rli[r + 1]);
            *(unsigned short*)(stg + ((r & 3) + 8 * (r >> 2)) * 272 + d0 * 64) = (unsigned short)w;
            *(unsigned short*)(stg + (((r + 1) & 3) + 8 * ((r + 1) >> 2)) * 272 + d0 * 64) = (unsigned short)(w >> 16); }
    asm volatile("s_waitcnt lgkmcnt(0)" ::: "memory");
    const char* strd = lds + OFF_QP + wid * (QBLK * 272) + (lane >> 4) * 272 + (lane & 15) * 16;
#pragma unroll
    for (int j = 0; j < 8; ++j) { const v4u ow = *(const v4u*)(strd + (4 * j) * 272); const v4u zw = __builtin_bit_cast(v4u, szq[j]); v4u gw;
#pragma unroll
        for (int e = 0; e < 4; ++e) gw[e] = cvtpk(__uint_as_float(ow[e] << 16) * __uint_as_float(zw[e] << 16), __uint_as_float(ow[e] & 0xffff0000u) * __uint_as_float(zw[e] & 0xffff0000u));
        v4u* gp = (v4u*)((char*)(cur.O + (size_t)(4 * j) * 1024) + voffg);
        if (!DRY && !rdry) *gp = gw; else asm volatile("" :: "v"(gw)); }
#pragma unroll
    for (int u = 0; u < 2; ++u) { const v4u pw = pack8(pcv[u][0], pcv[u][1]); if (pcc[u] < PNCH) *(v4u*)(pdst + pcc[u] * 8) = pw; }
    __syncthreads();
#undef RESC
#undef KBASE
#undef MASKT
#undef MLOAD
#undef MLO
#undef MHI
#undef SEAM_K0
#undef HALF_STEP
}
#undef VMW
#undef VMWN
#undef SLOAD_H
#undef SWRITE_HK
#undef SWRITE_HV
#undef SWRITE_H
#undef QLOAD
#undef QXLOAD
#undef QXWRITE

struct Item { int bh, qb0, qb1; };
__device__ __forceinline__ Item decode(int L, int nhkv) {
    const int Gq = 8 / nhkv, xcd = L & 7, k = L >> 3, per = Gq * 8, gi = k / per, r = k - gi * per;
    Item it; it.bh = (gi * 8 + xcd) * Gq + r / 8; const int x = r % 8; it.qb0 = x; it.qb1 = 15 - x; return it;
}
template <bool PE, bool MASKED, int LDQ, int QH, int LDK, int LDV, int NHKV>
__device__ __forceinline__ BlockRef make_ref(const Item& it, int pass, const bf16* Q, const bf16* K, const bf16* V, const bf16* KP, bf16* O, const unsigned long long* M) {
    const int qb = pass ? it.qb1 : it.qb0, b = it.bh >> 3, h = it.bh & 7, hk = h / (8 / NHKV); const size_t tok0 = (size_t)b * SEQ + (size_t)qb * QB;
    BlockRef r; r.Q = Q + tok0 * LDQ + h * QH; r.K = K + (size_t)b * SEQ * LDK + hk * 128; r.V = V + (size_t)b * SEQ * LDV + hk * 128; r.KP = PE ? KP + (size_t)b * SEQ * 64 : nullptr;
    r.O = O + tok0 * 1024 + h * 128; r.M = MASKED ? M + tok0 * 64 : nullptr; r.P0 = qb * QB; return r;
}
template <bool PE, bool MASKED, int LDQ, int QH, int LDK, int LDV, int NHKV, bool DRY = false>
__device__ __forceinline__ void attn_phase(char* lds, const bf16* Q, const bf16* K, const bf16* V, const bf16* KP, bf16* O, const unsigned long long* M, const float SCALE, const float* psrc, bf16* pdst, const bool rdry = false) {
    const int total = 8 * NB * 8, stride = gridDim.x;
    int L = blockIdx.x; if (L >= total) return;
    if (__builtin_amdgcn_readfirstlane((int)threadIdx.x) >= 256) __builtin_amdgcn_s_setprio(1);
    Item it = decode(L, NHKV); int pass = 0, kblk = 0;
    BlockRef cur = make_ref<PE, MASKED, LDQ, QH, LDK, LDV, NHKV>(it, 0, Q, K, V, KP, O, M);
    Seam<PE> S;
    attn_prime<PE, MASKED, LDQ, LDK, LDV>(cur, lds, S);
    for (;;) {
        const bool more_pass = pass == 0, more_item = L + stride < total, last = !more_pass && !more_item;
        Item itn = it; int passn = pass + 1, Ln = L;
        if (!more_pass) { passn = 0; Ln = more_item ? L + stride : L; itn = decode(Ln, NHKV); }
        const BlockRef nxt = last ? cur : make_ref<PE, MASKED, LDQ, QH, LDK, LDV, NHKV>(itn, passn, Q, K, V, KP, O, M);
        attn_block<PE, MASKED, LDQ, LDK, LDV, DRY>(cur, nxt, lds, S, SCALE, rdry, psrc, pdst, kblk); ++kblk;
        if (last) break;
        cur = nxt; it = itn; pass = passn; L = Ln;
    }
    __builtin_amdgcn_s_setprio(0);
    { constexpr size_t PNCH = (size_t)NB * 4096 * 256 / 8; const size_t gth_ = (size_t)gridDim.x * (NW * 64);
      for (size_t c_ = (size_t)kblk * 2 * gth_ + (size_t)blockIdx.x * (NW * 64) + threadIdx.x; c_ < PNCH; c_ += gth_) {
          const f32x4 a_ = *(const f32x4*)(psrc + c_ * 8), b_ = *(const f32x4*)(psrc + c_ * 8 + 4); *(v4u*)(pdst + c_ * 8) = pack8(a_, b_); } }
}
#undef KSWZ
#undef KPSWZ
#undef SBAR
}
#define EPI_ROWS _Pragma("unroll") for (int ai = 0; ai < 2; ++ai) _Pragma("unroll") for (int m = 0; m < 4; ++m)
#define EPI_ROW (u.pm * 256 + ai * 128 + wr * 64 + m * 16 + fr)
#define EPI_FENCE() __builtin_amdgcn_sched_barrier(0)
__device__ __forceinline__ __amdgpu_buffer_rsrc_t epi_rsrc(const void* ubase) {
    const unsigned long long b_ = (unsigned long long)ubase;
    const unsigned lo_ = __builtin_amdgcn_readfirstlane((unsigned)b_), hi_ = __builtin_amdgcn_readfirstlane((unsigned)(b_ >> 32));
    return __builtin_amdgcn_make_buffer_rsrc((void*)(((unsigned long long)hi_ << 32) | lo_), (short)0, 0x7fffffff, 0x00020000); }
__device__ __forceinline__ v4u epi_ld16(__amdgpu_buffer_rsrc_t r, unsigned voff) { return __builtin_amdgcn_raw_buffer_load_b128(r, (int)voff, 0, 0); }
typedef const f32x4 (&AccRef)[2][2][4][2];
template <int NP>
__device__ __forceinline__ void wave_rstd(const float* rs, int pm, int wr, int fr, int fq, float invn, float (&out)[2][4]) {
    const int l = fq * 16 + fr; float r2[2];
#pragma unroll
    for (int ai = 0; ai < 2; ++ai) { const int row = pm * 256 + ai * 128 + wr * 64 + l; float s;
        if (NP == 16) { const f32x4* p = (const f32x4*)(rs + (size_t)row * 16); const f32x4 a = p[0], b = p[1], c = p[2], d = p[3];
            s = ((a[0] + a[1]) + (a[2] + a[3])) + ((b[0] + b[1]) + (b[2] + b[3])) + ((c[0] + c[1]) + (c[2] + c[3])) + ((d[0] + d[1]) + (d[2] + d[3])); }
        else { const f32x4 a = *(const f32x4*)(rs + (size_t)row * 4); s = (a[0] + a[1]) + (a[2] + a[3]); }
        r2[ai] = rsqrtf(s * invn + NORM_EPS); }
#pragma unroll
    for (int ai = 0; ai < 2; ++ai)
#pragma unroll
        for (int m = 0; m < 4; ++m) out[ai][m] = __shfl(r2[ai], m * 16 + fr);
}

struct RstdHalf { f32x4 a, b, c, d; };
__device__ __forceinline__ void rstd_half_issue(const float* rs, int pm, int wr, int fr, int fq, int ai, RstdHalf& h) {
    const int l = fq * 16 + fr; const f32x4* p = (const f32x4*)(rs + (size_t)(pm * 256 + ai * 128 + wr * 64 + l) * 16); h.a = p[0]; h.b = p[1]; h.c = p[2]; h.d = p[3]; }
__device__ __forceinline__ void rstd_half_finish(const RstdHalf& h, int fr, float invn, float (&out)[4]) {
    const float s_ = ((h.a[0] + h.a[1]) + (h.a[2] + h.a[3])) + ((h.b[0] + h.b[1]) + (h.b[2] + h.b[3])) + ((h.c[0] + h.c[1]) + (h.c[2] + h.c[3])) + ((h.d[0] + h.d[1]) + (h.d[2] + h.d[3]));
    const float r2 = rsqrtf(s_ * invn + NORM_EPS);
#pragma unroll
    for (int m = 0; m < 4; ++m) out[m] = __shfl(r2, m * 16 + fr); }

struct EpiMlaIn {
    static constexpr bool PERM = true, AFTER_DRAIN = false;
    const float* rsx; bf16* cq; bf16* ckv; bf16* sz; bf16* kpe; float* rsq; float* rskv; const unsigned* rope32;
    __device__ __forceinline__ void operator()(AccRef acc, const pg8::Unit& u, int wr, int wc, int fr, int fq) const {
        const int pn = u.pn; float rst[2][4]; wave_rstd<16>(rsx, u.pm, wr, fr, fq, 1.f / 1024.f, rst);
        if (pn < 2) { bf16* dst = pn == 0 ? cq : ckv; float* rs = pn == 0 ? rsq : rskv;
            EPI_ROWS { const int row = EPI_ROW; const float rstd = rst[ai][m]; float ss = 0.f;
#pragma unroll
                for (int bj = 0; bj < 2; ++bj) { const f32x4 v0 = acc[ai][bj][m][0] * rstd, v1 = acc[ai][bj][m][1] * rstd; ss += sq4(v0) + sq4(v1);
                    *(v4u*)(dst + (size_t)row * 256 + bj * 128 + wc * 32 + fq * 8) = pack8(v0, v1); }
                ss += __shfl_xor(ss, 16); ss += __shfl_xor(ss, 32);
                if (fq == 0) rs[(size_t)row * 4 + wc] = ss; }
        } else if (pn < 6) {
            EPI_ROWS { const int row = EPI_ROW; const float rstd = rst[ai][m];
#pragma unroll
                for (int bj = 0; bj < 2; ++bj) { f32x4 v0 = acc[ai][bj][m][0] * rstd, v1 = acc[ai][bj][m][1] * rstd;
#pragma unroll
                    for (int e = 0; e < 4; ++e) { v0[e] = silu_f(v0[e]); v1[e] = silu_f(v1[e]); }
                    *(v4u*)(sz + (size_t)row * 1024 + (pn - 2) * 256 + bj * 128 + wc * 32 + fq * 8) = pack8(v0, v1); } }
        } else if (wc < 2) {
            const int c = wc * 32 + fq * 8;
#pragma unroll
            for (int ai = 0; ai < 2; ++ai)
            { v4u cs[4];
#pragma unroll
                for (int m = 0; m < 4; ++m) cs[m] = *(const v4u*)(rope32 + (size_t)EPI_ROW * 32 + (c >> 1));
                EPI_FENCE();
#pragma unroll
                for (int m = 0; m < 4; ++m) { const int row = EPI_ROW; const float rstd = rst[ai][m]; f32x4 v0 = acc[ai][0][m][0] * rstd, v1 = acc[ai][0][m][1] * rstd;
                    rope8h(v0, v1, cs[m]);
                    *(v4u*)(kpe + (size_t)row * 64 + c) = pack8(v0, v1); } }
        }
    }
};
struct EpiMlaQ {
    static constexpr bool PERM = true, AFTER_DRAIN = false;
    const float* rsq; bf16* q; const unsigned* rope32;
    __device__ __forceinline__ void operator()(AccRef acc, const pg8::Unit& u, int wr, int wc, int fr, int fq) const {
        int col[2], cin[2];
#pragma unroll
        for (int bj = 0; bj < 2; ++bj) { col[bj] = u.pn * 256 + bj * 128 + wc * 32 + fq * 8; const int h = col[bj] / 192; cin[bj] = col[bj] - h * 192; }
        const __amdgpu_buffer_rsrc_t rt_ = epi_rsrc(rope32 + (size_t)u.pm * 256 * 32);
        const unsigned to_ = (unsigned)((wr * 64 + fr) * 32) * 4u;
        v4u cs0[4][2], cs1[4][2];
#pragma unroll
        for (int m = 0; m < 4; ++m) {
#pragma unroll
            for (int bj = 0; bj < 2; ++bj) if (cin[bj] >= 128) { const unsigned o_ = to_ + (unsigned)((m * 16) * 32 + ((cin[bj] - 128) >> 1)) * 4u; cs0[m][bj] = epi_ld16(rt_, o_); cs1[m][bj] = epi_ld16(rt_, o_ + 128u * 32u * 4u); } }
        float rst[2][4]; wave_rstd<4>(rsq, u.pm, wr, fr, fq, 1.f / 256.f, rst);
#pragma unroll
        for (int ai = 0; ai < 2; ++ai)
        { v4u cs[4][2];
#pragma unroll
            for (int m = 0; m < 4; ++m) {
#pragma unroll
                for (int bj = 0; bj < 2; ++bj) cs[m][bj] = ai == 0 ? cs0[m][bj] : cs1[m][bj]; }
            EPI_FENCE();
#pragma unroll
            for (int m = 0; m < 4; ++m) { const int row = EPI_ROW; const float rstd = rst[ai][m];
#pragma unroll
                for (int bj = 0; bj < 2; ++bj) { f32x4 v0 = acc[ai][bj][m][0] * rstd, v1 = acc[ai][bj][m][1] * rstd;
                    if (cin[bj] >= 128) rope8h(v0, v1, cs[m][bj]);
                    *(v4u*)(q + (size_t)row * 1536 + col[bj]) = pack8(v0, v1); } } }
    }
};
struct EpiMlaKV {
    static constexpr bool PERM = true, AFTER_DRAIN = false;
    const float* rskv; bf16* dst;
    __device__ __forceinline__ void operator()(AccRef acc, const pg8::Unit& u, int wr, int wc, int fr, int fq) const {
        float rst[2][4]; wave_rstd<4>(rskv, u.pm, wr, fr, fq, 1.f / 256.f, rst);
        EPI_ROWS { const int row = EPI_ROW; const float rstd = rst[ai][m];
#pragma unroll
            for (int bj = 0; bj < 2; ++bj) { const int col = u.pn * 256 + bj * 128 + wc * 32 + fq * 8;
                *(v4u*)(dst + (size_t)row * 1024 + col) = pack8(acc[ai][bj][m][0] * rstd, acc[ai][bj][m][1] * rstd); }
        }
    }
};
struct EpiPlain {
    static constexpr bool PERM = true, AFTER_DRAIN = false;
    bf16* dst;
    __device__ __forceinline__ void operator()(AccRef acc, const pg8::Unit& u, int wr, int wc, int fr, int fq) const {
        EPI_ROWS { const int row = EPI_ROW;
#pragma unroll
            for (int bj = 0; bj < 2; ++bj) { const int col = u.pn * 256 + bj * 128 + wc * 32 + fq * 8;
                *(v4u*)(dst + (size_t)row * 1024 + col) = pack8(acc[ai][bj][m][0], acc[ai][bj][m][1]); }
        }
    }
};
#define SS8(ow) ({ const float r0 = bf2f((ow).x & 0xffffu), r1 = bf2f((ow).x >> 16), r2 = bf2f((ow).y & 0xffffu), r3 = bf2f((ow).y >> 16), r4 = bf2f((ow).z & 0xffffu), r5 = bf2f((ow).z >> 16), r6 = bf2f((ow).w & 0xffffu), r7 = bf2f((ow).w >> 16); \
                   ((r0 * r0 + r1 * r1) + (r2 * r2 + r3 * r3)) + ((r4 * r4 + r5 * r5) + (r6 * r6 + r7 * r7)); })
struct EpiOut {
    static constexpr bool PERM = true, AFTER_DRAIN = false;
    const bf16* xin; bf16* xb; float* rs1; bool dry;
    __device__ __forceinline__ void operator()(AccRef acc, const pg8::Unit& u, int wr, int wc, int fr, int fq) const {
        const size_t c0 = (size_t)u.pn * 256 + wc * 32 + fq * 8;
        v4u xw[2][4][2];
#pragma unroll
        for (int ai = 0; ai < 2; ++ai)
#pragma unroll
        for (int m = 0; m < 4; ++m) {
#pragma unroll
            for (int bj = 0; bj < 2; ++bj) xw[ai][m][bj] = *(const v4u*)(xin + (size_t)EPI_ROW * 1024 + c0 + bj * 128); }
        EPI_FENCE();
#pragma unroll
        for (int ai = 0; ai < 2; ++ai) {
#pragma unroll
        for (int m = 0; m < 4; ++m) { const int row = EPI_ROW; float ss = 0.f;
#pragma unroll
            for (int bj = 0; bj < 2; ++bj) { const v4u w = xw[ai][m][bj]; f32x4 a0 = acc[ai][bj][m][0], a1 = acc[ai][bj][m][1];
                a0[0] += bf2f(w.x & 0xffffu); a0[1] += bf2f(w.x >> 16); a0[2] += bf2f(w.y & 0xffffu); a0[3] += bf2f(w.y >> 16);
                a1[0] += bf2f(w.z & 0xffffu); a1[1] += bf2f(w.z >> 16); a1[2] += bf2f(w.w & 0xffffu); a1[3] += bf2f(w.w >> 16);
                const v4u ow = pack8(a0, a1); if (!dry) *(v4u*)(xb + (size_t)row * 1024 + c0 + bj * 128) = ow; ss += SS8(ow); }
            ss += __shfl_xor(ss, 16); ss += __shfl_xor(ss, 32);
            if (fq == 0 && !dry) rs1[(size_t)row * 16 + u.pn * 4 + wc] = ss; else asm volatile("" :: "v"(ss));
        } }
    }
};
struct EpiGate {
    static constexpr bool PERM = true, AFTER_DRAIN = false;
    const float* rs1; const bf16* x1; const bf16* pp; bf16* xb; float* rsx; bool dry;
    __device__ __forceinline__ void operator()(AccRef acc, const pg8::Unit& u, int wr, int wc, int fr, int fq) const {
        float rst[2][4]; RstdHalf rh; rstd_half_issue(rs1, u.pm, wr, fr, fq, 0, rh);
        const size_t c0 = (size_t)u.pn * 256 + wc * 32 + fq * 8;
        const __amdgpu_buffer_rsrc_t rx = epi_rsrc(x1 + (size_t)u.pm * 256 * 1024), rp = epi_rsrc(pp + (size_t)u.pm * 256 * 1024);
        const unsigned vo = (unsigned)((wr * 64 + fr) * 1024 + u.pn * 256 + wc * 32 + fq * 8) * 2u;
#pragma unroll
        for (int ai = 0; ai < 2; ++ai) { v4u xw[4][2], pw[4][2];
#pragma unroll
            for (int m = 0; m < 4; ++m)
#pragma unroll
                for (int bj = 0; bj < 2; ++bj) { const unsigned o_ = vo + (unsigned)((ai * 128 + m * 16) * 1024 + bj * 128) * 2u; xw[m][bj] = epi_ld16(rx, o_); pw[m][bj] = epi_ld16(rp, o_); }
            EPI_FENCE();
            rstd_half_finish(rh, fr, 1.f / 1024.f, rst[ai]);
            if (ai == 0) { rstd_half_issue(rs1, u.pm, wr, fr, fq, 1, rh); EPI_FENCE(); }
#pragma unroll
            for (int m = 0; m < 4; ++m) { const int row = EPI_ROW; const float rstd = rst[ai][m]; float ss = 0.f;
#pragma unroll
                for (int bj = 0; bj < 2; ++bj) { const v4u xv = xw[m][bj], pv = pw[m][bj];
                    const f32x4 g0 = acc[ai][bj][m][0] * rstd, g1 = acc[ai][bj][m][1] * rstd; f32x4 a0, a1;
                    a0[0] = bf2f(xv.x & 0xffffu) + bf2f(pv.x & 0xffffu) * sigmoid_f(g0[0]); a0[1] = bf2f(xv.x >> 16) + bf2f(pv.x >> 16) * sigmoid_f(g0[1]);
                    a0[2] = bf2f(xv.y & 0xffffu) + bf2f(pv.y & 0xffffu) * sigmoid_f(g0[2]); a0[3] = bf2f(xv.y >> 16) + bf2f(pv.y >> 16) * sigmoid_f(g0[3]);
                    a1[0] = bf2f(xv.z & 0xffffu) + bf2f(pv.z & 0xffffu) * sigmoid_f(g1[0]); a1[1] = bf2f(xv.z >> 16) + bf2f(pv.z >> 16) * sigmoid_f(g1[1]);
                    a1[2] = bf2f(xv.w & 0xffffu) + bf2f(pv.w & 0xffffu) * sigmoid_f(g1[2]); a1[3] = bf2f(xv.w >> 16) + bf2f(pv.w >> 16) * sigmoid_f(g1[3]);
                    const v4u ow = pack8(a0, a1); if (!dry) *(v4u*)(xb + (size_t)row * 1024 + c0 + bj * 128) = ow; ss += SS8(ow); }
                ss += __shfl_xor(ss, 16); ss += __shfl_xor(ss, 32);
                if (fq == 0 && !dry) rsx[(size_t)row * 16 + u.pn * 4 + wc] = ss; else asm volatile("" :: "v"(ss)); } }
    }
};
struct EpiDsaIn {
    static constexpr bool PERM = true, AFTER_DRAIN = false;
    const float* rsx; bf16* q; bf16* k; bf16* v; bf16* qi; bf16* sz; bf16* ki; float* wi; const unsigned* rope64; const unsigned* rope32;
    __device__ __forceinline__ void operator()(AccRef acc, const pg8::Unit& u, int wr, int wc, int fr, int fq) const {
        const int pn = u.pn;
        const int cb = wc * 32 + fq * 8;
        const bool rope_tile = pn < 5 || pn == 6 || pn == 7 || pn == 12;
        const unsigned* tab = (pn < 5) ? rope64 : rope32; const int tw = (pn < 5) ? 64 : 32, cm = (pn < 5) ? 127 : 63;
        v4u csa[2][4];
        if (rope_tile) {
#pragma unroll
            for (int ai = 0; ai < 2; ++ai)
#pragma unroll
                for (int m = 0; m < 4; ++m) csa[ai][m] = *(const v4u*)(tab + (size_t)EPI_ROW * tw + ((cb & cm) >> 1)); }
        float rst[2][4]; wave_rstd<16>(rsx, u.pm, wr, fr, fq, 1.f / 1024.f, rst);
#pragma unroll
        for (int ai = 0; ai < 2; ++ai)
        { v4u cs[4][2];
#pragma unroll
            for (int m = 0; m < 4; ++m) { cs[m][0] = csa[ai][m]; cs[m][1] = csa[ai][m]; }
            EPI_FENCE();
#pragma unroll
            for (int m = 0; m < 4; ++m) { const int row = EPI_ROW; const float rstd = rst[ai][m];
#pragma unroll
                for (int bj = 0; bj < 2; ++bj) { const int c = bj * 128 + cb;
                    f32x4 v0 = acc[ai][bj][m][0] * rstd, v1 = acc[ai][bj][m][1] * rstd;
                    if (pn < 4) { rope8h(v0, v1, cs[m][bj]); *(v4u*)(q + (size_t)row * 1024 + pn * 256 + c) = pack8(v0, v1); }
                    else if (pn == 4) { rope8h(v0, v1, cs[m][bj]); *(v4u*)(k + (size_t)row * 256 + c) = pack8(v0, v1); }
                    else if (pn == 5) { *(v4u*)(v + (size_t)row * 256 + c) = pack8(v0, v1); }
                    else if (pn < 8) { rope8h(v0, v1, cs[m][bj]); *(v4u*)(qi + (size_t)row * 512 + (pn - 6) * 256 + c) = pack8(v0, v1); }
                    else if (pn < 12) {
#pragma unroll
                        for (int e = 0; e < 4; ++e) { v0[e] = silu_f(v0[e]); v1[e] = silu_f(v1[e]); }
                        *(v4u*)(sz + (size_t)row * 1024 + (pn - 8) * 256 + c) = pack8(v0, v1); }
                    else if (c < 64) { rope8h(v0, v1, cs[m][bj]); *(v4u*)(ki + (size_t)row * 64 + c) = pack8(v0, v1); }
                    else if (c == 64) { *(f32x4*)(wi + (size_t)row * 8) = v0; *(f32x4*)(wi + (size_t)row * 8 + 4) = v1; }
                } } }
    }
};

__device__ __forceinline__ int src_col(int map, int n) {
    switch (map) {
    case 1:
        if (n < 512) return n; if (n < 1536) return n + 64; if (n < 1600) { const int c = n - 1536; return 512 + (c >> 1) + 32 * (c & 1); } return -1;
    case 2: {
        const int h = n / 192, c = n - h * 192; if (c < 128) return n; const int c2 = c - 128; return h * 192 + 128 + (c2 >> 1) + 32 * (c2 & 1); }
    case 3:
        if (n < 1280) { const int h = n >> 7, c = n & 127; return h * 128 + (c >> 1) + 64 * (c & 1); }
        if (n < 1536) return n;
        if (n < 2048) { const int c = n - 1536, h = c >> 6, cc = c & 63; return 1536 + h * 64 + (cc >> 1) + 32 * (cc & 1); }
        if (n < 3072) return 2120 + (n - 2048);
        if (n < 3136) { const int c = n - 3072; return 2048 + (c >> 1) + 32 * (c & 1); }
        if (n < 3144) return 2112 + (n - 3136);
        return -1;
    default: return n;
    }
}
__device__ __forceinline__ void tr_item(const float* W, int K, int N, bf16* WT, int Nout, const float* gain, int map, LAS float* scr, int item, int lane) {
    const int nblk = Nout / 32, kb = item / nblk, nb = item % nblk, k0 = 64 * kb, n0 = 32 * nb;
    const int src = src_col(map, n0 + (lane & 31));
    const int srcc = src >= 0 ? src : 0; float wv_[32], gv_[32];
#pragma unroll
    for (int i = 0; i < 32; ++i) { const int kk = 2 * i + (lane >> 5); wv_[i] = W[(size_t)(k0 + kk) * N + srcc]; gv_[i] = gain ? gain[k0 + kk] : 1.f; }
#pragma unroll
    for (int i = 0; i < 32; ++i) { const int kk = 2 * i + (lane >> 5); scr[kk * 33 + (lane & 31)] = src >= 0 ? wv_[i] * gv_[i] : 0.f; }
    LDS_WAIT(); asm volatile("" ::: "memory");
    const int c = lane & 7;
#pragma unroll
    for (int j = 0; j < 4; ++j) { const int n = (lane >> 3) + 8 * j; const LAS float* s = scr + (8 * c) * 33 + n;
        v4u o; o.x = cvtpk(s[0 * 33], s[1 * 33]); o.y = cvtpk(s[2 * 33], s[3 * 33]); o.z = cvtpk(s[4 * 33], s[5 * 33]); o.w = cvtpk(s[6 * 33], s[7 * 33]);
        *(v4u*)(WT + (size_t)(n0 + n) * K + k0 + 8 * c) = o; }
    LDS_WAIT(); asm volatile("" ::: "memory");
}

struct Args { const float* in[17]; float* out; unsigned char* ws; int ph_lo, ph_hi, pmode, pad; };

__device__ __forceinline__ void prologue(const Args& a, LAS unsigned char* lds, int gw, int ngw, int wave, int lane) {
    bf16* Wb = (bf16*)(a.ws + WS_W);
    LAS float* scr = (LAS float*)(lds + wave * 16384);
    for (int mi = 0; mi < 22; ++mi) {
        const float* W; int K, N, Nout, map = 0; const float* gain = nullptr; bf16* WT;
        if (mi < 2)       { const int j = mi;      W = a.in[4] + (size_t)j * 1024 * 1600;  K = 1024; N = 1600; Nout = MLA_N; map = 1; gain = a.in[3] + (size_t)(2 * j) * 1024; WT = Wb + W_WINM + (size_t)j * MLA_N * 1024; }
        else if (mi < 4)  { const int j = mi - 2;  W = a.in[7] + (size_t)j * 256 * 1536;   K = 256;  N = 1536; Nout = 1536;  map = 2; gain = a.in[5] + (size_t)j * 256; WT = Wb + W_WUQ + (size_t)j * 1536 * 256; }
        else if (mi < 6)  { const int j = mi - 4;  W = a.in[8] + (size_t)j * 256 * 1024;   K = 256;  N = 1024; Nout = 1024;  gain = a.in[6] + (size_t)j * 256; WT = Wb + W_WUK + (size_t)j * 1024 * 256; }
        else if (mi < 8)  { const int j = mi - 6;  W = a.in[9] + (size_t)j * 256 * 1024;   K = 256;  N = 1024; Nout = 1024;  gain = a.in[6] + (size_t)j * 256; WT = Wb + W_WUV + (size_t)j * 1024 * 256; }
        else if (mi < 10) { const int j = mi - 8;  W = a.in[10] + (size_t)j * 1024 * 1024; K = 1024; N = 1024; Nout = 1024;  WT = Wb + W_WOM + (size_t)j * 1024 * 1024; }
        else if (mi < 12) { const int j = mi - 10; W = a.in[11] + (size_t)j * 1024 * 3144; K = 1024; N = 3144; Nout = DSA_N; map = 3; gain = a.in[3] + (size_t)(2 * j + 1) * 1024; WT = Wb + W_WIND + (size_t)j * DSA_N * 1024; }
        else if (mi < 14) { const int j = mi - 12; W = a.in[12] + (size_t)j * 1024 * 1024; K = 1024; N = 1024; Nout = 1024;  WT = Wb + W_WOD + (size_t)j * 1024 * 1024; }
        else if (mi < 18) { const int i = mi - 14; W = a.in[13] + (size_t)i * 256 * 1024;  K = 256;  N = 1024; Nout = 1024;  WT = Wb + W_WP + (size_t)i * 1024 * 256; }
        else              { const int i = mi - 18; W = a.in[15] + (size_t)i * 1024 * 1024; K = 1024; N = 1024; Nout = 1024;  gain = a.in[14] + (size_t)i * 1024; WT = Wb + W_WG + (size_t)i * 1024 * 1024; }
        const int nitems = (K / 64) * (Nout / 32);
        for (int it = gw; it < nitems; it += ngw) tr_item(W, K, N, WT, Nout, gain, map, scr, it, lane);
    }
    {
        const int* pos = (const int*)a.in[2]; unsigned* r64 = (unsigned*)(a.ws + WS_ROPE64); unsigned* r32 = (unsigned*)(a.ws + WS_ROPE32);
        const float inv64 = 1.0f / powf(10000.0f, (float)lane / 64.0f);
        const float inv32 = 1.0f / powf(10000.0f, (float)(lane & 31) / 32.0f);
        for (int t0 = gw * 4; t0 < T; t0 += ngw * 4) { int pi[4];
#pragma unroll
          for (int a = 0; a < 4; ++a) pi[a] = pos[t0 + a];
#pragma unroll
          for (int a = 0; a < 4; ++a) { const int t = t0 + a; const float pf = (float)pi[a];
            { const float ang = pf * inv64; float sn, cs; sincosf(ang, &sn, &cs); r64[(size_t)t * 64 + lane] = pack_cs(cs, sn); }
            if (lane < 32) { const float ang = pf * inv32; float sn, cs; sincosf(ang, &sn, &cs); r32[(size_t)t * 32 + lane] = pack_cs(cs, sn); }
          } }
    }
    {
        const float* x = a.in[0]; bf16* xb = (bf16*)(a.ws + WS_XB0); float* rsx = (float*)(a.ws + WS_RSX);
        for (int r0 = gw * 4; r0 < T; r0 += ngw * 4) {
            f32x4 v[4][4];
#pragma unroll
            for (int a = 0; a < 4; ++a) { const f32x4* xr = (const f32x4*)(x + (size_t)(r0 + a) * 1024) + lane;
#pragma unroll
                for (int j = 0; j < 4; ++j) v[a][j] = xr[64 * j]; }
#pragma unroll
            for (int a = 0; a < 4; ++a) { float s = 0.f;
#pragma unroll
                for (int j = 0; j < 4; ++j) s += sq4(v[a][j]);
                s = wave_sum(s);
                u32x2* o8 = (u32x2*)(xb + (size_t)(r0 + a) * 1024) + lane;
#pragma unroll
                for (int j = 0; j < 4; ++j) { u32x2 w; w.x = cvtpk(v[a][j][0], v[a][j][1]); w.y = cvtpk(v[a][j][2], v[a][j][3]); o8[64 * j] = w; }
                if (lane < 16) rsx[(size_t)(r0 + a) * 16 + lane] = lane == 0 ? s : 0.f; }
        }
    }
}
__device__ __forceinline__ void convert_p(const float* p, bf16* pb, int gtid_in, int gthreads) {
    const int gtid = gtid_in;
    constexpr size_t NCH = (size_t)T * 256 / 8;
    size_t i = gtid;
    for (; i + 3 * (size_t)gthreads < NCH; i += 4 * (size_t)gthreads) { f32x4 a[4], b[4];
#pragma unroll
        for (int u = 0; u < 4; ++u) { const size_t c = i + u * (size_t)gthreads; a[u] = *(const f32x4*)(p + c * 8); b[u] = *(const f32x4*)(p + c * 8 + 4); }
#pragma unroll
        for (int u = 0; u < 4; ++u) { const size_t c = i + u * (size_t)gthreads; *(v4u*)(pb + c * 8) = pack8(a[u], b[u]); } }
    for (; i < NCH; i += gthreads) { const f32x4 a = *(const f32x4*)(p + i * 8), b = *(const f32x4*)(p + i * 8 + 4); *(v4u*)(pb + i * 8) = pack8(a, b); }
}

__device__ __forceinline__ unsigned f2key(float s) { const unsigned u = __builtin_bit_cast(unsigned, s); return (u & 0x80000000u) ? ~u : (u | 0x80000000u); }
__device__ __forceinline__ float relu_bits(float x) { const int i = __float_as_int(x); return __int_as_float(i > 0 ? i : 0); }
struct TkUnit { int b, q0; };
__device__ __forceinline__ TkUnit tk_unit(int i, int blk, int nblk, int per) {
    const int pass = i / (NB * per), rem = i - pass * NB * per, b = rem / per, w0 = blk + (rem - b * per) * nblk; TkUnit u; u.b = b; u.q0 = (pass ? 511 - w0 : w0) * 8; return u;
}
constexpr int TK_H1 = 131072, TK_HW = 131072 + 16384, TK_HWS = 576;
struct TkPre { bf16x8 aX[4], aY[4]; f32x4 w[4][2]; bf16x8 kA[4], kB[4], kC[4]; };
__device__ __forceinline__ void tk_preload(TkPre& P, const TkUnit u, int aw, int lane, const bf16* QI, const bf16* KI, const float* WI) {
    const int r = lane & 31, hb = lane >> 5;
    const int a_q = ((r >> 2) & 1) * 2 + (r >> 4), a_h = (r & 3) + 4 * ((r >> 3) & 1);
    const size_t tok0 = (size_t)u.b * SEQ + u.q0; const int ntile = (u.q0 + 8 + 31) >> 5;
#pragma unroll
    for (int s = 0; s < 4; ++s) { P.aX[s] = *(const bf16x8*)(QI + (tok0 + a_q) * 512 + a_h * 64 + 16 * s + 8 * hb); P.aY[s] = *(const bf16x8*)(QI + (tok0 + 4 + a_q) * 512 + a_h * 64 + 16 * s + 8 * hb); }
#pragma unroll
    for (int i = 0; i < 4; ++i) { const int qc = (i >> 1) * 4 + 2 * hb + (i & 1); P.w[i][0] = *(const f32x4*)(WI + (tok0 + qc) * 8); P.w[i][1] = *(const f32x4*)(WI + (tok0 + qc) * 8 + 4); }
    const bf16* kbase = KI + ((size_t)u.b * SEQ + r) * 64 + 8 * hb;
#pragma unroll
    for (int j = 0; j < 3; ++j) { const int t = aw + 4 * j, tt = t < ntile ? t : ntile - 1;
#pragma unroll
        for (int s = 0; s < 4; ++s) { const bf16x8 v = *(const bf16x8*)(kbase + (size_t)tt * 32 * 64 + 16 * s); if (j == 0) P.kA[s] = v; else if (j == 1) P.kB[s] = v; else P.kC[s] = v; } }
}
__device__ __forceinline__ void tk_stepA(TkPre& P, const TkUnit u, const TkUnit nxt, bool has_next, int aw, int lane, LAS unsigned char* lds, const bf16* QI, const bf16* KI, const float* WI) {
    typedef float f32x16 __attribute__((ext_vector_type(16)));
    LAS unsigned* ky = (LAS unsigned*)lds; LAS unsigned* h1 = (LAS unsigned*)(lds + TK_H1) + (lane & 3) * 1024;
    const int r = lane & 31, hb = lane >> 5;
    const int q0 = u.q0;
    float wv[4][8];
#pragma unroll
    for (int i = 0; i < 4; ++i) {
#pragma unroll
        for (int e = 0; e < 4; ++e) { wv[i][e] = P.w[i][0][e] * (0.125f * 0.35355339059327373f); wv[i][4 + e] = P.w[i][1][e] * (0.125f * 0.35355339059327373f); } }
    const int ntile = (q0 + 8 + 31) >> 5;
    const unsigned kvoff = (unsigned)(r * 64 + 8 * hb) * 2u;
    __amdgpu_buffer_rsrc_t krs; { const unsigned long long b_ = (unsigned long long)(KI + (size_t)u.b * SEQ * 64);
        const unsigned lo_ = __builtin_amdgcn_readfirstlane((unsigned)b_), hi_ = __builtin_amdgcn_readfirstlane((unsigned)(b_ >> 32));
        krs = __builtin_amdgcn_make_buffer_rsrc((void*)(((unsigned long long)hi_ << 32) | lo_), (short)0, 0x7fffffff, 0x00020000); }
    bf16x8 kD[4];
#define TK_KLOAD(buf, t) do { const int tt_ = (t) < ntile ? (t) : ntile - 1;     \
        _Pragma("unroll") for (int s = 0; s < 4; ++s) buf[s] = __builtin_bit_cast(bf16x8, __builtin_amdgcn_raw_buffer_load_b128(krs, (int)(kvoff + 32u * s), tt_ * 4096, 0)); } while (0)
#define TK_TILE(buf, t) do { if ((t) < ntile) { const int key = (t) * 32 + r; f32x16 cX = {}, cY = {};                                                            \
        _Pragma("unroll") for (int s = 0; s < 4; ++s) { cX = __builtin_amdgcn_mfma_f32_32x32x16_bf16(P.aX[s], buf[s], cX, 0, 0, 0); cY = __builtin_amdgcn_mfma_f32_32x32x16_bf16(P.aY[s], buf[s], cY, 0, 0, 0); } \
        float sc[4] = {0.f, 0.f, 0.f, 0.f};                                                                                                                      \
        _Pragma("unroll") for (int e = 0; e < 8; ++e) { sc[0] = __builtin_fmaf(relu_bits(cX[e]), wv[0][e], sc[0]); sc[1] = __builtin_fmaf(relu_bits(cX[8 + e]), wv[1][e], sc[1]); \
                                                        sc[2] = __builtin_fmaf(relu_bits(cY[e]), wv[2][e], sc[2]); sc[3] = __builtin_fmaf(relu_bits(cY[8 + e]), wv[3][e], sc[3]); } \
        _Pragma("unroll") for (int i = 0; i < 4; ++i) { const int qc = (i >> 1) * 4 + 2 * hb + (i & 1); const unsigned ub = __builtin_bit_cast(unsigned, sc[i] + 0.0f);        \
            const unsigned kf = ub ^ ((unsigned)((int)ub >> 31) | 0x80000000u);                                      \
            const unsigned kk = (key <= q0 + qc) ? kf : 0u; ky[qc * 4096 + key] = kk;                                                                            \
            __hip_atomic_fetch_add(h1 + qc * 128 + (kk >> 25), 1u << ((kk >> 20) & 16u), __ATOMIC_RELAXED, __HIP_MEMORY_SCOPE_WORKGROUP); } } } while (0)
    for (int tile = aw; tile < ntile; tile += 16) {
        TK_KLOAD(kD, tile + 12); TK_TILE(P.kA, tile);
        TK_KLOAD(P.kA, tile + 16); TK_TILE(P.kB, tile + 4);
        TK_KLOAD(P.kB, tile + 20); TK_TILE(P.kC, tile + 8);
        TK_KLOAD(P.kC, tile + 24); TK_TILE(kD, tile + 12);
    }
#undef TK_KLOAD
#undef TK_TILE
    const int kend = ((q0 + 8 + 511) >> 9) << 9;
    for (int key = ntile * 32 + aw * 64 + lane; key < kend; key += 256) {
#pragma unroll
        for (int i = 0; i < 8; ++i) ky[i * 4096 + key] = 0u; }
    if (has_next) tk_preload(P, nxt, aw, lane, QI, KI, WI);
}
__device__ __forceinline__ void tk_stepB(const unsigned (&k)[64], int q, size_t tok, int ngrp, int lane, const int (&c0)[4], LAS unsigned* hw, unsigned long long* mask) {
    unsigned thr = 0u; int need = 0;
    if (q >= 256) {
        unsigned prefix = 0u; int rem = 256; bool done = false;
#pragma unroll
        for (int p = 0; p < 4; ++p) {
            constexpr int SH[4] = {24, 15, 6, 0}, NBITS[4] = {8, 9, 9, 6};
            const int sh = SH[p], nb = NBITS[p];
            int c[8];
            if (p == 0) { c[0] = c0[0]; c[1] = c0[1]; c[2] = c0[2]; c[3] = c0[3]; c[4] = 0; c[5] = 0; c[6] = 0; c[7] = 0; }
            else {
                *(LAS v4u*)(hw + lane * 8) = (v4u){0u, 0u, 0u, 0u}; *(LAS v4u*)(hw + lane * 8 + 4) = (v4u){0u, 0u, 0u, 0u};
                const unsigned pfx = prefix >> (sh + nb), dummy = 512u + (unsigned)lane;
#pragma unroll
                for (int g = 0; g < 8; ++g) if (g < ngrp) {
#pragma unroll
                    for (int e = 0; e < 8; ++e) { const unsigned kk = k[g * 8 + e]; const bool cand = (kk >> (sh + nb)) == pfx; const unsigned bin = (kk >> sh) & ((1u << nb) - 1u);
                        if (p == 1) __hip_atomic_fetch_add(hw + (cand ? bin : dummy), 1u, __ATOMIC_RELAXED, __HIP_MEMORY_SCOPE_WORKGROUP);
                        else if (__ballot(cand) != 0ull) { if (cand) __hip_atomic_fetch_add(hw + bin, 1u, __ATOMIC_RELAXED, __HIP_MEMORY_SCOPE_WORKGROUP); } }
                    __builtin_amdgcn_sched_barrier(0); }
                LDS_WAIT(); asm volatile("" ::: "memory");
                const v4u h0 = *(const LAS v4u*)(hw + lane * 8), h1v = *(const LAS v4u*)(hw + lane * 8 + 4);
                c[0] = (int)h0.x; c[1] = (int)h0.y; c[2] = (int)h0.z; c[3] = (int)h0.w; c[4] = (int)h1v.x; c[5] = (int)h1v.y; c[6] = (int)h1v.z; c[7] = (int)h1v.w; }
            const int tot = ((c[0] + c[1]) + (c[2] + c[3])) + ((c[4] + c[5]) + (c[6] + c[7]));
            int P = tot;
            P += __builtin_amdgcn_update_dpp(0, P, 0x111, 0xf, 0xf, false); P += __builtin_amdgcn_update_dpp(0, P, 0x112, 0xf, 0xf, false);
            P += __builtin_amdgcn_update_dpp(0, P, 0x114, 0xf, 0xf, false); P += __builtin_amdgcn_update_dpp(0, P, 0x118, 0xf, 0xf, false);
            P += __builtin_amdgcn_update_dpp(0, P, 0x142, 0xa, 0xf, false); P += __builtin_amdgcn_update_dpp(0, P, 0x143, 0xc, 0xf, false);
            const int total = __builtin_amdgcn_readlane(P, 63);
            const int snext = total - P;
            const int L = __popcll(__ballot(snext + tot >= rem)) - 1;
            int s = snext, dl = 0, cgl = 0, cel = 0;
#pragma unroll
            for (int e = 7; e >= 0; --e) { const int s2 = s + c[e]; const bool hit = (s < rem) && (s2 >= rem); dl = hit ? e : dl; cgl = hit ? s : cgl; cel = hit ? c[e] : cel; s = s2; }
            const int d = L * (p == 0 ? 4 : 8) + __builtin_amdgcn_readlane(dl, L), cgt = __builtin_amdgcn_readlane(cgl, L), ceq = __builtin_amdgcn_readlane(cel, L);
            rem -= cgt; prefix |= (unsigned)d << sh;
            if (ceq == rem) { done = true; break; }
        }
        if (done) { thr = prefix - 1u; need = 0; } else { thr = prefix; need = rem; }
    }
    unsigned wlo = 0u, whi = 0u;
#define WL(J, w) do { const unsigned lo_ = (unsigned)(w), hi_ = (unsigned)((w) >> 32);                                                                      \
                asm volatile("s_nop 3\n\tv_writelane_b32 %0, %2, " #J "\n\tv_writelane_b32 %1, %3, " #J : "+v"(wlo), "+v"(whi) : "s"(lo_), "s"(hi_)); } while (0)
#define REP64(M) M(0); M(1); M(2); M(3); M(4); M(5); M(6); M(7); __builtin_amdgcn_sched_barrier(0); M(8); M(9); M(10); M(11); M(12); M(13); M(14); M(15); __builtin_amdgcn_sched_barrier(0); \
                 M(16); M(17); M(18); M(19); M(20); M(21); M(22); M(23); __builtin_amdgcn_sched_barrier(0); M(24); M(25); M(26); M(27); M(28); M(29); M(30); M(31); __builtin_amdgcn_sched_barrier(0); \
                 M(32); M(33); M(34); M(35); M(36); M(37); M(38); M(39); __builtin_amdgcn_sched_barrier(0); M(40); M(41); M(42); M(43); M(44); M(45); M(46); M(47); __builtin_amdgcn_sched_barrier(0); \
                 M(48); M(49); M(50); M(51); M(52); M(53); M(54); M(55); __builtin_amdgcn_sched_barrier(0); M(56); M(57); M(58); M(59); M(60); M(61); M(62); M(63); __builtin_amdgcn_sched_barrier(0)
    if (need == 0) {
#define SEL_GT8(J0, J1, J2, J3, J4, J5, J6, J7) do { const unsigned long long w0_ = __ballot(k[J0] > thr); const unsigned long long w1_ = __ballot(k[J1] > thr); const unsigned long long w2_ = __ballot(k[J2] > thr); const unsigned long long w3_ = __ballot(k[J3] > thr); const unsigned long long w4_ = __ballot(k[J4] > thr); const unsigned long long w5_ = __ballot(k[J5] > thr); const unsigned long long w6_ = __ballot(k[J6] > thr); const unsigned long long w7_ = __ballot(k[J7] > thr);                                     \
                asm volatile("s_nop 3\n\t" "v_writelane_b32 %0, %2, " #J0 "\n\tv_writelane_b32 %1, %3, " #J0 "\n\t" "v_writelane_b32 %0, %4, " #J1 "\n\tv_writelane_b32 %1, %5, " #J1 "\n\t" "v_writelane_b32 %0, %6, " #J2 "\n\tv_writelane_b32 %1, %7, " #J2 "\n\t" "v_writelane_b32 %0, %8, " #J3 "\n\tv_writelane_b32 %1, %9, " #J3 "\n\t" "v_writelane_b32 %0, %10, " #J4 "\n\tv_writelane_b32 %1, %11, " #J4 "\n\t" "v_writelane_b32 %0, %12, " #J5 "\n\tv_writelane_b32 %1, %13, " #J5 "\n\t" "v_writelane_b32 %0, %14, " #J6 "\n\tv_writelane_b32 %1, %15, " #J6 "\n\t" "v_writelane_b32 %0, %16, " #J7 "\n\tv_writelane_b32 %1, %17, " #J7 "\n\t" : "+v"(wlo), "+v"(whi) : "s"((unsigned)(w0_)), "s"((unsigned)((w0_) >> 32)), "s"((unsigned)(w1_)), "s"((unsigned)((w1_) >> 32)), "s"((unsigned)(w2_)), "s"((unsigned)((w2_) >> 32)), "s"((unsigned)(w3_)), "s"((unsigned)((w3_) >> 32)), "s"((unsigned)(w4_)), "s"((unsigned)((w4_) >> 32)), "s"((unsigned)(w5_)), "s"((unsigned)((w5_) >> 32)), "s"((unsigned)(w6_)), "s"((unsigned)((w6_) >> 32)), "s"((unsigned)(w7_)), "s"((unsigned)((w7_) >> 32))); __builtin_amdgcn_sched_barrier(0); } while (0)
        SEL_GT8(0, 1, 2, 3, 4, 5, 6, 7); SEL_GT8(8, 9, 10, 11, 12, 13, 14, 15); SEL_GT8(16, 17, 18, 19, 20, 21, 22, 23); SEL_GT8(24, 25, 26, 27, 28, 29, 30, 31);
        SEL_GT8(32, 33, 34, 35, 36, 37, 38, 39); SEL_GT8(40, 41, 42, 43, 44, 45, 46, 47); SEL_GT8(48, 49, 50, 51, 52, 53, 54, 55); SEL_GT8(56, 57, 58, 59, 60, 61, 62, 63);
#undef SEL_GT8
    } else {
        int run = 0; const unsigned long long ltmask = (1ull << lane) - 1ull;
#define SEL_TIE(J) do { const unsigned kk = k[J]; const bool eq = kk == thr; const unsigned long long beq = __ballot(eq);                                   \
                const int rank = run + __popcll(beq & ltmask); const bool sel = (kk > thr) || (eq && rank < need);                                          \
                const unsigned long long w = __ballot(sel); WL(J, w); run += __popcll(beq); } while (0)
        REP64(SEL_TIE);
#undef SEL_TIE
    }
#undef REP64
#undef WL
    mask[tok * 64 + lane] = ((unsigned long long)whi << 32) | wlo;
}
#define TK_LOADK(kk, rowi, ngrp_) do { const LAS unsigned* row_ = (const LAS unsigned*)lds + (rowi) * 4096;                                      \
        _Pragma("unroll") for (int g = 0; g < 8; ++g) { if (g < (ngrp_)) { _Pragma("unroll") for (int e = 0; e < 8; ++e) kk[g * 8 + e] = row_[(g * 8 + e) * 64 + lane]; } \
            else { _Pragma("unroll") for (int e = 0; e < 8; ++e) kk[g * 8 + e] = 0u; } } } while (0)
__device__ __forceinline__ void topk_phase(int blk, int nblk, int wave, int lane, LAS unsigned char* lds, const bf16* QI, const bf16* KI, const float* WI, unsigned long long* mask) {
    const bool isA = wave < 4; const int aw = wave, bw = wave - 4;
    const int per = (256 - blk + nblk - 1) / nblk, n = NB * 2 * per;
    if (per <= 0) return;
    { LAS unsigned* z = (LAS unsigned*)(lds + TK_H1); for (int i = wave * 64 + lane; i < 4096; i += 512) z[i] = 0u; }
    LDS_WAIT(); __syncthreads();
    if (isA) {
        TkPre P; tk_preload(P, tk_unit(0, blk, nblk, per), aw, lane, QI, KI, WI);
        tk_stepA(P, tk_unit(0, blk, nblk, per), tk_unit(n > 1 ? 1 : 0, blk, nblk, per), n > 1, aw, lane, lds, QI, KI, WI);
        LDS_WAIT(); __builtin_amdgcn_s_barrier();
        for (int s = 1; s <= n; ++s) {
            LDS_WAIT(); __builtin_amdgcn_s_barrier();
            if (s < n) tk_stepA(P, tk_unit(s, blk, nblk, per), tk_unit(s + 1 < n ? s + 1 : s, blk, nblk, per), s + 1 < n, aw, lane, lds, QI, KI, WI);
            LDS_WAIT(); __builtin_amdgcn_s_barrier();
        }
    } else {
        LDS_WAIT(); __builtin_amdgcn_s_barrier();
        for (int s = 1; s <= n; ++s) {
            const TkUnit up = tk_unit(s - 1, blk, nblk, per);
            const int ngrp = (((up.q0 + 8 + 511) >> 9) << 9) >> 9;
            unsigned k0[64], k1[64];
            TK_LOADK(k0, 2 * bw, ngrp); TK_LOADK(k1, 2 * bw + 1, ngrp);
            int c00[4] = {0, 0, 0, 0}, c01[4] = {0, 0, 0, 0};
            { LAS unsigned* hb0 = (LAS unsigned*)(lds + TK_H1) + (2 * bw) * 128 + lane * 2;
#pragma unroll
              for (int cp = 0; cp < 4; ++cp) { const u32x2 a = *(const LAS u32x2*)(hb0 + cp * 1024), b = *(const LAS u32x2*)(hb0 + cp * 1024 + 128);
                  c00[0] += (int)(a.x & 0xffffu); c00[1] += (int)(a.x >> 16); c00[2] += (int)(a.y & 0xffffu); c00[3] += (int)(a.y >> 16);
                  c01[0] += (int)(b.x & 0xffffu); c01[1] += (int)(b.x >> 16); c01[2] += (int)(b.y & 0xffffu); c01[3] += (int)(b.y >> 16);
                  *(LAS u32x2*)(hb0 + cp * 1024) = (u32x2){0u, 0u}; *(LAS u32x2*)(hb0 + cp * 1024 + 128) = (u32x2){0u, 0u}; } }
            LDS_WAIT(); __builtin_amdgcn_s_barrier();
            LAS unsigned* hw = (LAS unsigned*)(lds + TK_HW) + bw * TK_HWS;
            const size_t tok0 = (size_t)up.b * SEQ + up.q0;
            tk_stepB(k0, up.q0 + 2 * bw, tok0 + 2 * bw, ngrp, lane, c00, hw, mask);
            tk_stepB(k1, up.q0 + 2 * bw + 1, tok0 + 2 * bw + 1, ngrp, lane, c01, hw, mask);
            LDS_WAIT(); __builtin_amdgcn_s_barrier();
        }
    }
    __syncthreads();
}
#undef TK_LOADK

#define PROBE 0
#define IN(k) (lo <= (k) && (k) < hi)
#define SEAM(k) do { if (IN(k) && IN((k) + 1)) { xcd_barrier(bar); if (PROBE == 50) xcd_barrier(bar); } } while (0)
#define WSP(T_, off) ((T_*)(args.ws + (off)))
__device__ __forceinline__ int opaque_tid() { int t = threadIdx.x; asm volatile("" : "+v"(t)); return t; }
#define PROBE 0
template <int I>
__device__ __forceinline__ void layer(const Args& args, LAS unsigned char* lds, const XcdBarrier& bar, const int lo, const int hi, const int G, const int bx) {
    constexpr int k0 = 1 + 5 * I, j = I >> 1;
    extern __shared__ __attribute__((aligned(16))) unsigned char lds_dyn[];
#define ldsg ((char*)lds_dyn)
#define TID_ (opaque_tid())
#define LANE_ ((int)threadIdx.x & 63)
#define WAVE_ (__builtin_amdgcn_readfirstlane((int)threadIdx.x >> 6))
    if constexpr ((I & 1) == 0) {
        if (IN(k0)) {
            pg8::Gemm g{WSP(bf16, WS_XB0), WSP(bf16, WS_W) + W_WINM + (size_t)j * MLA_N * 1024, T, MLA_N, 1024}; pg8::StaticOrder S; S.init(T, MLA_N, G, bx);
            EpiMlaIn E{WSP(float, WS_RSX), WSP(bf16, WS_CQ), WSP(bf16, WS_CKV), WSP(bf16, WS_SZ), WSP(bf16, WS_KPE), WSP(float, WS_RSQ), WSP(float, WS_RSKV), WSP(unsigned, WS_ROPE32)};
            if (PROBE == 5 && I == 0) pg8::gemm_phase<EpiMlaIn, pg8::StaticOrder, true, true>(lds, g, S, E);
            pg8::gemm_phase<EpiMlaIn, pg8::StaticOrder, true, true>(lds, g, S, E);
        }
        SEAM(k0);
        if (IN(k0 + 1)) for (int rep = 0; rep < ((PROBE == 4 && I < 2) ? 2 : 1); ++rep) {
            { pg8::Gemm g{WSP(bf16, WS_CQ), WSP(bf16, WS_W) + W_WUQ + (size_t)j * 1536 * 256, T, 1536, 256}; pg8::StaticOrder S; S.init(T, 1536, G, bx); EpiMlaQ E{WSP(float, WS_RSQ), WSP(bf16, WS_Q), WSP(unsigned, WS_ROPE32)};
              pg8::gemm_phase<EpiMlaQ, pg8::StaticOrder, true, true>(lds, g, S, E); }
            { pg8::Gemm g{WSP(bf16, WS_CKV), WSP(bf16, WS_W) + W_WUK + (size_t)j * 1024 * 256, T, 1024, 256}; pg8::StaticOrder S; S.init(T, 1024, G, bx); EpiMlaKV E{WSP(float, WS_RSKV), WSP(bf16, WS_KN)};
              pg8::gemm_phase<EpiMlaKV, pg8::StaticOrder, true, true>(lds, g, S, E); }
            { pg8::Gemm g{WSP(bf16, WS_CKV), WSP(bf16, WS_W) + W_WUV + (size_t)j * 1024 * 256, T, 1024, 256}; pg8::StaticOrder S; S.init(T, 1024, G, bx); EpiMlaKV E{WSP(float, WS_RSKV), WSP(bf16, WS_V)};
              pg8::gemm_phase<EpiMlaKV, pg8::StaticOrder, true, true>(lds, g, S, E); }
        }
        SEAM(k0 + 1);
        if (IN(k0 + 2)) {
            for (int rep = (PROBE == 11 && I == 0) ? 0 : 1; rep < 2; ++rep)
            att::attn_phase<true, false, 1536, 192, 1024, 1024, 8>(ldsg, WSP(bf16, WS_Q), WSP(bf16, WS_KN), WSP(bf16, WS_V), WSP(bf16, WS_KPE), WSP(bf16, WS_SZ), nullptr, 0.07216878364870323f, args.in[1] + (size_t)I * T * 256, WSP(bf16, WS_PB), rep == 0);
        }
        SEAM(k0 + 2);
    } else {
        if (IN(k0)) {
            pg8::Gemm g{WSP(bf16, WS_XB0), WSP(bf16, WS_W) + W_WIND + (size_t)j * DSA_N * 1024, T, DSA_N, 1024}; pg8::StaticOrder S; S.init(T, DSA_N, G, bx);
            EpiDsaIn E{WSP(float, WS_RSX), WSP(bf16, WS_Q), WSP(bf16, WS_KD), WSP(bf16, WS_VD), WSP(bf16, WS_QI), WSP(bf16, WS_SZ), WSP(bf16, WS_KI), WSP(float, WS_WI), WSP(unsigned, WS_ROPE64), WSP(unsigned, WS_ROPE32)};
            for (int rep = 0; rep < ((PROBE == 4 && I < 2) ? 2 : 1); ++rep) pg8::gemm_phase<EpiDsaIn, pg8::StaticOrder, true, true>(lds, g, S, E);
        }
        SEAM(k0);
        if (IN(k0 + 1)) {
            topk_phase(bx, G, WAVE_, LANE_, lds, WSP(bf16, WS_QI), WSP(bf16, WS_KI), WSP(float, WS_WI), WSP(unsigned long long, WS_MASK)); }
        SEAM(k0 + 1);
        if (IN(k0 + 2)) {
            if (PROBE == 2 && I == 1) att::attn_phase<false, true, 1024, 128, 256, 256, 2, true>(ldsg, WSP(bf16, WS_Q), WSP(bf16, WS_KD), WSP(bf16, WS_VD), nullptr, WSP(bf16, WS_SZ), WSP(unsigned long long, WS_MASK), 0.08838834764831845f, args.in[1] + (size_t)I * T * 256, WSP(bf16, WS_PB));
            att::attn_phase<false, true, 1024, 128, 256, 256, 2>(ldsg, WSP(bf16, WS_Q), WSP(bf16, WS_KD), WSP(bf16, WS_VD), nullptr, WSP(bf16, WS_SZ), WSP(unsigned long long, WS_MASK), 0.08838834764831845f, args.in[1] + (size_t)I * T * 256, WSP(bf16, WS_PB));
        }
        SEAM(k0 + 2);
    }
    if (IN(k0 + 3)) for (int rep = ((PROBE == 4 && I < 2) ? 0 : 1); rep < 2; ++rep) {
        { pg8::Gemm g{WSP(bf16, WS_PB), WSP(bf16, WS_W) + W_WP + (size_t)I * 1024 * 256, T, 1024, 256}; pg8::StaticOrder S; S.init(T, 1024, G, bx); EpiPlain E{WSP(bf16, WS_PP)};
          pg8::gemm_phase<EpiPlain, pg8::StaticOrder, true, true>(lds, g, S, E); }
        { pg8::Gemm g{WSP(bf16, WS_SZ), WSP(bf16, WS_W) + ((I & 1) ? W_WOD : W_WOM) + (size_t)j * 1024 * 1024, T, 1024, 1024}; pg8::StaticOrder S; S.init(T, 1024, G, bx);
          EpiOut E{WSP(bf16, WS_XB0), WSP(bf16, WS_XB1), WSP(float, WS_RS1), rep == 0};
          pg8::gemm_phase<EpiOut, pg8::StaticOrder, true, true>(lds, g, S, E); }
    }
    SEAM(k0 + 3);
    if (IN(k0 + 4)) for (int rep = ((PROBE == 4 && I < 2) ? 0 : 1); rep < 2; ++rep) {
        pg8::Gemm g{WSP(bf16, WS_XB1), WSP(bf16, WS_W) + W_WG + (size_t)I * 1024 * 1024, T, 1024, 1024}; pg8::StaticOrder S; S.init(T, 1024, G, bx);
        EpiGate E{WSP(float, WS_RS1), WSP(bf16, WS_XB1), WSP(bf16, WS_PP), WSP(bf16, WS_XB0), WSP(float, WS_RSX), rep == 0};
        pg8::gemm_phase<EpiGate, pg8::StaticOrder, true, true>(lds, g, S, E);
    }
    SEAM(k0 + 4);
#undef TID_
#undef LANE_
#undef WAVE_
#undef ldsg
}

__global__ void __launch_bounds__(NWAVES * 64, 2) fwd(Args args) {
    extern __shared__ __attribute__((aligned(16))) unsigned char lds_raw[];
    LAS unsigned char* lds = (LAS unsigned char*)lds_raw;
    volatile LAS unsigned* MISC = (volatile LAS unsigned*)(lds + MISC_OFF);
    const int G = gridDim.x, bx = blockIdx.x;
    for (int u = threadIdx.x; u < (LDS_BYTES - MISC_OFF) / 4; u += NWAVES * 64) ((LAS unsigned*)(lds + MISC_OFF))[u] = 0u;
    __syncthreads();
    const int lo = args.ph_lo, hi = args.ph_hi;
    XcdBarrier bar; bar.bar = (unsigned*)(args.ws + WS_CTL) + CW_BAR; bar.x = 0; bar.st = nullptr;
    if (hi - lo > 1) bar = xcd_barrier_post((unsigned*)(args.ws + WS_CTL) + CW_BAR, MISC + 8);

    if (IN(0)) { const int lane = threadIdx.x & 63, wave = __builtin_amdgcn_readfirstlane((int)threadIdx.x >> 6);
        if (PROBE == 8) prologue(args, lds, bx * NWAVES + wave, G * NWAVES, wave, lane); prologue(args, lds, bx * NWAVES + wave, G * NWAVES, wave, lane); }
    SEAM(0);
    layer<0>(args, lds, bar, lo, hi, G, bx);
    layer<1>(args, lds, bar, lo, hi, G, bx);
    layer<2>(args, lds, bar, lo, hi, G, bx);
    layer<3>(args, lds, bar, lo, hi, G, bx);
    if (IN(21)) {
        const int lane = threadIdx.x & 63, wave = __builtin_amdgcn_readfirstlane((int)threadIdx.x >> 6);
        const int gw = bx * NWAVES + wave, ngw = G * NWAVES;
        const float* fg = args.in[16]; f32x4 gv[4];
#pragma unroll
        for (int jj = 0; jj < 4; ++jj) gv[jj] = ((const f32x4*)fg)[lane + 64 * jj];
        const bf16* xbf = (const bf16*)(args.ws + WS_XB0);
        for (int r0 = gw * 2; r0 < T; r0 += ngw * 2) { u32x2 w[2][4];
#pragma unroll
            for (int a = 0; a < 2; ++a) { const u32x2* xr = (const u32x2*)(xbf + (size_t)(r0 + a) * 1024) + lane;
#pragma unroll
                for (int jj = 0; jj < 4; ++jj) w[a][jj] = xr[64 * jj]; }
#pragma unroll
            for (int a = 0; a < 2; ++a) { f32x4 v[4]; float s = 0.f;
#pragma unroll
                for (int jj = 0; jj < 4; ++jj) { v[jj][0] = bf2f(w[a][jj].x & 0xffffu); v[jj][1] = bf2f(w[a][jj].x >> 16); v[jj][2] = bf2f(w[a][jj].y & 0xffffu); v[jj][3] = bf2f(w[a][jj].y >> 16); s += sq4(v[jj]); }
                const float rstd = rsqrtf(wave_sum(s) * (1.f / 1024.f) + NORM_EPS);
                f32x4* orow = (f32x4*)(args.out + (size_t)(r0 + a) * 1024) + lane;
#pragma unroll
                for (int jj = 0; jj < 4; ++jj) orow[64 * jj] = v[jj] * rstd * gv[jj]; } }
    }
}
#undef IN
#undef SEAM

#if PROBE == 12 || PROBE == 13
__global__ void __launch_bounds__(NWAVES * 64, 2) probe_attn(Args args) {
    extern __shared__ __attribute__((aligned(16))) unsigned char lds_raw[];
#if PROBE == 12
    att::attn_phase<true, false, 1536, 192, 1024, 1024, 8, true>((char*)lds_raw, WSP(bf16, WS_Q), WSP(bf16, WS_KN), WSP(bf16, WS_V), WSP(bf16, WS_KPE), WSP(bf16, WS_SZ), nullptr, 0.07216878364870323f, args.in[1], WSP(bf16, WS_PB));
#else
    att::attn_phase<false, true, 1024, 128, 256, 256, 2, true>((char*)lds_raw, WSP(bf16, WS_Q), WSP(bf16, WS_KD), WSP(bf16, WS_VD), nullptr, WSP(bf16, WS_SZ), WSP(unsigned long long, WS_MASK), 0.08838834764831845f, args.in[1], WSP(bf16, WS_PB));
#endif
}
#endif
#ifndef ONE_LAUNCH
#define ONE_LAUNCH 1
#endif
extern "C" void kernel_launch(void* const* d_in, const int* in_sizes, int n_in, void* d_out, int out_size, void* d_ws, size_t ws_size, hipStream_t stream) {
    static int grid = 0;
    if (grid == 0) {
        if (n_in != 17 || out_size != T * DM || ws_size < WS_END) { fprintf(stderr, "kernel_launch: unexpected shapes (n_in %d, out %d, ws %zu)\n", n_in, out_size, ws_size); grid = -1; return; }
        int dev = 0, cus = 0, per_cu = 0;
        if (hipGetDevice(&dev) != hipSuccess || hipDeviceGetAttribute(&cus, hipDeviceAttributeMultiprocessorCount, dev) != hipSuccess) { grid = -1; return; }
        if (hipFuncSetAttribute((const void*)fwd, hipFuncAttributeMaxDynamicSharedMemorySize, LDS_BYTES) != hipSuccess) { fprintf(stderr, "kernel_launch: hipFuncSetAttribute failed\n"); grid = -1; return; }
        if (hipOccupancyMaxActiveBlocksPerMultiprocessor(&per_cu, (const void*)fwd, NWAVES * 64, LDS_BYTES) != hipSuccess || per_cu < 1) fprintf(stderr, "kernel_launch: occupancy query says %d\n", per_cu);
        (void)hipGetLastError();
        grid = cus;
    }
    if (grid < 0) return;
    (void)hipMemsetAsync((char*)d_ws + WS_CTL, 0, CTL_ZERO_BYTES, stream);
    Args a{};
    for (int i = 0; i < 17; ++i) a.in[i] = (const float*)d_in[i];
    a.out = (float*)d_out; a.ws = (unsigned char*)d_ws;
    if (ONE_LAUNCH) { a.ph_lo = 0; a.ph_hi = NPHASE; hipLaunchKernelGGL(fwd, dim3(grid), dim3(NWAVES * 64), LDS_BYTES, stream, a); }
    else for (int ph = 0; ph < NPHASE; ++ph) { a.ph_lo = ph; a.ph_hi = ph + 1; hipLaunchKernelGGL(fwd, dim3(grid), dim3(NWAVES * 64), LDS_BYTES, stream, a); }
#if PROBE >= 100
    a.pmode = (PROBE / 100) - 1; a.ph_lo = PROBE % 100; a.ph_hi = PROBE % 100 + 1; hipLaunchKernelGGL(fwd, dim3(grid), dim3(NWAVES * 64), LDS_BYTES, stream, a);
#endif
#if PROBE == 12 || PROBE == 13
    { static bool attr2 = false; if (!attr2) { attr2 = true; (void)hipFuncSetAttribute((const void*)probe_attn, hipFuncAttributeMaxDynamicSharedMemorySize, LDS_BYTES); }
      hipLaunchKernelGGL(probe_attn, dim3(grid), dim3(NWAVES * 64), LDS_BYTES, stream, a); }
#endif
}
```
